# Optimizing an MI355X kernel written in HIP

```python
import math
import jax, jax.numpy as jnp
from jax import lax
import numpy as np


D_MODEL = 1024
BATCH = 32
SEQ = 2048
DEPTH = 2

N_EVEN = (DEPTH + 1) // 2
N_ODD = DEPTH // 2
HEAD_DIM = 64
ATT_HEADS = D_MODEL // (2 * HEAD_DIM)
ATT_WIDTH = ATT_HEADS * HEAD_DIM
ROPE_DIM = HEAD_DIM // 4
ROPE_THETA = 500000.0
DILATED_BRANCHES = ((128, 1), (512, 4), (2048, 16))
ATT_BLOCK = 128
NEG_INF = -1e30
SSM_WIDTH = D_MODEL - ATT_WIDTH
SSM_GROUP = 16
SSM_GROUPS = SSM_WIDTH // SSM_GROUP
SSM_STATE = 64
EVEN_IN = 3 * ATT_WIDTH + SSM_WIDTH
LRU_WIDTH = D_MODEL
LRU_BLOCKS = 4
LRU_BLOCK_DIM = LRU_WIDTH // LRU_BLOCKS
CONV_WIDTH = 4
RG_C = 8.0
FFN_HIDDEN = -(-8 * D_MODEL // (3 * 256)) * 256
NORM_EPS = 1e-6

kernel_name = 'hybrid_dilated_attn_s5_rglru_block'


def rms_norm(x, g):
    x32 = x.astype(jnp.float32)
    y = x32 * lax.rsqrt(jnp.mean(x32 * x32, axis=-1, keepdims=True) + NORM_EPS) * g.astype(jnp.float32)
    return y.astype(x.dtype)


def swiglu(x, w_gate, w_up, w_down):
    return (jax.nn.silu(x @ w_gate) * (x @ w_up)) @ w_down


def _linear_combine(e1, e2):
    a1, b1 = e1
    a2, b2 = e2
    return a1 * a2, a2 * b1 + b2


def partial_rope(t, positions):
    half = ROPE_DIM // 2
    inv_freq = ROPE_THETA ** (-(jnp.arange(half, dtype=jnp.float32) * 2.0 / ROPE_DIM))
    ang = positions.astype(jnp.float32)[..., None] * inv_freq
    cos = jnp.cos(ang)[:, :, None, :]
    sin = jnp.sin(ang)[:, :, None, :]
    t1 = t[..., :half]
    t2 = t[..., half:ROPE_DIM]
    return jnp.concatenate([t1 * cos - t2 * sin, t2 * cos + t1 * sin, t[..., ROPE_DIM:]], axis=-1)


def _dilated_branch(q, k, v, window, dilation):
    b, s, h, c = q.shape
    L = s // dilation
    nb = -(-L // ATT_BLOCK)
    Lp = nb * ATT_BLOCK
    span = window // dilation

    def strided(t):
        t = t.reshape(b, L, dilation, h, c).transpose(0, 2, 1, 3, 4)
        return jnp.pad(t, ((0, 0), (0, 0), (0, Lp - L), (0, 0), (0, 0)))

    def band(t):
        t = jnp.pad(strided(t), ((0, 0), (0, 0), (ATT_BLOCK, 0), (0, 0), (0, 0)))
        t = t.reshape(b, dilation, nb + 1, ATT_BLOCK, h, c)
        return jnp.concatenate([t[:, :, :-1], t[:, :, 1:]], axis=3)

    qb = strided(q).reshape(b, dilation, nb, ATT_BLOCK, h, c)
    kb = band(k)
    vb = band(v)
    scores = jnp.einsum('brnqhc,brnkhc->brnhqk', qb, kb)
    qi = jnp.arange(ATT_BLOCK)[:, None] + ATT_BLOCK
    ki = jnp.arange(2 * ATT_BLOCK)[None, :]
    dist = qi - ki
    kpos = jnp.arange(nb)[:, None, None] * ATT_BLOCK + ki[None] - ATT_BLOCK
    mask = ((dist >= 0) & (dist <= span))[None] & (kpos >= 0)
    scores = jnp.where(mask[None, None, :, None], scores, NEG_INF)
    m = jnp.max(scores, axis=-1)
    p = jnp.exp(scores - m[..., None])
    l = jnp.sum(p, axis=-1)
    acc = jnp.einsum('brnhqk,brnkhc->brnqhc', p, vb)

    def unstride(t):
        t = t.reshape((b, dilation, Lp) + t.shape[4:])[:, :, :L]
        t = jnp.moveaxis(t, 1, 2)
        return t.reshape((b, s) + t.shape[3:])

    m = jnp.moveaxis(m, -1, 3)
    l = jnp.moveaxis(l, -1, 3)
    return unstride(acc), unstride(m), unstride(l)


def dilated_attention(q, k, v):
    outs = [_dilated_branch(q, k, v, w, d) for (w, d) in DILATED_BRANCHES]
    acc_all = jnp.stack([o[0] for o in outs])
    m_all = jnp.stack([o[1] for o in outs])
    l_all = jnp.stack([o[2] for o in outs])
    wts = jnp.exp(m_all - jnp.max(m_all, axis=0, keepdims=True))
    num = jnp.einsum('ibsh,ibshc->bshc', wts, acc_all)
    den = jnp.sum(wts * l_all, axis=0)
    return num / den[..., None]


def s5_mixer(u, a_re, a_im, log_dt, b_re, b_im, c_re, c_im, d_skip, w_glu):
    b, s, _ = u.shape
    u = u.reshape(b, s, SSM_GROUPS, SSM_GROUP)
    f32 = jnp.float32
    A = lax.complex(a_re.astype(f32), a_im.astype(f32))
    dt = jnp.exp(log_dt.astype(f32))[:, None]
    a_bar = jnp.exp(A * dt)
    b_bar = ((a_bar - 1.0) / A)[..., None] * lax.complex(b_re.astype(f32), b_im.astype(f32))
    bu = jnp.einsum('gpc,bsgc->bsgp', b_bar, u.astype(jnp.complex64))
    a_seq = jnp.broadcast_to(a_bar, (s,) + a_bar.shape)
    h = jax.vmap(lambda bu_b: lax.associative_scan(_linear_combine, (a_seq, bu_b), axis=0)[1])(bu)
    c_mat = lax.complex(c_re.astype(f32), c_im.astype(f32))
    y = jnp.einsum('gcp,bsgp->bsgc', c_mat, h).real + d_skip.astype(f32) * u
    y = jax.nn.gelu(y.reshape(b, s, SSM_WIDTH))
    return y * jax.nn.sigmoid(y @ w_glu.astype(f32))


def rglru_mixer(xb, conv_w, conv_b, w_r, b_r, w_i, b_i, lam):
    b, s, r = xb.shape
    f32 = jnp.float32
    xc = lax.conv_general_dilated(xb, conv_w.astype(f32)[:, None, :], window_strides=(1,),
                                  padding=[(CONV_WIDTH - 1, 0)],
                                  dimension_numbers=('NWC', 'WIO', 'NWC'),
                                  feature_group_count=r) + conv_b.astype(f32)
    xh = xc.reshape(b, s, LRU_BLOCKS, LRU_BLOCK_DIM)
    gate_r = jax.nn.sigmoid(jnp.einsum('bshi,hij->bshj', xh, w_r.astype(f32)).reshape(b, s, r) + b_r.astype(f32))
    gate_i = jax.nn.sigmoid(jnp.einsum('bshi,hij->bshj', xh, w_i.astype(f32)).reshape(b, s, r) + b_i.astype(f32))
    log_a = -RG_C * gate_r * jax.nn.softplus(-lam.astype(f32))
    a = jnp.exp(log_a)
    mult = jnp.sqrt(-jnp.expm1(2.0 * log_a))
    _, h = lax.associative_scan(_linear_combine, (a, mult * (gate_i * xc)), axis=1)
    return h


def even_mixer(xn, positions, w_in, w_out, a_re, a_im, log_dt, b_re, b_im, c_re, c_im, d_skip, w_glu):
    b, s, _ = xn.shape
    z = (xn @ w_in).astype(jnp.float32)
    q = z[..., :ATT_WIDTH].reshape(b, s, ATT_HEADS, HEAD_DIM)
    k = z[..., ATT_WIDTH:2 * ATT_WIDTH].reshape(b, s, ATT_HEADS, HEAD_DIM)
    v = z[..., 2 * ATT_WIDTH:3 * ATT_WIDTH].reshape(b, s, ATT_HEADS, HEAD_DIM)
    u = z[..., 3 * ATT_WIDTH:]
    q = partial_rope(q, positions) * (HEAD_DIM ** -0.5)
    k = partial_rope(k, positions)
    att = dilated_attention(q, k, v).reshape(b, s, ATT_WIDTH)
    ssm = s5_mixer(u, a_re, a_im, log_dt, b_re, b_im, c_re, c_im, d_skip, w_glu)
    y = jnp.concatenate([att, ssm], axis=-1).astype(w_out.dtype)
    return (y @ w_out).astype(xn.dtype)


def odd_mixer(xn, w_in, w_out, conv_w, conv_b, w_r, b_r, w_i, b_i, lam):
    z = (xn @ w_in).astype(jnp.float32)
    h = rglru_mixer(z[..., :LRU_WIDTH], conv_w, conv_b, w_r, b_r, w_i, b_i, lam)
    y = (h * jax.nn.gelu(z[..., LRU_WIDTH:])).astype(w_out.dtype)
    return (y @ w_out).astype(xn.dtype)


def setup_inputs(seed: int = 0) -> dict:
    key = jax.random.key(seed)
    ks = iter(jax.random.split(key, 32))
    f32 = jnp.float32

    def nrm(shape, scale):
        return jax.random.normal(next(ks), shape, f32) * scale

    G, P, NC, BD = SSM_GROUPS, SSM_STATE, SSM_GROUP, LRU_BLOCK_DIM
    x = nrm((BATCH, SEQ, D_MODEL), 1.0)
    offset = jax.random.randint(next(ks), (BATCH, 1), 0, SEQ, dtype=jnp.int32)
    positions = offset + jnp.arange(SEQ, dtype=jnp.int32)[None, :]
    norm_mix_pre = 1.0 + nrm((DEPTH, D_MODEL), 0.05)
    norm_mix_post = 1.0 + nrm((DEPTH, D_MODEL), 0.05)
    norm_ffn_pre = 1.0 + nrm((DEPTH, D_MODEL), 0.05)
    norm_ffn_post = 1.0 + nrm((DEPTH, D_MODEL), 0.05)
    ev_w_in = nrm((N_EVEN, D_MODEL, EVEN_IN), D_MODEL ** -0.5)
    ev_w_out = nrm((N_EVEN, D_MODEL, D_MODEL), D_MODEL ** -0.5)
    s5_a_re = -0.5 * jnp.exp(nrm((N_EVEN, G, P), 0.02))
    s5_a_im = jnp.pi * jnp.arange(P, dtype=f32) + nrm((N_EVEN, G, P), 0.02)
    s5_log_dt = jax.random.uniform(next(ks), (N_EVEN, G), f32, math.log(1e-3), math.log(1e-1))
    s5_b_re = nrm((N_EVEN, G, P, NC), (2 * NC) ** -0.5)
    s5_b_im = nrm((N_EVEN, G, P, NC), (2 * NC) ** -0.5)
    s5_c_re = nrm((N_EVEN, G, NC, P), (2 * P) ** -0.5)
    s5_c_im = nrm((N_EVEN, G, NC, P), (2 * P) ** -0.5)
    s5_d = nrm((N_EVEN, G, NC), 1.0)
    s5_w_glu = nrm((N_EVEN, SSM_WIDTH, SSM_WIDTH), SSM_WIDTH ** -0.5)
    od_w_in = nrm((N_ODD, D_MODEL, 2 * LRU_WIDTH), D_MODEL ** -0.5)
    od_w_out = nrm((N_ODD, LRU_WIDTH, D_MODEL), LRU_WIDTH ** -0.5)
    rg_conv_w = nrm((N_ODD, CONV_WIDTH, LRU_WIDTH), CONV_WIDTH ** -0.5)
    rg_conv_b = nrm((N_ODD, LRU_WIDTH), 0.01)
    rg_w_r = nrm((N_ODD, LRU_BLOCKS, BD, BD), BD ** -0.5)
    rg_b_r = nrm((N_ODD, LRU_WIDTH), 0.01)
    rg_w_i = nrm((N_ODD, LRU_BLOCKS, BD, BD), BD ** -0.5)
    rg_b_i = nrm((N_ODD, LRU_WIDTH), 0.01)
    a0 = jax.random.uniform(next(ks), (N_ODD, LRU_WIDTH), f32, 0.9, 0.999)
    sig = a0 ** (1.0 / RG_C)
    rg_lam = jnp.log(sig) - jnp.log1p(-sig)
    ffn_w_gate = nrm((DEPTH, D_MODEL, FFN_HIDDEN), D_MODEL ** -0.5)
    ffn_w_up = nrm((DEPTH, D_MODEL, FFN_HIDDEN), D_MODEL ** -0.5)
    ffn_w_down = nrm((DEPTH, FFN_HIDDEN, D_MODEL), FFN_HIDDEN ** -0.5)
    return {'x': x, 'positions': positions,
            'norm_mix_pre': norm_mix_pre, 'norm_mix_post': norm_mix_post,
            'norm_ffn_pre': norm_ffn_pre, 'norm_ffn_post': norm_ffn_post,
            'ev_w_in': ev_w_in, 'ev_w_out': ev_w_out,
            's5_a_re': s5_a_re, 's5_a_im': s5_a_im, 's5_log_dt': s5_log_dt,
            's5_b_re': s5_b_re, 's5_b_im': s5_b_im, 's5_c_re': s5_c_re, 's5_c_im': s5_c_im,
            's5_d': s5_d, 's5_w_glu': s5_w_glu,
            'od_w_in': od_w_in, 'od_w_out': od_w_out,
            'rg_conv_w': rg_conv_w, 'rg_conv_b': rg_conv_b,
            'rg_w_r': rg_w_r, 'rg_b_r': rg_b_r, 'rg_w_i': rg_w_i, 'rg_b_i': rg_b_i, 'rg_lam': rg_lam,
            'ffn_w_gate': ffn_w_gate, 'ffn_w_up': ffn_w_up, 'ffn_w_down': ffn_w_down}


def reference(x, positions, norm_mix_pre, norm_mix_post, norm_ffn_pre, norm_ffn_post,
              ev_w_in, ev_w_out, s5_a_re, s5_a_im, s5_log_dt, s5_b_re, s5_b_im, s5_c_re, s5_c_im,
              s5_d, s5_w_glu, od_w_in, od_w_out, rg_conv_w, rg_conv_b, rg_w_r, rg_b_r, rg_w_i, rg_b_i,
              rg_lam, ffn_w_gate, ffn_w_up, ffn_w_down):
    for layer in range(DEPTH):
        hn = rms_norm(x, norm_mix_pre[layer])
        if layer % 2 == 0:
            e = layer // 2
            mix = even_mixer(hn, positions, ev_w_in[e], ev_w_out[e], s5_a_re[e], s5_a_im[e],
                             s5_log_dt[e], s5_b_re[e], s5_b_im[e], s5_c_re[e], s5_c_im[e],
                             s5_d[e], s5_w_glu[e])
        else:
            o = layer // 2
            mix = odd_mixer(hn, od_w_in[o], od_w_out[o], rg_conv_w[o], rg_conv_b[o],
                            rg_w_r[o], rg_b_r[o], rg_w_i[o], rg_b_i[o], rg_lam[o])
        x = x + rms_norm(mix, norm_mix_post[layer])
        hn = rms_norm(x, norm_ffn_pre[layer])
        ff = swiglu(hn, ffn_w_gate[layer], ffn_w_up[layer], ffn_w_down[layer])
        x = x + rms_norm(ff, norm_ffn_post[layer])
    return x
```

```cpp
#include <hip/hip_runtime.h>
#include <hip/hip_cooperative_groups.h>
#include <cstdio>
#include <cstdint>
namespace cg = cooperative_groups;

#ifndef N_LAUNCH_MODE
#define N_LAUNCH_MODE 0
#endif

#define LAS __attribute__((address_space(3)))
typedef unsigned short bf16_t;
typedef short bf16x8 __attribute__((ext_vector_type(8)));
typedef float f32x4 __attribute__((ext_vector_type(4)));
typedef unsigned u32x4 __attribute__((ext_vector_type(4)));
typedef unsigned u32x2 __attribute__((ext_vector_type(2)));

constexpr int MTOK = 65536, DM = 1024, SEQ = 2048, NBATCH = 32, FFH = 2816;
constexpr float NORM_EPS = 1e-6f;
constexpr float LOG2E = 1.4426950408889634f;
constexpr int NWAVES = 8, NTHREADS = 512;
constexpr int LDS_BYTES = 136 * 1024;

constexpr size_t MiB = 1u << 20;
constexpr size_t WS_CTL = 0;
constexpr size_t WS_W_IN0 = 1 * MiB, WS_W_OUT0 = 5 * MiB, WS_W_GLU = 7 * MiB, WS_W_IN1 = 8 * MiB, WS_W_OUT1 = 12 * MiB, WS_W_GATE = 14 * MiB;
constexpr size_t WS_W_UP0 = 15 * MiB, WS_W_UP1 = 26 * MiB, WS_W_DN0 = 37 * MiB, WS_W_DN1 = 43 * MiB;
constexpr size_t WS_ROPE = 49 * MiB;
constexpr size_t WS_S5TAB = 53 * MiB;
constexpr size_t S5_ABAR = 0, S5_BM = 16384, S5_CM = 16384 + 262144, S5_SP = 16384 + 262144 + 131072;
constexpr size_t WS_HN = 64 * MiB, WS_Z = 192 * MiB, WS_YC = 448 * MiB, WS_MIX = 576 * MiB, WS_PO = 704 * MiB, WS_PM = 896 * MiB, WS_PL = 902 * MiB, WS_Y5 = 908 * MiB;
constexpr size_t WS_HID = 192 * MiB;
constexpr size_t WS_XC = 448 * MiB, WS_BB = 576 * MiB, WS_Y1 = 704 * MiB, WS_LA = 832 * MiB;
constexpr size_t WS_END = 972 * MiB;

struct Args { const float* in[29]; float* out; unsigned char* ws; int ph_lo, ph_hi; };

__device__ __forceinline__ unsigned f2bf(float f) { unsigned u = __builtin_bit_cast(unsigned, f); return (u + 0x7fffu + ((u >> 16) & 1u)) >> 16; }
__device__ __forceinline__ unsigned pk2(float lo, float hi) { return f2bf(lo) | (f2bf(hi) << 16); }
__device__ __forceinline__ float bf2f(unsigned short h) { return __builtin_bit_cast(float, (unsigned)h << 16); }
__device__ __forceinline__ float bflo(unsigned w) { return __builtin_bit_cast(float, w << 16); }
__device__ __forceinline__ float bfhi(unsigned w) { return __builtin_bit_cast(float, w & 0xffff0000u); }
__device__ __forceinline__ float fast_exp2(float x) { return __builtin_amdgcn_exp2f(x); }
__device__ __forceinline__ float fast_rcp(float x) { return __builtin_amdgcn_rcpf(x); }
__device__ __forceinline__ float sigmoidf_(float x) { return fast_rcp(1.f + fast_exp2(-x * LOG2E)); }
__device__ __forceinline__ float gelu_tanh(float x) { const float u = 0.7978845608028654f * (x + 0.044715f * x * x * x); return x * sigmoidf_(2.f * u); }
__device__ __forceinline__ float wave_sum(float v) {
#pragma unroll
    for (int o = 1; o < 64; o <<= 1) v += __shfl_xor(v, o);
    return v;
}
#define LDS_WAIT() asm volatile("s_waitcnt lgkmcnt(0)" ::: "memory")

namespace pg8 {
constexpr int BM = 256, BK = 64, HALF = 128, HTB = HALF * BK * 2, STAGE_BYTES = 8 * HTB, NXCD = 8, WGM = 8;
__host__ __device__ __forceinline__ int lds_byte(int r, int c) { const int st = (r >> 4) * 2 + (c >> 5), rr = r & 15, cc = c & 31, ob = rr * 64 + cc * 2; return st * 1024 + (ob ^ (((ob >> 9) & 1) << 5)); }
__host__ __device__ __forceinline__ void stage_rc(int b, int& R, int& C) { const int st = b / 1024, sb = b % 1024, swz = sb ^ (((sb >> 9) & 1) << 5); R = (st >> 1) * 16 + swz / 64; C = (st & 1) * 32 + (swz % 64) / 2; }
__host__ __device__ __forceinline__ int perm32(int rho) { const int n = rho >> 4, i = rho & 15; return 8 * (i >> 2) + 4 * n + (i & 3); }
struct Unit { int pm, pn; };
struct Gemm { const bf16_t* A; const bf16_t* Bt; int M, N, K, lda, grp; };
struct StaticOrder {
    int nM, nN, nwg, G, c;
    __host__ __device__ void init(int M, int N, int G_, int c_) { nM = M / BM; nN = N / BM; nwg = nM * nN; G = G_; c = c_; }
    __host__ __device__ bool next(int i, Unit& u) const {
        const long L = (long)i * G + c; if (L >= nwg) return false;
        int wgid = (int)L; { const int q = nwg / NXCD, r = nwg % NXCD, xcd = wgid % NXCD, off = wgid / NXCD; wgid = (xcd < r ? xcd * (q + 1) : r * (q + 1) + (xcd - r) * q) + off; }
        const int nig = WGM * nN, gid = wgid / nig, fm = gid * WGM, gsz = (nM - fm) < WGM ? (nM - fm) : WGM;
        u.pm = fm + ((wgid % nig) % gsz); u.pn = (wgid % nig) / gsz; return true;
    }
};
template <class Epi>
__device__ __forceinline__ void gemm_phase(LAS unsigned char* lds, const Gemm g, const StaticOrder& S, const Epi& E) {
    const int tid = threadIdx.x, wid = __builtin_amdgcn_readfirstlane(tid >> 6), lane = tid & 63, wr = wid >> 2, wc = wid & 3, fr = lane & 15, fq = lane >> 4;
    const int K = g.K, nt = K / BK, lda = g.lda;
    unsigned voffA[2], voffB[2];
#pragma unroll
    for (int i = 0; i < 2; ++i) { int R, C; stage_rc(tid * 16 + i * 8192, R, C); const int Rb = (R & ~31) + perm32(R & 31);
        voffA[i] = (unsigned)(R * lda + C) * 2u; voffB[i] = (unsigned)(Rb * K + C) * 2u; }
    const size_t kstep = (size_t)(BK * 2);
    const size_t hstepA = (size_t)HALF * lda * 2, hstepB = (size_t)HALF * K * 2;
    const size_t tstepA = 2 * hstepA, tstepB = 2 * hstepB;
    const unsigned ldsw = (unsigned)wid * 1024u;
    const int aoff = lds_byte(wr * 64 + fr, fq * 8), boff = lds_byte(wc * 32 + fr, fq * 8);
#define PG8_SA(b, h) (((b) * 2 + (h)) * HTB)
#define PG8_SB(b, h) ((4 + (b) * 2 + (h)) * HTB)
#define PG8_STAGE(bufoff, gbase, voff) do { _Pragma("unroll") for (int _i = 0; _i < 2; ++_i) \
        __builtin_amdgcn_global_load_lds((const unsigned*)((const char*)(gbase) + (voff)[_i]), (LAS unsigned*)(lds + (bufoff) + ldsw + _i * 8192), 16, 0, 0); } while (0)
#define PG8_LDA(dst, b, h) do { _Pragma("unroll") for (int m = 0; m < 4; ++m) _Pragma("unroll") for (int k = 0; k < 2; ++k) dst[m][k] = *(const LAS bf16x8*)(lds + PG8_SA(b, h) + aoff + m * 2048 + k * 1024); } while (0)
#define PG8_LDB(dst, b, h) do { _Pragma("unroll") for (int n = 0; n < 2; ++n) _Pragma("unroll") for (int k = 0; k < 2; ++k) dst[n][k] = *(const LAS bf16x8*)(lds + PG8_SB(b, h) + boff + n * 2048 + k * 1024); } while (0)
#define PG8_MMA(ai, bj, At, Bt) do { __builtin_amdgcn_s_setprio(1); _Pragma("unroll") for (int m = 0; m < 4; ++m) _Pragma("unroll") for (int n = 0; n < 2; ++n) _Pragma("unroll") for (int k = 0; k < 2; ++k) \
        acc[ai][bj][m][n] = __builtin_amdgcn_mfma_f32_16x16x32_bf16(Bt[n][k], At[m][k], acc[ai][bj][m][n], 0, 0, 0); __builtin_amdgcn_s_setprio(0); } while (0)
#define PG8_WAIT_V(n) asm volatile("s_waitcnt vmcnt(" #n ")" ::: "memory")
#define PG8_WAIT_L(n) asm volatile("s_waitcnt lgkmcnt(" #n ")" ::: "memory")
#define PG8_BAR __builtin_amdgcn_s_barrier()
#define PG8_SCHED __builtin_amdgcn_sched_barrier(0)
    Unit cur, nxt; int ui = 0;
    if (!S.next(0, cur)) return;
    f32x4 acc[2][2][4][2];
#pragma unroll
    for (int a = 0; a < 2; ++a)
#pragma unroll
        for (int b = 0; b < 2; ++b)
#pragma unroll
            for (int m = 0; m < 4; ++m)
#pragma unroll
                for (int n = 0; n < 2; ++n) acc[a][b][m][n] = (f32x4){0.f, 0.f, 0.f, 0.f};
    bf16x8 At[4][2], B0[2][2], B1[2][2];
    const char* cA = (const char*)g.A + (size_t)cur.pm * tstepA + (g.grp ? (size_t)(cur.pn >> 1) * K * 2 : 0); const char* cB = (const char*)g.Bt + (size_t)cur.pn * tstepB;
    PG8_STAGE(PG8_SB(0, 0), cB, voffB); PG8_STAGE(PG8_SB(0, 1), cB + hstepB, voffB); PG8_STAGE(PG8_SA(0, 0), cA, voffA); PG8_STAGE(PG8_SA(0, 1), cA + hstepA, voffA);
    if (wr == 1) PG8_BAR;
    PG8_WAIT_V(2); PG8_BAR;
    PG8_STAGE(PG8_SB(1, 0), cB + kstep, voffB); PG8_STAGE(PG8_SA(1, 0), cA + kstep, voffA); PG8_STAGE(PG8_SB(1, 1), cB + hstepB + kstep, voffB);
    PG8_WAIT_V(6); PG8_BAR;
    for (;;) {
        const bool has_next = S.next(ui + 1, nxt);
        const char* nA = has_next ? (const char*)g.A + (size_t)nxt.pm * tstepA + (g.grp ? (size_t)(nxt.pn >> 1) * K * 2 : 0) : cA; const char* nB = has_next ? (const char*)g.Bt + (size_t)nxt.pn * tstepB : cB;
        for (int t = 0; t < nt; t += 2) {
            const bool last = (t == nt - 2);
            const char* a1 = cA + (size_t)(t + 1) * kstep;
            const char* a2 = last ? nA : cA + (size_t)(t + 2) * kstep; const char* b2 = last ? nB : cB + (size_t)(t + 2) * kstep;
            const char* a3 = a2 + kstep; const char* b3 = b2 + kstep;
            PG8_LDB(B0, 0, 0); PG8_LDB(B1, 0, 1); PG8_SCHED; PG8_LDA(At, 0, 0); PG8_STAGE(PG8_SA(1, 1), a1 + hstepA, voffA);
            PG8_WAIT_V(8); PG8_WAIT_L(0); PG8_BAR; PG8_MMA(0, 0, At, B0); PG8_MMA(0, 1, At, B1); PG8_BAR; PG8_SCHED;
            PG8_LDA(At, 0, 1); PG8_STAGE(PG8_SB(0, 0), b2, voffB); PG8_STAGE(PG8_SB(0, 1), b2 + hstepB, voffB); PG8_STAGE(PG8_SA(0, 0), a2, voffA);
            PG8_WAIT_V(8); PG8_WAIT_L(0); PG8_BAR; PG8_MMA(1, 0, At, B0); PG8_MMA(1, 1, At, B1); PG8_BAR; PG8_SCHED;
            PG8_LDB(B0, 1, 0); PG8_LDB(B1, 1, 1); PG8_SCHED; PG8_LDA(At, 1, 0); PG8_STAGE(PG8_SA(0, 1), a2 + hstepA, voffA);
            PG8_WAIT_V(8); PG8_WAIT_L(0); PG8_BAR; PG8_MMA(0, 0, At, B0); PG8_MMA(0, 1, At, B1); PG8_BAR; PG8_SCHED;
            PG8_LDA(At, 1, 1); PG8_STAGE(PG8_SB(1, 0), b3, voffB); PG8_STAGE(PG8_SB(1, 1), b3 + hstepB, voffB); PG8_STAGE(PG8_SA(1, 0), a3, voffA);
            PG8_WAIT_V(8); PG8_WAIT_L(0); PG8_BAR; PG8_MMA(1, 0, At, B0); PG8_MMA(1, 1, At, B1); PG8_BAR; PG8_SCHED;
        }
        if (wr == 0) PG8_BAR;
        E(acc, cur, wr, wc, fr, fq);
        if (!has_next) break;
#pragma unroll
        for (int a = 0; a < 2; ++a)
#pragma unroll
            for (int b = 0; b < 2; ++b)
#pragma unroll
                for (int m = 0; m < 4; ++m)
#pragma unroll
                    for (int n = 0; n < 2; ++n) acc[a][b][m][n] = (f32x4){0.f, 0.f, 0.f, 0.f};
        cur = nxt; cA = nA; cB = nB; ++ui;
        if (wr == 1) PG8_BAR;
    }
    PG8_WAIT_V(0);
    PG8_BAR;
#undef PG8_SA
#undef PG8_SB
#undef PG8_STAGE
#undef PG8_LDA
#undef PG8_LDB
#undef PG8_MMA
#undef PG8_WAIT_V
#undef PG8_WAIT_L
#undef PG8_BAR
#undef PG8_SCHED
}
typedef f32x4 AccT[2][2][4][2];

__device__ __forceinline__ void st8(bf16_t* p, f32x4 v0, f32x4 v1) {
    u32x4 w; w.x = pk2(v0[0], v0[1]); w.y = pk2(v0[2], v0[3]); w.z = pk2(v1[0], v1[1]); w.w = pk2(v1[2], v1[3]); *(u32x4*)p = w;
}
struct EpiPlain {
    bf16_t* O; int ldc;
    __device__ __forceinline__ void operator()(const AccT& acc, const Unit& u, int wr, int wc, int fr, int fq) const {
        const int row0 = u.pm * BM + wr * 64 + fr, col0 = u.pn * BM + wc * 32 + 8 * fq;
#pragma unroll
        for (int ai = 0; ai < 2; ++ai)
#pragma unroll
            for (int m = 0; m < 4; ++m) { bf16_t* rowp = O + (size_t)(row0 + ai * HALF + m * 16) * ldc + col0;
#pragma unroll
                for (int bj = 0; bj < 2; ++bj) st8(rowp + bj * HALF, acc[ai][bj][m][0], acc[ai][bj][m][1]); }
    }
};
struct EpiRope {
    bf16_t* Z; const float* rope;
    __device__ __forceinline__ void operator()(const AccT& acc, const Unit& u, int wr, int wc, int fr, int fq) const {
        const int row0 = u.pm * BM + wr * 64 + fr, col0 = u.pn * BM + wc * 32 + 8 * fq;
        const bool ropew = (u.pn < 4) && !(wc & 1); const float sc = (u.pn < 2) ? 0.125f : 1.f;
#pragma unroll
        for (int ai = 0; ai < 2; ++ai)
#pragma unroll
            for (int m = 0; m < 4; ++m) { const int row = row0 + ai * HALF + m * 16; bf16_t* rowp = Z + (size_t)row * 2048 + col0;
                f32x4 c0 = {1.f, 1.f, 1.f, 1.f}, c1 = c0, s0 = {0.f, 0.f, 0.f, 0.f}, s1 = s0;
                if (ropew && fq < 2) { const f32x4* rp = (const f32x4*)(rope + (size_t)row * 16); c0 = rp[0]; c1 = rp[1]; s0 = rp[2]; s1 = rp[3]; if (fq == 0) { s0 = -s0; s1 = -s1; } }
#pragma unroll
                for (int bj = 0; bj < 2; ++bj) { f32x4 v0 = acc[ai][bj][m][0], v1 = acc[ai][bj][m][1];
                    if (ropew) { f32x4 p0, p1;
#pragma unroll
                        for (int i = 0; i < 4; ++i) { p0[i] = __shfl_xor(v0[i], 16); p1[i] = __shfl_xor(v1[i], 16); }
                        v0 = v0 * c0 + p0 * s0; v1 = v1 * c1 + p1 * s1; }
                    v0 = v0 * sc; v1 = v1 * sc; st8(rowp + bj * HALF, v0, v1); } }
    }
};
struct EpiGlu {
    const bf16_t* Y; bf16_t* O;
    __device__ __forceinline__ void operator()(const AccT& acc, const Unit& u, int wr, int wc, int fr, int fq) const {
        const int row0 = u.pm * BM + wr * 64 + fr, col0 = u.pn * BM + wc * 32 + 8 * fq;
#pragma unroll
        for (int ai = 0; ai < 2; ++ai)
#pragma unroll
            for (int m = 0; m < 4; ++m) { const int row = row0 + ai * HALF + m * 16;
#pragma unroll
                for (int bj = 0; bj < 2; ++bj) { const int col = col0 + bj * HALF; const u32x4 yw = *(const u32x4*)(Y + (size_t)row * 512 + col);
                    f32x4 a0 = acc[ai][bj][m][0], a1 = acc[ai][bj][m][1], v0, v1;
                    v0[0] = bflo(yw.x) * sigmoidf_(a0[0]); v0[1] = bfhi(yw.x) * sigmoidf_(a0[1]); v0[2] = bflo(yw.y) * sigmoidf_(a0[2]); v0[3] = bfhi(yw.y) * sigmoidf_(a0[3]);
                    v1[0] = bflo(yw.z) * sigmoidf_(a1[0]); v1[1] = bfhi(yw.z) * sigmoidf_(a1[1]); v1[2] = bflo(yw.w) * sigmoidf_(a1[2]); v1[3] = bfhi(yw.w) * sigmoidf_(a1[3]);
                    st8(O + (size_t)row * 1024 + 512 + col, v0, v1); } }
    }
};
struct EpiSwiGlu {
    bf16_t* O;
    __device__ __forceinline__ void operator()(const AccT& acc, const Unit& u, int wr, int wc, int fr, int fq) const {
        const int row0 = u.pm * BM + wr * 64 + fr, col0 = u.pn * HALF + wc * 32 + 8 * fq;
#pragma unroll
        for (int ai = 0; ai < 2; ++ai)
#pragma unroll
            for (int m = 0; m < 4; ++m) { const int row = row0 + ai * HALF + m * 16; f32x4 v[2];
#pragma unroll
                for (int n = 0; n < 2; ++n)
#pragma unroll
                    for (int i = 0; i < 4; ++i) { const float gt = acc[ai][0][m][n][i], up = acc[ai][1][m][n][i]; v[n][i] = gt * sigmoidf_(gt) * up; }
                st8(O + (size_t)row * FFH + col0, v[0], v[1]); }
    }
};
struct EpiIn1 {
    bf16_t* Z;
    __device__ __forceinline__ void operator()(const AccT& acc, const Unit& u, int wr, int wc, int fr, int fq) const {
        const int row0 = u.pm * BM + wr * 64 + fr, col0 = u.pn * BM + wc * 32 + 8 * fq; const bool act = u.pn >= 4;
#pragma unroll
        for (int ai = 0; ai < 2; ++ai)
#pragma unroll
            for (int m = 0; m < 4; ++m) { bf16_t* rowp = Z + (size_t)(row0 + ai * HALF + m * 16) * 2048 + col0;
#pragma unroll
                for (int bj = 0; bj < 2; ++bj) { f32x4 v0 = acc[ai][bj][m][0], v1 = acc[ai][bj][m][1];
                    if (act) {
#pragma unroll
                        for (int i = 0; i < 4; ++i) { v0[i] = gelu_tanh(v0[i]); v1[i] = gelu_tanh(v1[i]); } }
                    st8(rowp + bj * HALF, v0, v1); } }
    }
};
struct EpiGates {
    const bf16_t* XC; bf16_t* LA; bf16_t* BB; const float* b_r; const float* b_i; const float* sp;
    __device__ __forceinline__ void operator()(const AccT& acc, const Unit& u, int wr, int wc, int fr, int fq) const {
        const int row0 = u.pm * BM + wr * 64 + fr, c0 = (u.pn >> 1) * 256 + (u.pn & 1) * 128 + wc * 32 + 8 * fq;
#pragma unroll
        for (int ai = 0; ai < 2; ++ai)
#pragma unroll
            for (int m = 0; m < 4; ++m) { const int row = row0 + ai * HALF + m * 16; const u32x4 xw = *(const u32x4*)(XC + (size_t)row * 1024 + c0);
                const float xv[8] = {bflo(xw.x), bfhi(xw.x), bflo(xw.y), bfhi(xw.y), bflo(xw.z), bfhi(xw.z), bflo(xw.w), bfhi(xw.w)};
                f32x4 la[2], bb[2];
#pragma unroll
                for (int n = 0; n < 2; ++n) { const f32x4 br = *(const f32x4*)(b_r + c0 + 4 * n), bi = *(const f32x4*)(b_i + c0 + 4 * n), spv = *(const f32x4*)(sp + c0 + 4 * n);
#pragma unroll
                    for (int i = 0; i < 4; ++i) { const float gr = sigmoidf_(acc[ai][0][m][n][i] + br[i]), gi = sigmoidf_(acc[ai][1][m][n][i] + bi[i]);
                        const float l = -8.f * gr * spv[i]; const float a2 = fast_exp2(2.f * l * LOG2E); const float mult = sqrtf(fmaxf(1.f - a2, 0.f));
                        la[n][i] = l; bb[n][i] = mult * gi * xv[4 * n + i]; } }
                st8(LA + (size_t)row * 1024 + c0, la[0], la[1]); st8(BB + (size_t)row * 1024 + c0, bb[0], bb[1]); }
    }
};
}

__device__ __forceinline__ void transpose_item(const float* W, int ld, int K, bf16_t* dst, int k0, LAS float* scr, int lane) {
#pragma unroll 8
    for (int i = 0; i < 32; ++i) { const int kk = 2 * i + (lane >> 5); scr[kk * 33 + (lane & 31)] = W[(size_t)(k0 + kk) * ld + (lane & 31)]; }
    LDS_WAIT();
    const int c = lane & 7;
#pragma unroll
    for (int j = 0; j < 4; ++j) { const int n = (lane >> 3) + 8 * j; const LAS float* s = scr + (8 * c) * 33 + n;
        u32x4 o; o.x = pk2(s[0 * 33], s[1 * 33]); o.y = pk2(s[2 * 33], s[3 * 33]); o.z = pk2(s[4 * 33], s[5 * 33]); o.w = pk2(s[6 * 33], s[7 * 33]);
        *(u32x4*)(dst + (size_t)n * K + k0 + 8 * c) = o; }
    LDS_WAIT();
}
__device__ __forceinline__ void sincos_rr(float ang, float& s, float& c) {
    const double r = (double)ang * 0.15915494309189535; const double fr = r - __builtin_rint(r); const float f = (float)fr;
    s = __builtin_amdgcn_sinf(f); c = __builtin_amdgcn_cosf(f);
}
__device__ __forceinline__ void rms_row_to_bf16(const float* xrow, const float* g, bf16_t* orow, int lane) {
    const f32x4* xr = (const f32x4*)xrow + lane; const f32x4* gr = (const f32x4*)g + lane;
    f32x4 v[4]; float s = 0.f;
#pragma unroll
    for (int j = 0; j < 4; ++j) { v[j] = xr[64 * j]; s += (v[j].x * v[j].x + v[j].y * v[j].y) + (v[j].z * v[j].z + v[j].w * v[j].w); }
    const float rstd = 1.f / sqrtf(wave_sum(s) * (1.f / DM) + NORM_EPS);
    u32x2* o8 = (u32x2*)orow + lane;
#pragma unroll
    for (int j = 0; j < 4; ++j) { const f32x4 gg = gr[64 * j]; u32x2 w; w.x = pk2(v[j].x * rstd * gg.x, v[j].y * rstd * gg.y); w.y = pk2(v[j].z * rstd * gg.z, v[j].w * rstd * gg.w); o8[64 * j] = w; }
}
__device__ __forceinline__ void resnorm_row(const float* xin, const bf16_t* mix, const float* gpost, float* xout, const float* gpre, bf16_t* hn, int lane) {
    const f32x4* xr = (const f32x4*)xin + lane; const u32x2* mr = (const u32x2*)mix + lane; const f32x4* gp = (const f32x4*)gpost + lane;
    f32x4 v[4]; float s = 0.f;
#pragma unroll
    for (int j = 0; j < 4; ++j) { const u32x2 w = mr[64 * j]; v[j] = (f32x4){bflo(w.x), bfhi(w.x), bflo(w.y), bfhi(w.y)}; s += (v[j].x * v[j].x + v[j].y * v[j].y) + (v[j].z * v[j].z + v[j].w * v[j].w); }
    const float rstd = 1.f / sqrtf(wave_sum(s) * (1.f / DM) + NORM_EPS);
    float s2 = 0.f;
#pragma unroll
    for (int j = 0; j < 4; ++j) { const f32x4 gg = gp[64 * j]; v[j] = xr[64 * j] + v[j] * rstd * gg; s2 += (v[j].x * v[j].x + v[j].y * v[j].y) + (v[j].z * v[j].z + v[j].w * v[j].w);
        ((f32x4*)xout + lane)[64 * j] = v[j]; }
    if (hn) { const float rstd2 = 1.f / sqrtf(wave_sum(s2) * (1.f / DM) + NORM_EPS); const f32x4* gq = (const f32x4*)gpre + lane; u32x2* o8 = (u32x2*)hn + lane;
#pragma unroll
        for (int j = 0; j < 4; ++j) { const f32x4 gg = gq[64 * j]; u32x2 w; w.x = pk2(v[j].x * rstd2 * gg.x, v[j].y * rstd2 * gg.y); w.y = pk2(v[j].z * rstd2 * gg.z, v[j].w * rstd2 * gg.w); o8[64 * j] = w; } }
}

constexpr int AT_KPITCH = 144, AT_VPITCH = 528, AT_VOFF = 256 * AT_KPITCH;
__device__ __forceinline__ void attn_unit(const bf16_t* Z, bf16_t* PO, float* PM, float* PL, LAS unsigned char* lds, int unit, int tid, int wave, int lane) {
    const int sub = unit & 15, br = (unit >> 4) % 3, bh = unit / 48, h = bh & 7, b = bh >> 3;
    const int dil = br == 0 ? 1 : (br == 1 ? 4 : 16), nb = 16 / dil, rho = sub / nb, n = sub % nb;
    const bf16_t* Zb = Z + (size_t)b * SEQ * 2048;
    __syncthreads();
#pragma unroll
    for (int it = 0; it < 4; ++it) { const int idx = tid + it * NTHREADS, kb = idx >> 3, ch = idx & 7;
        int sidx = n * 128 - 128 + kb; if (sidx < 0) sidx = 0; const int tok = sidx * dil + rho;
        const bf16_t* rowp = Zb + (size_t)tok * 2048 + h * 64 + ch * 8;
        const u32x4 kv = *(const u32x4*)(rowp + 512); const u32x4 vv = *(const u32x4*)(rowp + 1024);
        *(LAS u32x4*)(lds + kb * AT_KPITCH + ch * 16) = kv;
        LAS bf16_t* vt = (LAS bf16_t*)(lds + AT_VOFF) + (ch * 8) * (AT_VPITCH / 2) + kb;
        vt[0 * (AT_VPITCH / 2)] = (bf16_t)(vv.x & 0xffff); vt[1 * (AT_VPITCH / 2)] = (bf16_t)(vv.x >> 16);
        vt[2 * (AT_VPITCH / 2)] = (bf16_t)(vv.y & 0xffff); vt[3 * (AT_VPITCH / 2)] = (bf16_t)(vv.y >> 16);
        vt[4 * (AT_VPITCH / 2)] = (bf16_t)(vv.z & 0xffff); vt[5 * (AT_VPITCH / 2)] = (bf16_t)(vv.z >> 16);
        vt[6 * (AT_VPITCH / 2)] = (bf16_t)(vv.w & 0xffff); vt[7 * (AT_VPITCH / 2)] = (bf16_t)(vv.w >> 16); }
    const int q = lane & 15, kq = lane >> 4, qi = 16 * wave + q;
    const int tokq = (n * 128 + qi) * dil + rho;
    const bf16_t* qrow = Zb + (size_t)tokq * 2048 + h * 64;
    const bf16x8 qf0 = *(const bf16x8*)(qrow + 8 * kq), qf1 = *(const bf16x8*)(qrow + 32 + 8 * kq);
    __syncthreads();
    f32x4 o[4];
#pragma unroll
    for (int mm = 0; mm < 4; ++mm) o[mm] = (f32x4){0.f, 0.f, 0.f, 0.f};
    float mrun = -1e30f, lrun = 0.f;
    const int kstart = (16 * wave < 96) ? 16 * wave : 96;
    for (int p = 0; p < 5; ++p) {
        const int ks = kstart + 32 * p;
        if (n == 0 && ks + 32 <= 128) continue;
        if (ks + 31 < 16 * wave) continue;
        const LAS unsigned char* kp = lds + (ks + q) * AT_KPITCH + kq * 16;
        const bf16x8 k00 = *(const LAS bf16x8*)(kp), k01 = *(const LAS bf16x8*)(kp + 64);
        const bf16x8 k10 = *(const LAS bf16x8*)(kp + 16 * AT_KPITCH), k11 = *(const LAS bf16x8*)(kp + 16 * AT_KPITCH + 64);
        f32x4 s0 = {0.f, 0.f, 0.f, 0.f}, s1 = {0.f, 0.f, 0.f, 0.f};
        s0 = __builtin_amdgcn_mfma_f32_16x16x32_bf16(k00, qf0, s0, 0, 0, 0); s0 = __builtin_amdgcn_mfma_f32_16x16x32_bf16(k01, qf1, s0, 0, 0, 0);
        s1 = __builtin_amdgcn_mfma_f32_16x16x32_bf16(k10, qf0, s1, 0, 0, 0); s1 = __builtin_amdgcn_mfma_f32_16x16x32_bf16(k11, qf1, s1, 0, 0, 0);
        float sv[8]; float mx = -1e30f;
#pragma unroll
        for (int i = 0; i < 8; ++i) { const int kb = ks + (i >> 2) * 16 + 4 * kq + (i & 3); const bool ok = (kb >= qi) && (kb <= qi + 128) && (n * 128 + kb >= 128);
            const float sraw = (i < 4) ? s0[i & 3] : s1[i & 3]; sv[i] = ok ? sraw * LOG2E : -1e30f; mx = fmaxf(mx, sv[i]); }
        mx = fmaxf(mx, __shfl_xor(mx, 16)); mx = fmaxf(mx, __shfl_xor(mx, 32));
        const float mn = fmaxf(mrun, mx); const float alpha = fast_exp2(mrun - mn);
        float ps = 0.f; float pv[8];
#pragma unroll
        for (int i = 0; i < 8; ++i) { pv[i] = (sv[i] > -1e29f) ? fast_exp2(sv[i] - mn) : 0.f; ps += pv[i]; }
        ps += __shfl_xor(ps, 16); ps += __shfl_xor(ps, 32);
        lrun = lrun * alpha + ps; mrun = mn;
        u32x4 pw; pw.x = pk2(pv[0], pv[1]); pw.y = pk2(pv[2], pv[3]); pw.z = pk2(pv[4], pv[5]); pw.w = pk2(pv[6], pv[7]);
        const bf16x8 pf = __builtin_bit_cast(bf16x8, pw);
#pragma unroll
        for (int mm = 0; mm < 4; ++mm) { const LAS unsigned char* vp = lds + AT_VOFF + (16 * mm + q) * AT_VPITCH + (ks + 4 * kq) * 2;
            const u32x2 lo = *(const LAS u32x2*)vp, hi = *(const LAS u32x2*)(vp + 32);
            u32x4 vw; vw.x = lo.x; vw.y = lo.y; vw.z = hi.x; vw.w = hi.y;
            o[mm] = o[mm] * alpha;
            o[mm] = __builtin_amdgcn_mfma_f32_16x16x32_bf16(__builtin_bit_cast(bf16x8, vw), pf, o[mm], 0, 0, 0); }
    }
    const float inv = 1.f / lrun; const size_t row = (size_t)b * SEQ + tokq;
    bf16_t* orow = PO + ((size_t)br * MTOK + row) * 512 + h * 64 + 4 * kq;
#pragma unroll
    for (int mm = 0; mm < 4; ++mm) { u32x2 w; w.x = pk2(o[mm][0] * inv, o[mm][1] * inv); w.y = pk2(o[mm][2] * inv, o[mm][3] * inv); *(u32x2*)(orow + 16 * mm) = w; }
    if (kq == 0) { PM[((size_t)br * MTOK + row) * 8 + h] = mrun; PL[((size_t)br * MTOK + row) * 8 + h] = lrun; }
}

constexpr int S5_WAVE_BYTES = 12544;
__device__ __forceinline__ void s5_unit(const bf16_t* Z, const unsigned char* tab, const float* dskip, bf16_t* Y5, LAS unsigned char* lds, int unit, int wave, int lane) {
    const int b = unit >> 2, g = (unit & 3) * 8 + wave;
    LAS float* bus = (LAS float*)(lds + wave * S5_WAVE_BYTES);
    LAS bf16_t* hs = (LAS bf16_t*)(lds + wave * S5_WAVE_BYTES + 8192);
    const int n = lane & 15, kg = lane >> 4;
    const bf16_t* BMt = (const bf16_t*)(tab + S5_BM); const bf16_t* CMt = (const bf16_t*)(tab + S5_CM); const float* AB = (const float*)(tab + S5_ABAR);
    bf16x8 bm[8], cm[4];
#pragma unroll
    for (int nt = 0; nt < 8; ++nt) bm[nt] = *(const bf16x8*)(BMt + ((size_t)(g * 128 + 16 * nt + n)) * 32 + 8 * kg);
#pragma unroll
    for (int kk = 0; kk < 4; ++kk) cm[kk] = *(const bf16x8*)(CMt + ((size_t)(g * 16 + n)) * 128 + 32 * kk + 8 * kg);
    const float dsk = dskip[g * 16 + n];
    const float ar = AB[(g * 64 + lane) * 2], ai = AB[(g * 64 + lane) * 2 + 1];
    float hr = 0.f, hi = 0.f;
    const bf16_t* ub = Z + (size_t)b * SEQ * 2048 + 1536 + g * 16;
    bf16_t* yb = Y5 + (size_t)b * SEQ * 512 + g * 16 + n;
    for (int t0 = 0; t0 < SEQ; t0 += 16) {
        bf16x8 uf = {0, 0, 0, 0, 0, 0, 0, 0};
        if (kg < 2) uf = *(const bf16x8*)(ub + (size_t)(t0 + n) * 2048 + 8 * kg);
#pragma unroll
        for (int nt = 0; nt < 8; ++nt) { f32x4 d = {0.f, 0.f, 0.f, 0.f}; d = __builtin_amdgcn_mfma_f32_16x16x32_bf16(uf, bm[nt], d, 0, 0, 0);
#pragma unroll
            for (int i = 0; i < 4; ++i) bus[(4 * kg + i) * 128 + 16 * nt + n] = d[i]; }
        LDS_WAIT();
#pragma unroll
        for (int t = 0; t < 16; ++t) { const float bre = bus[t * 128 + lane], bim = bus[t * 128 + 64 + lane];
            const float nr = ar * hr - ai * hi + bre, ni = ar * hi + ai * hr + bim; hr = nr; hi = ni;
            hs[t * 136 + lane] = (bf16_t)f2bf(hr); hs[t * 136 + 64 + lane] = (bf16_t)f2bf(hi); }
        LDS_WAIT();
        f32x4 y = {0.f, 0.f, 0.f, 0.f};
#pragma unroll
        for (int kk = 0; kk < 4; ++kk) { const bf16x8 hf = *(const LAS bf16x8*)(hs + n * 136 + 32 * kk + 8 * kg); y = __builtin_amdgcn_mfma_f32_16x16x32_bf16(hf, cm[kk], y, 0, 0, 0); }
#pragma unroll
        for (int i = 0; i < 4; ++i) { const int t = t0 + 4 * kg + i; const float u = bf2f(ub[(size_t)t * 2048 + n]); const float v = gelu_tanh(y[i] + dsk * u); yb[(size_t)t * 512] = (bf16_t)f2bf(v); }
        LDS_WAIT();
    }
}

__global__ void __launch_bounds__(NTHREADS, 2) mega(Args a) {
    extern __shared__ __attribute__((aligned(16))) unsigned char lds_raw[];
    LAS unsigned char* lds = (LAS unsigned char*)lds_raw;
    cg::grid_group grid = cg::this_grid();
    const int tid = threadIdx.x, lane = tid & 63, wave = __builtin_amdgcn_readfirstlane(tid >> 6);
    const int G = gridDim.x, bx = blockIdx.x;
    const int gw = bx * NWAVES + wave, NGW = G * NWAVES;
    const int gt = bx * NTHREADS + tid, NGT = G * NTHREADS;
    unsigned char* ws = a.ws;
    const float* x_in = a.in[0]; const int* positions = (const int*)a.in[1];
    const float *g_mix_pre = a.in[2], *g_mix_post = a.in[3], *g_ffn_pre = a.in[4], *g_ffn_post = a.in[5];
    bf16_t* HN = (bf16_t*)(ws + WS_HN); bf16_t* Z = (bf16_t*)(ws + WS_Z); bf16_t* YC = (bf16_t*)(ws + WS_YC); bf16_t* MIX = (bf16_t*)(ws + WS_MIX);
    bf16_t* PO = (bf16_t*)(ws + WS_PO); float* PM = (float*)(ws + WS_PM); float* PL = (float*)(ws + WS_PL); bf16_t* Y5 = (bf16_t*)(ws + WS_Y5);
    bf16_t* HID = (bf16_t*)(ws + WS_HID); bf16_t* XC = (bf16_t*)(ws + WS_XC); bf16_t* BB = (bf16_t*)(ws + WS_BB); bf16_t* Y1 = (bf16_t*)(ws + WS_Y1); bf16_t* LA = (bf16_t*)(ws + WS_LA);
    float* ROPE = (float*)(ws + WS_ROPE); unsigned char* S5T = ws + WS_S5TAB; float* SP = (float*)(S5T + S5_SP);
    float* X = a.out;
    const int lo = a.ph_lo, hi = a.ph_hi;
#ifndef PHMASK
#define PHMASK 0xFFFFFFFFu
#endif
#define IN(k) (((PHMASK >> (k)) & 1u) && lo <= (k) && (k) < hi)
#define SEAM(k) do { if (IN(k) && IN((k) + 1)) grid.sync(); } while (0)

    if (IN(0)) {
        LAS float* scr = (LAS float*)(lds + wave * 8448);
        constexpr int I_IN = 16 * 64, I_OUT = 16 * 32, I_GLU = 8 * 16, I_GATE = 4 * 64, I_UP = 16 * 176, I_DN = 44 * 32;
        constexpr int NITEMS = 2 * I_IN + 2 * I_OUT + I_GLU + I_GATE + 2 * I_UP + 2 * I_DN;
        for (int it = gw; it < NITEMS; it += NGW) {
            int r = it;
            if (r < I_IN) { const int kb = r / 64, nb = r % 64; transpose_item(a.in[6] + nb * 32, 2048, 1024, (bf16_t*)(ws + WS_W_IN0) + (size_t)nb * 32 * 1024, kb * 64, scr, lane); continue; } r -= I_IN;
            if (r < I_IN) { const int kb = r / 64, nb = r % 64; transpose_item(a.in[17] + nb * 32, 2048, 1024, (bf16_t*)(ws + WS_W_IN1) + (size_t)nb * 32 * 1024, kb * 64, scr, lane); continue; } r -= I_IN;
            if (r < I_OUT) { const int kb = r / 32, nb = r % 32; transpose_item(a.in[7] + nb * 32, 1024, 1024, (bf16_t*)(ws + WS_W_OUT0) + (size_t)nb * 32 * 1024, kb * 64, scr, lane); continue; } r -= I_OUT;
            if (r < I_OUT) { const int kb = r / 32, nb = r % 32; transpose_item(a.in[18] + nb * 32, 1024, 1024, (bf16_t*)(ws + WS_W_OUT1) + (size_t)nb * 32 * 1024, kb * 64, scr, lane); continue; } r -= I_OUT;
            if (r < I_GLU) { const int kb = r / 16, nb = r % 16; transpose_item(a.in[16] + nb * 32, 512, 512, (bf16_t*)(ws + WS_W_GLU) + (size_t)nb * 32 * 512, kb * 64, scr, lane); continue; } r -= I_GLU;
            if (r < I_GATE) { const int kb = r / 64, nb = r % 64; const int n0 = nb * 32, pn = n0 >> 8, half = (n0 >> 7) & 1, j = n0 & 127, hh = pn >> 1, colg = (pn & 1) * 128 + j;
                const float* src = (half ? a.in[23] : a.in[21]) + (size_t)hh * 256 * 256 + colg;
                transpose_item(src, 256, 256, (bf16_t*)(ws + WS_W_GATE) + (size_t)n0 * 256, kb * 64, scr, lane); continue; } r -= I_GATE;
            if (r < 2 * I_UP) { const int layer = r / I_UP; r -= layer * I_UP; const int kb = r / 176, nb = r % 176; const int n0 = nb * 32, t = n0 >> 8, half = (n0 >> 7) & 1, j = n0 & 127;
                const float* src = (half ? a.in[27] : a.in[26]) + (size_t)layer * 1024 * FFH + t * 128 + j;
                transpose_item(src, FFH, 1024, (bf16_t*)(ws + (layer ? WS_W_UP1 : WS_W_UP0)) + (size_t)n0 * 1024, kb * 64, scr, lane); continue; } r -= 2 * I_UP;
            { const int layer = r / I_DN; r -= layer * I_DN; const int kb = r / 32, nb = r % 32;
                transpose_item(a.in[28] + (size_t)layer * FFH * 1024 + nb * 32, 1024, FFH, (bf16_t*)(ws + (layer ? WS_W_DN1 : WS_W_DN0)) + (size_t)nb * 32 * FFH, kb * 64, scr, lane); }
        }
        for (int idx = gt; idx < MTOK * 8; idx += NGT) { const int tok = idx >> 3, j = idx & 7; const float inv_freq = powf(500000.0f, -(float)j * 0.125f);
            const float ang = (float)positions[tok] * inv_freq; float s, c; sincos_rr(ang, s, c); ROPE[(size_t)tok * 16 + j] = c; ROPE[(size_t)tok * 16 + 8 + j] = s; }
        for (int idx = gt; idx < 32 * 64; idx += NGT) { const int g = idx >> 6, p = idx & 63;
            const float are = a.in[8][idx], aim = a.in[9][idx], dt = expf(a.in[10][g]);
            const float xr = are * dt, yi = aim * dt; const float ex = expf(xr); float sn, cs; sincos_rr(yi, sn, cs);
            const float abr = ex * cs, abi = ex * sn;
            float sh, ch; sincos_rr(0.5f * yi, sh, ch); (void)ch;
            const float nre = expm1f(xr) * cs - 2.f * sh * sh, nim = abi;
            const float den = 1.f / (are * are + aim * aim);
            const float cre = (nre * are + nim * aim) * den, cim = (nim * are - nre * aim) * den;
            float* AB = (float*)(S5T + S5_ABAR); AB[idx * 2] = abr; AB[idx * 2 + 1] = abi;
            bf16_t* BMt = (bf16_t*)(S5T + S5_BM); bf16_t* CMt = (bf16_t*)(S5T + S5_CM);
            for (int c = 0; c < 16; ++c) { const float bre = a.in[11][(size_t)idx * 16 + c], bim = a.in[12][(size_t)idx * 16 + c];
                BMt[((size_t)g * 128 + p) * 32 + c] = (bf16_t)f2bf(cre * bre - cim * bim); BMt[((size_t)g * 128 + 64 + p) * 32 + c] = (bf16_t)f2bf(cre * bim + cim * bre);
                BMt[((size_t)g * 128 + p) * 32 + 16 + c] = 0; BMt[((size_t)g * 128 + 64 + p) * 32 + 16 + c] = 0;
                CMt[((size_t)g * 16 + c) * 128 + p] = (bf16_t)f2bf(a.in[13][((size_t)g * 16 + c) * 64 + p]); CMt[((size_t)g * 16 + c) * 128 + 64 + p] = (bf16_t)f2bf(-a.in[14][((size_t)g * 16 + c) * 64 + p]); } }
        for (int idx = gt; idx < 1024; idx += NGT) SP[idx] = log1pf(expf(-a.in[25][idx]));
        for (int m = gw; m < MTOK; m += NGW) rms_row_to_bf16(x_in + (size_t)m * DM, g_mix_pre, HN + (size_t)m * DM, lane);
    }
    SEAM(0);
    if (IN(1)) { pg8::Gemm g{HN, (const bf16_t*)(ws + WS_W_IN0), MTOK, 2048, 1024, 1024, 0}; pg8::StaticOrder S; S.init(MTOK, 2048, G, bx);
        pg8::EpiRope E{Z, ROPE}; pg8::gemm_phase(lds, g, S, E); }
    SEAM(1);
    if (IN(2)) {
        if (bx < 128) s5_unit(Z, S5T, a.in[15], Y5, lds, bx, wave, lane);
        for (int u = bx; u < 12288; u += G) attn_unit(Z, PO, PM, PL, lds, u, tid, wave, lane);
    }
    SEAM(2);
    if (IN(3)) {
        for (int idx = gt; idx < MTOK * 64; idx += NGT) { const int row = idx >> 6, c8 = idx & 63, h = c8 >> 3;
            float mv[3], lv[3]; u32x4 ow[3];
#pragma unroll
            for (int i = 0; i < 3; ++i) { mv[i] = PM[((size_t)i * MTOK + row) * 8 + h]; lv[i] = PL[((size_t)i * MTOK + row) * 8 + h]; ow[i] = *(const u32x4*)(PO + ((size_t)i * MTOK + row) * 512 + c8 * 8); }
            const float mx = fmaxf(mv[0], fmaxf(mv[1], mv[2]));
            float w[3]; float den = 0.f;
#pragma unroll
            for (int i = 0; i < 3; ++i) { w[i] = fast_exp2(mv[i] - mx) * lv[i]; den += w[i]; }
            const float inv = 1.f / den; f32x4 v0 = {0.f, 0.f, 0.f, 0.f}, v1 = v0;
#pragma unroll
            for (int i = 0; i < 3; ++i) { const float ww = w[i] * inv;
                v0[0] += ww * bflo(ow[i].x); v0[1] += ww * bfhi(ow[i].x); v0[2] += ww * bflo(ow[i].y); v0[3] += ww * bfhi(ow[i].y);
                v1[0] += ww * bflo(ow[i].z); v1[1] += ww * bfhi(ow[i].z); v1[2] += ww * bflo(ow[i].w); v1[3] += ww * bfhi(ow[i].w); }
            pg8::st8(YC + (size_t)row * 1024 + c8 * 8, v0, v1); }
        __syncthreads();
        pg8::Gemm g{Y5, (const bf16_t*)(ws + WS_W_GLU), MTOK, 512, 512, 512, 0}; pg8::StaticOrder S; S.init(MTOK, 512, G, bx);
        pg8::EpiGlu E{Y5, YC}; pg8::gemm_phase(lds, g, S, E);
    }
    SEAM(3);
    if (IN(4)) { pg8::Gemm g{YC, (const bf16_t*)(ws + WS_W_OUT0), MTOK, 1024, 1024, 1024, 0}; pg8::StaticOrder S; S.init(MTOK, 1024, G, bx);
        pg8::EpiPlain E{MIX, 1024}; pg8::gemm_phase(lds, g, S, E); }
    SEAM(4);
    if (IN(5)) for (int m = gw; m < MTOK; m += NGW) resnorm_row(x_in + (size_t)m * DM, MIX + (size_t)m * DM, g_mix_post, X + (size_t)m * DM, g_ffn_pre, HN + (size_t)m * DM, lane);
    SEAM(5);
    if (IN(6)) { pg8::Gemm g{HN, (const bf16_t*)(ws + WS_W_UP0), MTOK, 2 * FFH, 1024, 1024, 0}; pg8::StaticOrder S; S.init(MTOK, 2 * FFH, G, bx);
        pg8::EpiSwiGlu E{HID}; pg8::gemm_phase(lds, g, S, E); }
    SEAM(6);
    if (IN(7)) { pg8::Gemm g{HID, (const bf16_t*)(ws + WS_W_DN0), MTOK, 1024, FFH, FFH, 0}; pg8::StaticOrder S; S.init(MTOK, 1024, G, bx);
        pg8::EpiPlain E{MIX, 1024}; pg8::gemm_phase(lds, g, S, E); }
    SEAM(7);
    if (IN(8)) for (int m = gw; m < MTOK; m += NGW) resnorm_row(X + (size_t)m * DM, MIX + (size_t)m * DM, g_ffn_post, X + (size_t)m * DM, g_mix_pre + DM, HN + (size_t)m * DM, lane);
    SEAM(8);
    if (IN(9)) { pg8::Gemm g{HN, (const bf16_t*)(ws + WS_W_IN1), MTOK, 2048, 1024, 1024, 0}; pg8::StaticOrder S; S.init(MTOK, 2048, G, bx);
        pg8::EpiIn1 E{Z}; pg8::gemm_phase(lds, g, S, E); }
    SEAM(9);
    if (IN(10)) {
        const float* cw = a.in[19]; const float* cb = a.in[20];
        for (int idx = gt; idx < (MTOK / 8) * 128; idx += NGT) { const int c8 = idx & 127, tb = idx >> 7, row0 = tb * 8, c0 = c8 * 8; const int t0 = row0 & (SEQ - 1);
            float w[4][8], bias[8];
#pragma unroll
            for (int k = 0; k < 4; ++k) { const f32x4 wa = *(const f32x4*)(cw + k * 1024 + c0), wb = *(const f32x4*)(cw + k * 1024 + c0 + 4);
                w[k][0] = wa.x; w[k][1] = wa.y; w[k][2] = wa.z; w[k][3] = wa.w; w[k][4] = wb.x; w[k][5] = wb.y; w[k][6] = wb.z; w[k][7] = wb.w; }
            { const f32x4 ba = *(const f32x4*)(cb + c0), bb = *(const f32x4*)(cb + c0 + 4); bias[0] = ba.x; bias[1] = ba.y; bias[2] = ba.z; bias[3] = ba.w; bias[4] = bb.x; bias[5] = bb.y; bias[6] = bb.z; bias[7] = bb.w; }
            float xm[3][8];
#pragma unroll
            for (int k = 0; k < 3; ++k) { u32x4 v = {0u, 0u, 0u, 0u}; if (t0 - 3 + k >= 0) v = *(const u32x4*)(Z + (size_t)(row0 - 3 + k) * 2048 + c0);
                xm[k][0] = bflo(v.x); xm[k][1] = bfhi(v.x); xm[k][2] = bflo(v.y); xm[k][3] = bfhi(v.y); xm[k][4] = bflo(v.z); xm[k][5] = bfhi(v.z); xm[k][6] = bflo(v.w); xm[k][7] = bfhi(v.w); }
#pragma unroll
            for (int r = 0; r < 8; ++r) { const u32x4 v = *(const u32x4*)(Z + (size_t)(row0 + r) * 2048 + c0);
                const float xc[8] = {bflo(v.x), bfhi(v.x), bflo(v.y), bfhi(v.y), bflo(v.z), bfhi(v.z), bflo(v.w), bfhi(v.w)};
                f32x4 o0, o1;
#pragma unroll
                for (int i = 0; i < 8; ++i) { const float o = bias[i] + w[0][i] * xm[0][i] + w[1][i] * xm[1][i] + w[2][i] * xm[2][i] + w[3][i] * xc[i];
                    if (i < 4) o0[i] = o; else o1[i - 4] = o; xm[0][i] = xm[1][i]; xm[1][i] = xm[2][i]; xm[2][i] = xc[i]; }
                pg8::st8(XC + (size_t)(row0 + r) * 1024 + c0, o0, o1); } }
    }
    SEAM(10);
    if (IN(11)) { pg8::Gemm g{XC, (const bf16_t*)(ws + WS_W_GATE), MTOK, 2048, 256, 1024, 1}; pg8::StaticOrder S; S.init(MTOK, 2048, G, bx);
        pg8::EpiGates E{XC, LA, BB, a.in[22], a.in[24], SP}; pg8::gemm_phase(lds, g, S, E); }
    SEAM(11);
    if (IN(12)) {
        LAS float* car = (LAS float*)lds;
        for (int u = bx; u < 256; u += G) { const int b = u >> 3, c0 = (u & 7) * 128 + 2 * lane; const size_t rbase = (size_t)b * SEQ + wave * 256;
            const bf16_t* la = LA + rbase * 1024 + c0; const bf16_t* bb = BB + rbase * 1024 + c0;
            float h0 = 0.f, h1 = 0.f, s0 = 0.f, s1 = 0.f;
#pragma unroll 8
            for (int t = 0; t < 256; ++t) { const unsigned lw = *(const unsigned*)(la + (size_t)t * 1024), bw = *(const unsigned*)(bb + (size_t)t * 1024);
                const float l0 = bflo(lw), l1 = bfhi(lw); s0 += l0; s1 += l1;
                h0 = fast_exp2(l0 * LOG2E) * h0 + bflo(bw); h1 = fast_exp2(l1 * LOG2E) * h1 + bfhi(bw); }
            __syncthreads();
            car[(wave * 64 + lane) * 4 + 0] = fast_exp2(s0 * LOG2E); car[(wave * 64 + lane) * 4 + 1] = fast_exp2(s1 * LOG2E); car[(wave * 64 + lane) * 4 + 2] = h0; car[(wave * 64 + lane) * 4 + 3] = h1;
            __syncthreads();
            h0 = 0.f; h1 = 0.f;
            for (int j = 0; j < wave; ++j) { const f32x4 cv = *(const LAS f32x4*)(car + (j * 64 + lane) * 4); h0 = cv.x * h0 + cv.z; h1 = cv.y * h1 + cv.w; }
            const bf16_t* gb = Z + rbase * 2048 + 1024 + c0; bf16_t* yo = Y1 + rbase * 1024 + c0;
#pragma unroll 8
            for (int t = 0; t < 256; ++t) { const unsigned lw = *(const unsigned*)(la + (size_t)t * 1024), bw = *(const unsigned*)(bb + (size_t)t * 1024), gwv = *(const unsigned*)(gb + (size_t)t * 2048);
                h0 = fast_exp2(bflo(lw) * LOG2E) * h0 + bflo(bw); h1 = fast_exp2(bfhi(lw) * LOG2E) * h1 + bfhi(bw);
                *(unsigned*)(yo + (size_t)t * 1024) = pk2(h0 * bflo(gwv), h1 * bfhi(gwv)); }
        }
    }
    SEAM(12);
    if (IN(13)) { pg8::Gemm g{Y1, (const bf16_t*)(ws + WS_W_OUT1), MTOK, 1024, 1024, 1024, 0}; pg8::StaticOrder S; S.init(MTOK, 1024, G, bx);
        pg8::EpiPlain E{MIX, 1024}; pg8::gemm_phase(lds, g, S, E); }
    SEAM(13);
    if (IN(14)) for (int m = gw; m < MTOK; m += NGW) resnorm_row(X + (size_t)m * DM, MIX + (size_t)m * DM, g_mix_post + DM, X + (size_t)m * DM, g_ffn_pre + DM, HN + (size_t)m * DM, lane);
    SEAM(14);
    if (IN(15)) { pg8::Gemm g{HN, (const bf16_t*)(ws + WS_W_UP1), MTOK, 2 * FFH, 1024, 1024, 0}; pg8::StaticOrder S; S.init(MTOK, 2 * FFH, G, bx);
        pg8::EpiSwiGlu E{HID}; pg8::gemm_phase(lds, g, S, E); }
    SEAM(15);
    if (IN(16)) { pg8::Gemm g{HID, (const bf16_t*)(ws + WS_W_DN1), MTOK, 1024, FFH, FFH, 0}; pg8::StaticOrder S; S.init(MTOK, 1024, G, bx);
        pg8::EpiPlain E{MIX, 1024}; pg8::gemm_phase(lds, g, S, E); }
    SEAM(16);
    if (IN(17)) for (int m = gw; m < MTOK; m += NGW) resnorm_row(X + (size_t)m * DM, MIX + (size_t)m * DM, g_ffn_post + DM, X + (size_t)m * DM, nullptr, nullptr, lane);
#undef IN
#undef SEAM
}
constexpr int NPHASES = 18;

extern "C" void kernel_launch(void* const* d_in, const int* in_sizes, int n_in, void* d_out, int out_size, void* d_ws, size_t ws_size, hipStream_t stream) {
    static int grid = 0;
    if (grid == 0) {
        if (n_in != 29 || in_sizes[0] != MTOK * DM || out_size != MTOK * DM || ws_size < WS_END) {
            fprintf(stderr, "kernel_launch: unexpected shapes: n_in %d in0 %d out %d ws %zu (need %zu)\n", n_in, n_in > 0 ? in_sizes[0] : -1, out_size, ws_size, (size_t)WS_END); grid = -1; return; }
        int dev = 0, cus = 0, per_cu = 0;
        hipGetDevice(&dev); hipDeviceGetAttribute(&cus, hipDeviceAttributeMultiprocessorCount, dev);
        if (hipFuncSetAttribute((const void*)mega, hipFuncAttributeMaxDynamicSharedMemorySize, LDS_BYTES) != hipSuccess) { fprintf(stderr, "kernel_launch: hipFuncSetAttribute failed\n"); grid = -1; return; }
        if (hipOccupancyMaxActiveBlocksPerMultiprocessor(&per_cu, (const void*)mega, NTHREADS, LDS_BYTES) != hipSuccess || per_cu < 1) { fprintf(stderr, "kernel_launch: occupancy query says %d\n", per_cu); per_cu = 1; }
        (void)hipGetLastError();
        grid = cus;
    }
    if (grid < 0) return;
    Args a{};
    for (int i = 0; i < 29; ++i) a.in[i] = (const float*)d_in[i];
    a.out = (float*)d_out; a.ws = (unsigned char*)d_ws;
#if N_LAUNCH_MODE == 1
    a.ph_lo = 0; a.ph_hi = NPHASES;
    void* args[] = {&a};
    hipError_t e = hipLaunchCooperativeKernel((const void*)mega, dim3(grid), dim3(NTHREADS), args, LDS_BYTES, stream);
    if (e != hipSuccess) fprintf(stderr, "cooperative launch failed: %s (grid %d)\n", hipGetErrorString(e), grid);
#else
    for (int ph = 0; ph < NPHASES; ++ph) { a.ph_lo = ph; a.ph_hi = ph + 1; hipLaunchKernelGGL(mega, dim3(grid), dim3(NTHREADS), LDS_BYTES, stream, a); }
#endif
}
```

```cpp
#include <hip/hip_runtime.h>
#include <hip/hip_cooperative_groups.h>
#include <cstdio>
#include <cstdint>
namespace cg = cooperative_groups;

#ifndef N_LAUNCH_MODE
#define N_LAUNCH_MODE 1
#endif

#define LAS __attribute__((address_space(3)))
typedef unsigned short bf16_t;
typedef short bf16x8 __attribute__((ext_vector_type(8)));
typedef float f32x4 __attribute__((ext_vector_type(4)));
typedef unsigned u32x4 __attribute__((ext_vector_type(4)));
typedef unsigned u32x2 __attribute__((ext_vector_type(2)));

constexpr int MTOK = 65536, DM = 1024, SEQ = 2048, NBATCH = 32, FFH = 2816;
constexpr float NORM_EPS = 1e-6f;
constexpr float LOG2E = 1.4426950408889634f;
constexpr int NWAVES = 8, NTHREADS = 512;
constexpr int LDS_BYTES = 136 * 1024;

constexpr size_t MiB = 1u << 20;
constexpr size_t WS_CTL = 0;
constexpr size_t WS_W_IN0 = 1 * MiB, WS_W_OUT0 = 5 * MiB, WS_W_GLU = 7 * MiB, WS_W_IN1 = 8 * MiB, WS_W_OUT1 = 12 * MiB, WS_W_GATE = 14 * MiB;
constexpr size_t WS_W_UP0 = 15 * MiB, WS_W_UP1 = 26 * MiB, WS_W_DN0 = 37 * MiB, WS_W_DN1 = 43 * MiB;
constexpr size_t WS_ROPE = 49 * MiB;
constexpr size_t WS_S5TAB = 53 * MiB;
constexpr size_t S5_ABAR = 0, S5_BM = 16384, S5_CM = 16384 + 262144, S5_SP = 16384 + 262144 + 131072;
constexpr size_t WS_HN = 64 * MiB, WS_Z = 192 * MiB, WS_YC = 448 * MiB, WS_MIX = 576 * MiB, WS_PO = 704 * MiB, WS_PM = 896 * MiB, WS_PL = 902 * MiB, WS_Y5 = 908 * MiB;
constexpr size_t WS_HID = 192 * MiB;
constexpr size_t WS_XC = 448 * MiB, WS_BB = 576 * MiB, WS_Y1 = 704 * MiB, WS_LA = 832 * MiB;
constexpr size_t WS_END = 972 * MiB;

struct Args { const float* in[29]; float* out; unsigned char* ws; int ph_lo, ph_hi; };

__device__ __forceinline__ unsigned f2bf(float f) { unsigned u = __builtin_bit_cast(unsigned, f); return (u + 0x7fffu + ((u >> 16) & 1u)) >> 16; }
__device__ __forceinline__ unsigned pk2(float lo, float hi) { return f2bf(lo) | (f2bf(hi) << 16); }
__device__ __forceinline__ float bf2f(unsigned short h) { return __builtin_bit_cast(float, (unsigned)h << 16); }
__device__ __forceinline__ float bflo(unsigned w) { return __builtin_bit_cast(float, w << 16); }
__device__ __forceinline__ float bfhi(unsigned w) { return __builtin_bit_cast(float, w & 0xffff0000u); }
__device__ __forceinline__ float fast_exp2(float x) { return __builtin_amdgcn_exp2f(x); }
__device__ __forceinline__ float fast_rcp(float x) { return __builtin_amdgcn_rcpf(x); }
__device__ __forceinline__ float sigmoidf_(float x) { return fast_rcp(1.f + fast_exp2(-x * LOG2E)); }
__device__ __forceinline__ float gelu_tanh(float x) { const float u = 0.7978845608028654f * (x + 0.044715f * x * x * x); return x * sigmoidf_(2.f * u); }
__device__ __forceinline__ float wave_sum(float v) {
#pragma unroll
    for (int o = 1; o < 64; o <<= 1) v += __shfl_xor(v, o);
    return v;
}
#define LDS_WAIT() asm volatile("s_waitcnt lgkmcnt(0)" ::: "memory")

namespace pg8 {
constexpr int BM = 256, BK = 64, HALF = 128, HTB = HALF * BK * 2, STAGE_BYTES = 8 * HTB, NXCD = 8, WGM = 8;
__host__ __device__ __forceinline__ int lds_byte(int r, int c) { const int st = (r >> 4) * 2 + (c >> 5), rr = r & 15, cc = c & 31, ob = rr * 64 + cc * 2; return st * 1024 + (ob ^ (((ob >> 9) & 1) << 5)); }
__host__ __device__ __forceinline__ void stage_rc(int b, int& R, int& C) { const int st = b / 1024, sb = b % 1024, swz = sb ^ (((sb >> 9) & 1) << 5); R = (st >> 1) * 16 + swz / 64; C = (st & 1) * 32 + (swz % 64) / 2; }
__host__ __device__ __forceinline__ int perm32(int rho) { const int n = rho >> 4, i = rho & 15; return 8 * (i >> 2) + 4 * n + (i & 3); }
struct Unit { int pm, pn; };
struct Gemm { const bf16_t* A; const bf16_t* Bt; int M, N, K, lda, grp; };
struct StaticOrder {
    int nM, nN, nwg, G, c;
    __host__ __device__ void init(int M, int N, int G_, int c_) { nM = M / BM; nN = N / BM; nwg = nM * nN; G = G_; c = c_; }
    __host__ __device__ bool next(int i, Unit& u) const {
        const long L = (long)i * G + c; if (L >= nwg) return false;
        int wgid = (int)L; { const int q = nwg / NXCD, r = nwg % NXCD, xcd = wgid % NXCD, off = wgid / NXCD; wgid = (xcd < r ? xcd * (q + 1) : r * (q + 1) + (xcd - r) * q) + off; }
        const int nig = WGM * nN, gid = wgid / nig, fm = gid * WGM, gsz = (nM - fm) < WGM ? (nM - fm) : WGM;
        u.pm = fm + ((wgid % nig) % gsz); u.pn = (wgid % nig) / gsz; return true;
    }
};
template <class Epi>
__device__ __forceinline__ void gemm_phase(LAS unsigned char* lds, const Gemm g, const StaticOrder& S, const Epi& E) {
    const int tid = threadIdx.x, wid = __builtin_amdgcn_readfirstlane(tid >> 6), lane = tid & 63, wr = wid >> 2, wc = wid & 3, fr = lane & 15, fq = lane >> 4;
    const int K = g.K, nt = K / BK, lda = g.lda;
    unsigned voffA[2], voffB[2];
#pragma unroll
    for (int i = 0; i < 2; ++i) { int R, C; stage_rc(tid * 16 + i * 8192, R, C); const int Rb = (R & ~31) + perm32(R & 31);
        voffA[i] = (unsigned)(R * lda + C) * 2u; voffB[i] = (unsigned)(Rb * K + C) * 2u; }
    const size_t kstep = (size_t)(BK * 2);
    const size_t hstepA = (size_t)HALF * lda * 2, hstepB = (size_t)HALF * K * 2;
    const size_t tstepA = 2 * hstepA, tstepB = 2 * hstepB;
    const unsigned ldsw = (unsigned)wid * 1024u;
    const int aoff = lds_byte(wr * 64 + fr, fq * 8), boff = lds_byte(wc * 32 + fr, fq * 8);
#define PG8_SA(b, h) (((b) * 2 + (h)) * HTB)
#define PG8_SB(b, h) ((4 + (b) * 2 + (h)) * HTB)
#define PG8_STAGE(bufoff, gbase, voff) do { _Pragma("unroll") for (int _i = 0; _i < 2; ++_i) \
        __builtin_amdgcn_global_load_lds((const unsigned*)((const char*)(gbase) + (voff)[_i]), (LAS unsigned*)(lds + (bufoff) + ldsw + _i * 8192), 16, 0, 0); } while (0)
#define PG8_LDA(dst, b, h) do { _Pragma("unroll") for (int m = 0; m < 4; ++m) _Pragma("unroll") for (int k = 0; k < 2; ++k) dst[m][k] = *(const LAS bf16x8*)(lds + PG8_SA(b, h) + aoff + m * 2048 + k * 1024); } while (0)
#define PG8_LDB(dst, b, h) do { _Pragma("unroll") for (int n = 0; n < 2; ++n) _Pragma("unroll") for (int k = 0; k < 2; ++k) dst[n][k] = *(const LAS bf16x8*)(lds + PG8_SB(b, h) + boff + n * 2048 + k * 1024); } while (0)
#define PG8_MMA(ai, bj, At, Bt) do { __builtin_amdgcn_s_setprio(1); _Pragma("unroll") for (int m = 0; m < 4; ++m) _Pragma("unroll") for (int n = 0; n < 2; ++n) _Pragma("unroll") for (int k = 0; k < 2; ++k) \
        acc[ai][bj][m][n] = __builtin_amdgcn_mfma_f32_16x16x32_bf16(Bt[n][k], At[m][k], acc[ai][bj][m][n], 0, 0, 0); __builtin_amdgcn_s_setprio(0); } while (0)
#define PG8_WAIT_V(n) asm volatile("s_waitcnt vmcnt(" #n ")" ::: "memory")
#define PG8_WAIT_L(n) asm volatile("s_waitcnt lgkmcnt(" #n ")" ::: "memory")
#define PG8_BAR __builtin_amdgcn_s_barrier()
#define PG8_SCHED __builtin_amdgcn_sched_barrier(0)
    Unit cur, nxt; int ui = 0;
    if (!S.next(0, cur)) return;
    f32x4 acc[2][2][4][2];
#pragma unroll
    for (int a = 0; a < 2; ++a)
#pragma unroll
        for (int b = 0; b < 2; ++b)
#pragma unroll
            for (int m = 0; m < 4; ++m)
#pragma unroll
                for (int n = 0; n < 2; ++n) acc[a][b][m][n] = (f32x4){0.f, 0.f, 0.f, 0.f};
    bf16x8 At[4][2], B0[2][2], B1[2][2];
    const char* cA = (const char*)g.A + (size_t)cur.pm * tstepA + (g.grp ? (size_t)(cur.pn >> 1) * K * 2 : 0); const char* cB = (const char*)g.Bt + (size_t)cur.pn * tstepB;
    PG8_STAGE(PG8_SB(0, 0), cB, voffB); PG8_STAGE(PG8_SB(0, 1), cB + hstepB, voffB); PG8_STAGE(PG8_SA(0, 0), cA, voffA); PG8_STAGE(PG8_SA(0, 1), cA + hstepA, voffA);
    if (wr == 1) PG8_BAR;
    PG8_WAIT_V(2); PG8_BAR;
    PG8_STAGE(PG8_SB(1, 0), cB + kstep, voffB); PG8_STAGE(PG8_SA(1, 0), cA + kstep, voffA); PG8_STAGE(PG8_SB(1, 1), cB + hstepB + kstep, voffB);
    PG8_WAIT_V(6); PG8_BAR;
    for (;;) {
        const bool has_next = S.next(ui + 1, nxt);
        const char* nA = has_next ? (const char*)g.A + (size_t)nxt.pm * tstepA + (g.grp ? (size_t)(nxt.pn >> 1) * K * 2 : 0) : cA; const char* nB = has_next ? (const char*)g.Bt + (size_t)nxt.pn * tstepB : cB;
        for (int t = 0; t < nt; t += 2) {
            const bool last = (t == nt - 2);
            const char* a1 = cA + (size_t)(t + 1) * kstep;
            const char* a2 = last ? nA : cA + (size_t)(t + 2) * kstep; const char* b2 = last ? nB : cB + (size_t)(t + 2) * kstep;
            const char* a3 = a2 + kstep; const char* b3 = b2 + kstep;
            PG8_LDB(B0, 0, 0); PG8_LDB(B1, 0, 1); PG8_SCHED; PG8_LDA(At, 0, 0); PG8_STAGE(PG8_SA(1, 1), a1 + hstepA, voffA);
            PG8_WAIT_V(8); PG8_WAIT_L(0); PG8_BAR; PG8_MMA(0, 0, At, B0); PG8_MMA(0, 1, At, B1); PG8_BAR; PG8_SCHED;
            PG8_LDA(At, 0, 1); PG8_STAGE(PG8_SB(0, 0), b2, voffB); PG8_STAGE(PG8_SB(0, 1), b2 + hstepB, voffB); PG8_STAGE(PG8_SA(0, 0), a2, voffA);
            PG8_WAIT_V(8); PG8_WAIT_L(0); PG8_BAR; PG8_MMA(1, 0, At, B0); PG8_MMA(1, 1, At, B1); PG8_BAR; PG8_SCHED;
            PG8_LDB(B0, 1, 0); PG8_LDB(B1, 1, 1); PG8_SCHED; PG8_LDA(At, 1, 0); PG8_STAGE(PG8_SA(0, 1), a2 + hstepA, voffA);
            PG8_WAIT_V(8); PG8_WAIT_L(0); PG8_BAR; PG8_MMA(0, 0, At, B0); PG8_MMA(0, 1, At, B1); PG8_BAR; PG8_SCHED;
            PG8_LDA(At, 1, 1); PG8_STAGE(PG8_SB(1, 0), b3, voffB); PG8_STAGE(PG8_SB(1, 1), b3 + hstepB, voffB); PG8_STAGE(PG8_SA(1, 0), a3, voffA);
            PG8_WAIT_V(8); PG8_WAIT_L(0); PG8_BAR; PG8_MMA(1, 0, At, B0); PG8_MMA(1, 1, At, B1); PG8_BAR; PG8_SCHED;
        }
        if (wr == 0) PG8_BAR;
        E(acc, cur, wr, wc, fr, fq);
        if (!has_next) break;
#pragma unroll
        for (int a = 0; a < 2; ++a)
#pragma unroll
            for (int b = 0; b < 2; ++b)
#pragma unroll
                for (int m = 0; m < 4; ++m)
#pragma unroll
                    for (int n = 0; n < 2; ++n) acc[a][b][m][n] = (f32x4){0.f, 0.f, 0.f, 0.f};
        cur = nxt; cA = nA; cB = nB; ++ui;
        if (wr == 1) PG8_BAR;
    }
    PG8_WAIT_V(0);
    PG8_BAR;
#undef PG8_SA
#undef PG8_SB
#undef PG8_STAGE
#undef PG8_LDA
#undef PG8_LDB
#undef PG8_MMA
#undef PG8_WAIT_V
#undef PG8_WAIT_L
#undef PG8_BAR
#undef PG8_SCHED
}
typedef f32x4 AccT[2][2][4][2];

__device__ __forceinline__ void st8(bf16_t* p, f32x4 v0, f32x4 v1) {
    u32x4 w; w.x = pk2(v0[0], v0[1]); w.y = pk2(v0[2], v0[3]); w.z = pk2(v1[0], v1[1]); w.w = pk2(v1[2], v1[3]); *(u32x4*)p = w;
}
struct EpiPlain {
    bf16_t* O; int ldc;
    __device__ __forceinline__ void operator()(const AccT& acc, const Unit& u, int wr, int wc, int fr, int fq) const {
        const int row0 = u.pm * BM + wr * 64 + fr, col0 = u.pn * BM + wc * 32 + 8 * fq;
#pragma unroll
        for (int ai = 0; ai < 2; ++ai)
#pragma unroll
            for (int m = 0; m < 4; ++m) { bf16_t* rowp = O + (size_t)(row0 + ai * HALF + m * 16) * ldc + col0;
#pragma unroll
                for (int bj = 0; bj < 2; ++bj) st8(rowp + bj * HALF, acc[ai][bj][m][0], acc[ai][bj][m][1]); }
    }
};
struct EpiRope {
    bf16_t* Z; const float* rope;
    __device__ __forceinline__ void operator()(const AccT& acc, const Unit& u, int wr, int wc, int fr, int fq) const {
        const int row0 = u.pm * BM + wr * 64 + fr, col0 = u.pn * BM + wc * 32 + 8 * fq;
        const bool ropew = (u.pn < 4) && !(wc & 1); const float sc = (u.pn < 2) ? 0.125f : 1.f;
#pragma unroll
        for (int ai = 0; ai < 2; ++ai)
#pragma unroll
            for (int m = 0; m < 4; ++m) { const int row = row0 + ai * HALF + m * 16; bf16_t* rowp = Z + (size_t)row * 2048 + col0;
                f32x4 c0 = {1.f, 1.f, 1.f, 1.f}, c1 = c0, s0 = {0.f, 0.f, 0.f, 0.f}, s1 = s0;
                if (ropew && fq < 2) { const f32x4* rp = (const f32x4*)(rope + (size_t)row * 16); c0 = rp[0]; c1 = rp[1]; s0 = rp[2]; s1 = rp[3]; if (fq == 0) { s0 = -s0; s1 = -s1; } }
#pragma unroll
                for (int bj = 0; bj < 2; ++bj) { f32x4 v0 = acc[ai][bj][m][0], v1 = acc[ai][bj][m][1];
                    if (ropew) { f32x4 p0, p1;
#pragma unroll
                        for (int i = 0; i < 4; ++i) { p0[i] = __shfl_xor(v0[i], 16); p1[i] = __shfl_xor(v1[i], 16); }
                        v0 = v0 * c0 + p0 * s0; v1 = v1 * c1 + p1 * s1; }
                    v0 = v0 * sc; v1 = v1 * sc; st8(rowp + bj * HALF, v0, v1); } }
    }
};
struct EpiGlu {
    const bf16_t* Y; bf16_t* O;
    __device__ __forceinline__ void operator()(const AccT& acc, const Unit& u, int wr, int wc, int fr, int fq) const {
        const int row0 = u.pm * BM + wr * 64 + fr, col0 = u.pn * BM + wc * 32 + 8 * fq;
#pragma unroll
        for (int ai = 0; ai < 2; ++ai)
#pragma unroll
            for (int m = 0; m < 4; ++m) { const int row = row0 + ai * HALF + m * 16;
#pragma unroll
                for (int bj = 0; bj < 2; ++bj) { const int col = col0 + bj * HALF; const u32x4 yw = *(const u32x4*)(Y + (size_t)row * 512 + col);
                    f32x4 a0 = acc[ai][bj][m][0], a1 = acc[ai][bj][m][1], v0, v1;
                    v0[0] = bflo(yw.x) * sigmoidf_(a0[0]); v0[1] = bfhi(yw.x) * sigmoidf_(a0[1]); v0[2] = bflo(yw.y) * sigmoidf_(a0[2]); v0[3] = bfhi(yw.y) * sigmoidf_(a0[3]);
                    v1[0] = bflo(yw.z) * sigmoidf_(a1[0]); v1[1] = bfhi(yw.z) * sigmoidf_(a1[1]); v1[2] = bflo(yw.w) * sigmoidf_(a1[2]); v1[3] = bfhi(yw.w) * sigmoidf_(a1[3]);
                    st8(O + (size_t)row * 1024 + 512 + col, v0, v1); } }
    }
};
struct EpiSwiGlu {
    bf16_t* O;
    __device__ __forceinline__ void operator()(const AccT& acc, const Unit& u, int wr, int wc, int fr, int fq) const {
        const int row0 = u.pm * BM + wr * 64 + fr, col0 = u.pn * HALF + wc * 32 + 8 * fq;
#pragma unroll
        for (int ai = 0; ai < 2; ++ai)
#pragma unroll
            for (int m = 0; m < 4; ++m) { const int row = row0 + ai * HALF + m * 16; f32x4 v[2];
#pragma unroll
                for (int n = 0; n < 2; ++n)
#pragma unroll
                    for (int i = 0; i < 4; ++i) { const float gt = acc[ai][0][m][n][i], up = acc[ai][1][m][n][i]; v[n][i] = gt * sigmoidf_(gt) * up; }
                st8(O + (size_t)row * FFH + col0, v[0], v[1]); }
    }
};
struct EpiIn1 {
    bf16_t* Z;
    __device__ __forceinline__ void operator()(const AccT& acc, const Unit& u, int wr, int wc, int fr, int fq) const {
        const int row0 = u.pm * BM + wr * 64 + fr, col0 = u.pn * BM + wc * 32 + 8 * fq; const bool act = u.pn >= 4;
#pragma unroll
        for (int ai = 0; ai < 2; ++ai)
#pragma unroll
            for (int m = 0; m < 4; ++m) { bf16_t* rowp = Z + (size_t)(row0 + ai * HALF + m * 16) * 2048 + col0;
#pragma unroll
                for (int bj = 0; bj < 2; ++bj) { f32x4 v0 = acc[ai][bj][m][0], v1 = acc[ai][bj][m][1];
                    if (act) {
#pragma unroll
                        for (int i = 0; i < 4; ++i) { v0[i] = gelu_tanh(v0[i]); v1[i] = gelu_tanh(v1[i]); } }
                    st8(rowp + bj * HALF, v0, v1); } }
    }
};
struct EpiGates {
    const bf16_t* XC; bf16_t* LA; bf16_t* BB; const float* b_r; const float* b_i; const float* sp;
    __device__ __forceinline__ void operator()(const AccT& acc, const Unit& u, int wr, int wc, int fr, int fq) const {
        const int row0 = u.pm * BM + wr * 64 + fr, c0 = (u.pn >> 1) * 256 + (u.pn & 1) * 128 + wc * 32 + 8 * fq;
#pragma unroll
        for (int ai = 0; ai < 2; ++ai)
#pragma unroll
            for (int m = 0; m < 4; ++m) { const int row = row0 + ai * HALF + m * 16; const u32x4 xw = *(const u32x4*)(XC + (size_t)row * 1024 + c0);
                const float xv[8] = {bflo(xw.x), bfhi(xw.x), bflo(xw.y), bfhi(xw.y), bflo(xw.z), bfhi(xw.z), bflo(xw.w), bfhi(xw.w)};
                f32x4 la[2], bb[2];
#pragma unroll
                for (int n = 0; n < 2; ++n) { const f32x4 br = *(const f32x4*)(b_r + c0 + 4 * n), bi = *(const f32x4*)(b_i + c0 + 4 * n), spv = *(const f32x4*)(sp + c0 + 4 * n);
#pragma unroll
                    for (int i = 0; i < 4; ++i) { const float gr = sigmoidf_(acc[ai][0][m][n][i] + br[i]), gi = sigmoidf_(acc[ai][1][m][n][i] + bi[i]);
                        const float l = -8.f * gr * spv[i]; const float a2 = fast_exp2(2.f * l * LOG2E); const float mult = sqrtf(fmaxf(1.f - a2, 0.f));
                        la[n][i] = l; bb[n][i] = mult * gi * xv[4 * n + i]; } }
                st8(LA + (size_t)row * 1024 + c0, la[0], la[1]); st8(BB + (size_t)row * 1024 + c0, bb[0], bb[1]); }
    }
};
}

__device__ __forceinline__ void transpose_item(const float* W, int ld, int K, bf16_t* dst, int k0, LAS float* scr, int lane) {
#pragma unroll 8
    for (int i = 0; i < 32; ++i) { const int kk = 2 * i + (lane >> 5); scr[kk * 33 + (lane & 31)] = W[(size_t)(k0 + kk) * ld + (lane & 31)]; }
    LDS_WAIT();
    const int c = lane & 7;
#pragma unroll
    for (int j = 0; j < 4; ++j) { const int n = (lane >> 3) + 8 * j; const LAS float* s = scr + (8 * c) * 33 + n;
        u32x4 o; o.x = pk2(s[0 * 33], s[1 * 33]); o.y = pk2(s[2 * 33], s[3 * 33]); o.z = pk2(s[4 * 33], s[5 * 33]); o.w = pk2(s[6 * 33], s[7 * 33]);
        *(u32x4*)(dst + (size_t)n * K + k0 + 8 * c) = o; }
    LDS_WAIT();
}
__device__ __forceinline__ void sincos_rr(float ang, float& s, float& c) {
    const double r = (double)ang * 0.15915494309189535; const double fr = r - __builtin_rint(r); const float f = (float)fr;
    s = __builtin_amdgcn_sinf(f); c = __builtin_amdgcn_cosf(f);
}
__device__ __forceinline__ void rms_row_to_bf16(const float* xrow, const float* g, bf16_t* orow, int lane) {
    const f32x4* xr = (const f32x4*)xrow + lane; const f32x4* gr = (const f32x4*)g + lane;
    f32x4 v[4]; float s = 0.f;
#pragma unroll
    for (int j = 0; j < 4; ++j) { v[j] = xr[64 * j]; s += (v[j].x * v[j].x + v[j].y * v[j].y) + (v[j].z * v[j].z + v[j].w * v[j].w); }
    const float rstd = 1.f / sqrtf(wave_sum(s) * (1.f / DM) + NORM_EPS);
    u32x2* o8 = (u32x2*)orow + lane;
#pragma unroll
    for (int j = 0; j < 4; ++j) { const f32x4 gg = gr[64 * j]; u32x2 w; w.x = pk2(v[j].x * rstd * gg.x, v[j].y * rstd * gg.y); w.y = pk2(v[j].z * rstd * gg.z, v[j].w * rstd * gg.w); o8[64 * j] = w; }
}
__device__ __forceinline__ void resnorm_row(const float* xin, const bf16_t* mix, const float* gpost, float* xout, const float* gpre, bf16_t* hn, int lane) {
    const f32x4* xr = (const f32x4*)xin + lane; const u32x2* mr = (const u32x2*)mix + lane; const f32x4* gp = (const f32x4*)gpost + lane;
    f32x4 v[4]; float s = 0.f;
#pragma unroll
    for (int j = 0; j < 4; ++j) { const u32x2 w = mr[64 * j]; v[j] = (f32x4){bflo(w.x), bfhi(w.x), bflo(w.y), bfhi(w.y)}; s += (v[j].x * v[j].x + v[j].y * v[j].y) + (v[j].z * v[j].z + v[j].w * v[j].w); }
    const float rstd = 1.f / sqrtf(wave_sum(s) * (1.f / DM) + NORM_EPS);
    float s2 = 0.f;
#pragma unroll
    for (int j = 0; j < 4; ++j) { const f32x4 gg = gp[64 * j]; v[j] = xr[64 * j] + v[j] * rstd * gg; s2 += (v[j].x * v[j].x + v[j].y * v[j].y) + (v[j].z * v[j].z + v[j].w * v[j].w);
        ((f32x4*)xout + lane)[64 * j] = v[j]; }
    if (hn) { const float rstd2 = 1.f / sqrtf(wave_sum(s2) * (1.f / DM) + NORM_EPS); const f32x4* gq = (const f32x4*)gpre + lane; u32x2* o8 = (u32x2*)hn + lane;
#pragma unroll
        for (int j = 0; j < 4; ++j) { const f32x4 gg = gq[64 * j]; u32x2 w; w.x = pk2(v[j].x * rstd2 * gg.x, v[j].y * rstd2 * gg.y); w.y = pk2(v[j].z * rstd2 * gg.z, v[j].w * rstd2 * gg.w); o8[64 * j] = w; } }
}

constexpr int AT_KPITCH = 144, AT_VPITCH = 528, AT_VOFF = 256 * AT_KPITCH;
__device__ __forceinline__ void attn_unit(const bf16_t* Z, bf16_t* PO, float* PM, float* PL, LAS unsigned char* lds, int unit, int tid, int wave, int lane) {
    const int sub = unit & 15, br = (unit >> 4) % 3, bh = unit / 48, h = bh & 7, b = bh >> 3;
    const int dil = br == 0 ? 1 : (br == 1 ? 4 : 16), nb = 16 / dil, rho = sub / nb, n = sub % nb;
    const bf16_t* Zb = Z + (size_t)b * SEQ * 2048;
    __syncthreads();
#pragma unroll
    for (int it = 0; it < 4; ++it) { const int idx = tid + it * NTHREADS, kb = idx >> 3, ch = idx & 7;
        int sidx = n * 128 - 128 + kb; if (sidx < 0) sidx = 0; const int tok = sidx * dil + rho;
        const bf16_t* rowp = Zb + (size_t)tok * 2048 + h * 64 + ch * 8;
        const u32x4 kv = *(const u32x4*)(rowp + 512); const u32x4 vv = *(const u32x4*)(rowp + 1024);
        *(LAS u32x4*)(lds + kb * AT_KPITCH + ch * 16) = kv;
        LAS bf16_t* vt = (LAS bf16_t*)(lds + AT_VOFF) + (ch * 8) * (AT_VPITCH / 2) + kb;
        vt[0 * (AT_VPITCH / 2)] = (bf16_t)(vv.x & 0xffff); vt[1 * (AT_VPITCH / 2)] = (bf16_t)(vv.x >> 16);
        vt[2 * (AT_VPITCH / 2)] = (bf16_t)(vv.y & 0xffff); vt[3 * (AT_VPITCH / 2)] = (bf16_t)(vv.y >> 16);
        vt[4 * (AT_VPITCH / 2)] = (bf16_t)(vv.z & 0xffff); vt[5 * (AT_VPITCH / 2)] = (bf16_t)(vv.z >> 16);
        vt[6 * (AT_VPITCH / 2)] = (bf16_t)(vv.w & 0xffff); vt[7 * (AT_VPITCH / 2)] = (bf16_t)(vv.w >> 16); }
    const int q = lane & 15, kq = lane >> 4, qi = 16 * wave + q;
    const int tokq = (n * 128 + qi) * dil + rho;
    const bf16_t* qrow = Zb + (size_t)tokq * 2048 + h * 64;
    const bf16x8 qf0 = *(const bf16x8*)(qrow + 8 * kq), qf1 = *(const bf16x8*)(qrow + 32 + 8 * kq);
    __syncthreads();
    f32x4 o[4];
#pragma unroll
    for (int mm = 0; mm < 4; ++mm) o[mm] = (f32x4){0.f, 0.f, 0.f, 0.f};
    float mrun = -1e30f, lrun = 0.f;
    const int kstart = (16 * wave < 96) ? 16 * wave : 96;
    for (int p = 0; p < 5; ++p) {
        const int ks = kstart + 32 * p;
        if (n == 0 && ks + 32 <= 128) continue;
        if (ks + 31 < 16 * wave) continue;
        const LAS unsigned char* kp = lds + (ks + q) * AT_KPITCH + kq * 16;
        const bf16x8 k00 = *(const LAS bf16x8*)(kp), k01 = *(const LAS bf16x8*)(kp + 64);
        const bf16x8 k10 = *(const LAS bf16x8*)(kp + 16 * AT_KPITCH), k11 = *(const LAS bf16x8*)(kp + 16 * AT_KPITCH + 64);
        f32x4 s0 = {0.f, 0.f, 0.f, 0.f}, s1 = {0.f, 0.f, 0.f, 0.f};
        s0 = __builtin_amdgcn_mfma_f32_16x16x32_bf16(k00, qf0, s0, 0, 0, 0); s0 = __builtin_amdgcn_mfma_f32_16x16x32_bf16(k01, qf1, s0, 0, 0, 0);
        s1 = __builtin_amdgcn_mfma_f32_16x16x32_bf16(k10, qf0, s1, 0, 0, 0); s1 = __builtin_amdgcn_mfma_f32_16x16x32_bf16(k11, qf1, s1, 0, 0, 0);
        float sv[8]; float mx = -1e30f;
#pragma unroll
        for (int i = 0; i < 8; ++i) { const int kb = ks + (i >> 2) * 16 + 4 * kq + (i & 3); const bool ok = (kb >= qi) && (kb <= qi + 128) && (n * 128 + kb >= 128);
            const float sraw = (i < 4) ? s0[i & 3] : s1[i & 3]; sv[i] = ok ? sraw * LOG2E : -1e30f; mx = fmaxf(mx, sv[i]); }
        mx = fmaxf(mx, __shfl_xor(mx, 16)); mx = fmaxf(mx, __shfl_xor(mx, 32));
        const float mn = fmaxf(mrun, mx); const float alpha = fast_exp2(mrun - mn);
        float ps = 0.f; float pv[8];
#pragma unroll
        for (int i = 0; i < 8; ++i) { pv[i] = (sv[i] > -1e29f) ? fast_exp2(sv[i] - mn) : 0.f; ps += pv[i]; }
        ps += __shfl_xor(ps, 16); ps += __shfl_xor(ps, 32);
        lrun = lrun * alpha + ps; mrun = mn;
        u32x4 pw; pw.x = pk2(pv[0], pv[1]); pw.y = pk2(pv[2], pv[3]); pw.z = pk2(pv[4], pv[5]); pw.w = pk2(pv[6], pv[7]);
        const bf16x8 pf = __builtin_bit_cast(bf16x8, pw);
#pragma unroll
        for (int mm = 0; mm < 4; ++mm) { const LAS unsigned char* vp = lds + AT_VOFF + (16 * mm + q) * AT_VPITCH + (ks + 4 * kq) * 2;
            const u32x2 lo = *(const LAS u32x2*)vp, hi = *(const LAS u32x2*)(vp + 32);
            u32x4 vw; vw.x = lo.x; vw.y = lo.y; vw.z = hi.x; vw.w = hi.y;
            o[mm] = o[mm] * alpha;
            o[mm] = __builtin_amdgcn_mfma_f32_16x16x32_bf16(__builtin_bit_cast(bf16x8, vw), pf, o[mm], 0, 0, 0); }
    }
    const float inv = 1.f / lrun; const size_t row = (size_t)b * SEQ + tokq;
    bf16_t* orow = PO + ((size_t)br * MTOK + row) * 512 + h * 64 + 4 * kq;
#pragma unroll
    for (int mm = 0; mm < 4; ++mm) { u32x2 w; w.x = pk2(o[mm][0] * inv, o[mm][1] * inv); w.y = pk2(o[mm][2] * inv, o[mm][3] * inv); *(u32x2*)(orow + 16 * mm) = w; }
    if (kq == 0) { PM[((size_t)br * MTOK + row) * 8 + h] = mrun; PL[((size_t)br * MTOK + row) * 8 + h] = lrun; }
}

constexpr int S5_WAVE_BYTES = 12544;
__device__ __forceinline__ void s5_unit(const bf16_t* Z, const unsigned char* tab, const float* dskip, bf16_t* Y5, LAS unsigned char* lds, int unit, int wave, int lane) {
    const int b = unit >> 2, g = (unit & 3) * 8 + wave;
    LAS float* bus = (LAS float*)(lds + wave * S5_WAVE_BYTES);
    LAS bf16_t* hs = (LAS bf16_t*)(lds + wave * S5_WAVE_BYTES + 8192);
    const int n = lane & 15, kg = lane >> 4;
    const bf16_t* BMt = (const bf16_t*)(tab + S5_BM); const bf16_t* CMt = (const bf16_t*)(tab + S5_CM); const float* AB = (const float*)(tab + S5_ABAR);
    bf16x8 bm[8], cm[4];
#pragma unroll
    for (int nt = 0; nt < 8; ++nt) bm[nt] = *(const bf16x8*)(BMt + ((size_t)(g * 128 + 16 * nt + n)) * 32 + 8 * kg);
#pragma unroll
    for (int kk = 0; kk < 4; ++kk) cm[kk] = *(const bf16x8*)(CMt + ((size_t)(g * 16 + n)) * 128 + 32 * kk + 8 * kg);
    const float dsk = dskip[g * 16 + n];
    const float ar = AB[(g * 64 + lane) * 2], ai = AB[(g * 64 + lane) * 2 + 1];
    float hr = 0.f, hi = 0.f;
    const bf16_t* ub = Z + (size_t)b * SEQ * 2048 + 1536 + g * 16;
    bf16_t* yb = Y5 + (size_t)b * SEQ * 512 + g * 16 + n;
    for (int t0 = 0; t0 < SEQ; t0 += 16) {
        bf16x8 uf = {0, 0, 0, 0, 0, 0, 0, 0};
        if (kg < 2) uf = *(const bf16x8*)(ub + (size_t)(t0 + n) * 2048 + 8 * kg);
#pragma unroll
        for (int nt = 0; nt < 8; ++nt) { f32x4 d = {0.f, 0.f, 0.f, 0.f}; d = __builtin_amdgcn_mfma_f32_16x16x32_bf16(uf, bm[nt], d, 0, 0, 0);
#pragma unroll
            for (int i = 0; i < 4; ++i) bus[(4 * kg + i) * 128 + 16 * nt + n] = d[i]; }
        LDS_WAIT();
#pragma unroll
        for (int t = 0; t < 16; ++t) { const float bre = bus[t * 128 + lane], bim = bus[t * 128 + 64 + lane];
            const float nr = ar * hr - ai * hi + bre, ni = ar * hi + ai * hr + bim; hr = nr; hi = ni;
            hs[t * 136 + lane] = (bf16_t)f2bf(hr); hs[t * 136 + 64 + lane] = (bf16_t)f2bf(hi); }
        LDS_WAIT();
        f32x4 y = {0.f, 0.f, 0.f, 0.f};
#pragma unroll
        for (int kk = 0; kk < 4; ++kk) { const bf16x8 hf = *(const LAS bf16x8*)(hs + n * 136 + 32 * kk + 8 * kg); y = __builtin_amdgcn_mfma_f32_16x16x32_bf16(hf, cm[kk], y, 0, 0, 0); }
#pragma unroll
        for (int i = 0; i < 4; ++i) { const int t = t0 + 4 * kg + i; const float u = bf2f(ub[(size_t)t * 2048 + n]); const float v = gelu_tanh(y[i] + dsk * u); yb[(size_t)t * 512] = (bf16_t)f2bf(v); }
        LDS_WAIT();
    }
}

__global__ void __launch_bounds__(NTHREADS, 2) mega(Args a) {
    extern __shared__ __attribute__((aligned(16))) unsigned char lds_raw[];
    LAS unsigned char* lds = (LAS unsigned char*)lds_raw;
    cg::grid_group grid = cg::this_grid();
    const int tid = threadIdx.x, lane = tid & 63, wave = __builtin_amdgcn_readfirstlane(tid >> 6);
    const int G = gridDim.x, bx = blockIdx.x;
    const int gw = bx * NWAVES + wave, NGW = G * NWAVES;
    const int gt = bx * NTHREADS + tid, NGT = G * NTHREADS;
    unsigned char* ws = a.ws;
    const float* x_in = a.in[0]; const int* positions = (const int*)a.in[1];
    const float *g_mix_pre = a.in[2], *g_mix_post = a.in[3], *g_ffn_pre = a.in[4], *g_ffn_post = a.in[5];
    bf16_t* HN = (bf16_t*)(ws + WS_HN); bf16_t* Z = (bf16_t*)(ws + WS_Z); bf16_t* YC = (bf16_t*)(ws + WS_YC); bf16_t* MIX = (bf16_t*)(ws + WS_MIX);
    bf16_t* PO = (bf16_t*)(ws + WS_PO); float* PM = (float*)(ws + WS_PM); float* PL = (float*)(ws + WS_PL); bf16_t* Y5 = (bf16_t*)(ws + WS_Y5);
    bf16_t* HID = (bf16_t*)(ws + WS_HID); bf16_t* XC = (bf16_t*)(ws + WS_XC); bf16_t* BB = (bf16_t*)(ws + WS_BB); bf16_t* Y1 = (bf16_t*)(ws + WS_Y1); bf16_t* LA = (bf16_t*)(ws + WS_LA);
    float* ROPE = (float*)(ws + WS_ROPE); unsigned char* S5T = ws + WS_S5TAB; float* SP = (float*)(S5T + S5_SP);
    float* X = a.out;
    const int lo = a.ph_lo, hi = a.ph_hi;
#ifndef PHMASK
#define PHMASK 0xFFFFFFFFu
#endif
#define IN(k) (((PHMASK >> (k)) & 1u) && lo <= (k) && (k) < hi)
#define SEAM(k) do { if (IN(k) && IN((k) + 1)) grid.sync(); } while (0)

    if (IN(0)) {
        LAS float* scr = (LAS float*)(lds + wave * 8448);
        constexpr int I_IN = 16 * 64, I_OUT = 16 * 32, I_GLU = 8 * 16, I_GATE = 4 * 64, I_UP = 16 * 176, I_DN = 44 * 32;
        constexpr int NITEMS = 2 * I_IN + 2 * I_OUT + I_GLU + I_GATE + 2 * I_UP + 2 * I_DN;
        for (int it = gw; it < NITEMS; it += NGW) {
            int r = it;
            if (r < I_IN) { const int kb = r / 64, nb = r % 64; transpose_item(a.in[6] + nb * 32, 2048, 1024, (bf16_t*)(ws + WS_W_IN0) + (size_t)nb * 32 * 1024, kb * 64, scr, lane); continue; } r -= I_IN;
            if (r < I_IN) { const int kb = r / 64, nb = r % 64; transpose_item(a.in[17] + nb * 32, 2048, 1024, (bf16_t*)(ws + WS_W_IN1) + (size_t)nb * 32 * 1024, kb * 64, scr, lane); continue; } r -= I_IN;
            if (r < I_OUT) { const int kb = r / 32, nb = r % 32; transpose_item(a.in[7] + nb * 32, 1024, 1024, (bf16_t*)(ws + WS_W_OUT0) + (size_t)nb * 32 * 1024, kb * 64, scr, lane); continue; } r -= I_OUT;
            if (r < I_OUT) { const int kb = r / 32, nb = r % 32; transpose_item(a.in[18] + nb * 32, 1024, 1024, (bf16_t*)(ws + WS_W_OUT1) + (size_t)nb * 32 * 1024, kb * 64, scr, lane); continue; } r -= I_OUT;
            if (r < I_GLU) { const int kb = r / 16, nb = r % 16; transpose_item(a.in[16] + nb * 32, 512, 512, (bf16_t*)(ws + WS_W_GLU) + (size_t)nb * 32 * 512, kb * 64, scr, lane); continue; } r -= I_GLU;
            if (r < I_GATE) { const int kb = r / 64, nb = r % 64; const int n0 = nb * 32, pn = n0 >> 8, half = (n0 >> 7) & 1, j = n0 & 127, hh = pn >> 1, colg = (pn & 1) * 128 + j;
                const float* src = (half ? a.in[23] : a.in[21]) + (size_t)hh * 256 * 256 + colg;
                transpose_item(src, 256, 256, (bf16_t*)(ws + WS_W_GATE) + (size_t)n0 * 256, kb * 64, scr, lane); continue; } r -= I_GATE;
            if (r < 2 * I_UP) { const int layer = r / I_UP; r -= layer * I_UP; const int kb = r / 176, nb = r % 176; const int n0 = nb * 32, t = n0 >> 8, half = (n0 >> 7) & 1, j = n0 & 127;
                const float* src = (half ? a.in[27] : a.in[26]) + (size_t)layer * 1024 * FFH + t * 128 + j;
                transpose_item(src, FFH, 1024, (bf16_t*)(ws + (layer ? WS_W_UP1 : WS_W_UP0)) + (size_t)n0 * 1024, kb * 64, scr, lane); continue; } r -= 2 * I_UP;
            { const int layer = r / I_DN; r -= layer * I_DN; const int kb = r / 32, nb = r % 32;
                transpose_item(a.in[28] + (size_t)layer * FFH * 1024 + nb * 32, 1024, FFH, (bf16_t*)(ws + (layer ? WS_W_DN1 : WS_W_DN0)) + (size_t)nb * 32 * FFH, kb * 64, scr, lane); }
        }
        for (int idx = gt; idx < MTOK * 8; idx += NGT) { const int tok = idx >> 3, j = idx & 7; const float inv_freq = powf(500000.0f, -(float)j * 0.125f);
            const float ang = (float)positions[tok] * inv_freq; float s, c; sincos_rr(ang, s, c); ROPE[(size_t)tok * 16 + j] = c; ROPE[(size_t)tok * 16 + 8 + j] = s; }
        for (int idx = gt; idx < 32 * 64; idx += NGT) { const int g = idx >> 6, p = idx & 63;
            const float are = a.in[8][idx], aim = a.in[9][idx], dt = expf(a.in[10][g]);
            const float xr = are * dt, yi = aim * dt; const float ex = expf(xr); float sn, cs; sincos_rr(yi, sn, cs);
            const float abr = ex * cs, abi = ex * sn;
            float sh, ch; sincos_rr(0.5f * yi, sh, ch); (void)ch;
            const float nre = expm1f(xr) * cs - 2.f * sh * sh, nim = abi;
            const float den = 1.f / (are * are + aim * aim);
            const float cre = (nre * are + nim * aim) * den, cim = (nim * are - nre * aim) * den;
            float* AB = (float*)(S5T + S5_ABAR); AB[idx * 2] = abr; AB[idx * 2 + 1] = abi;
            bf16_t* BMt = (bf16_t*)(S5T + S5_BM); bf16_t* CMt = (bf16_t*)(S5T + S5_CM);
            for (int c = 0; c < 16; ++c) { const float bre = a.in[11][(size_t)idx * 16 + c], bim = a.in[12][(size_t)idx * 16 + c];
                BMt[((size_t)g * 128 + p) * 32 + c] = (bf16_t)f2bf(cre * bre - cim * bim); BMt[((size_t)g * 128 + 64 + p) * 32 + c] = (bf16_t)f2bf(cre * bim + cim * bre);
                BMt[((size_t)g * 128 + p) * 32 + 16 + c] = 0; BMt[((size_t)g * 128 + 64 + p) * 32 + 16 + c] = 0;
                CMt[((size_t)g * 16 + c) * 128 + p] = (bf16_t)f2bf(a.in[13][((size_t)g * 16 + c) * 64 + p]); CMt[((size_t)g * 16 + c) * 128 + 64 + p] = (bf16_t)f2bf(-a.in[14][((size_t)g * 16 + c) * 64 + p]); } }
        for (int idx = gt; idx < 1024; idx += NGT) SP[idx] = log1pf(expf(-a.in[25][idx]));
        for (int m = gw; m < MTOK; m += NGW) rms_row_to_bf16(x_in + (size_t)m * DM, g_mix_pre, HN + (size_t)m * DM, lane);
    }
    SEAM(0);
    if (IN(1)) { pg8::Gemm g{HN, (const bf16_t*)(ws + WS_W_IN0), MTOK, 2048, 1024, 1024, 0}; pg8::StaticOrder S; S.init(MTOK, 2048, G, bx);
        pg8::EpiRope E{Z, ROPE}; pg8::gemm_phase(lds, g, S, E); }
    SEAM(1);
    if (IN(2)) {
        if (bx < 128) s5_unit(Z, S5T, a.in[15], Y5, lds, bx, wave, lane);
        for (int u = bx; u < 12288; u += G) attn_unit(Z, PO, PM, PL, lds, u, tid, wave, lane);
    }
    SEAM(2);
    if (IN(3)) {
        for (int idx = gt; idx < MTOK * 64; idx += NGT) { const int row = idx >> 6, c8 = idx & 63, h = c8 >> 3;
            float mv[3], lv[3]; u32x4 ow[3];
#pragma unroll
            for (int i = 0; i < 3; ++i) { mv[i] = PM[((size_t)i * MTOK + row) * 8 + h]; lv[i] = PL[((size_t)i * MTOK + row) * 8 + h]; ow[i] = *(const u32x4*)(PO + ((size_t)i * MTOK + row) * 512 + c8 * 8); }
            const float mx = fmaxf(mv[0], fmaxf(mv[1], mv[2]));
            float w[3]; float den = 0.f;
#pragma unroll
            for (int i = 0; i < 3; ++i) { w[i] = fast_exp2(mv[i] - mx) * lv[i]; den += w[i]; }
            const float inv = 1.f / den; f32x4 v0 = {0.f, 0.f, 0.f, 0.f}, v1 = v0;
#pragma unroll
            for (int i = 0; i < 3; ++i) { const float ww = w[i] * inv;
                v0[0] += ww * bflo(ow[i].x); v0[1] += ww * bfhi(ow[i].x); v0[2] += ww * bflo(ow[i].y); v0[3] += ww * bfhi(ow[i].y);
                v1[0] += ww * bflo(ow[i].z); v1[1] += ww * bfhi(ow[i].z); v1[2] += ww * bflo(ow[i].w); v1[3] += ww * bfhi(ow[i].w); }
            pg8::st8(YC + (size_t)row * 1024 + c8 * 8, v0, v1); }
        __syncthreads();
        pg8::Gemm g{Y5, (const bf16_t*)(ws + WS_W_GLU), MTOK, 512, 512, 512, 0}; pg8::StaticOrder S; S.init(MTOK, 512, G, bx);
        pg8::EpiGlu E{Y5, YC}; pg8::gemm_phase(lds, g, S, E);
    }
    SEAM(3);
    if (IN(4)) { pg8::Gemm g{YC, (const bf16_t*)(ws + WS_W_OUT0), MTOK, 1024, 1024, 1024, 0}; pg8::StaticOrder S; S.init(MTOK, 1024, G, bx);
        pg8::EpiPlain E{MIX, 1024}; pg8::gemm_phase(lds, g, S, E); }
    SEAM(4);
    if (IN(5)) for (int m = gw; m < MTOK; m += NGW) resnorm_row(x_in + (size_t)m * DM, MIX + (size_t)m * DM, g_mix_post, X + (size_t)m * DM, g_ffn_pre, HN + (size_t)m * DM, lane);
    SEAM(5);
    if (IN(6)) { pg8::Gemm g{HN, (const bf16_t*)(ws + WS_W_UP0), MTOK, 2 * FFH, 1024, 1024, 0}; pg8::StaticOrder S; S.init(MTOK, 2 * FFH, G, bx);
        pg8::EpiSwiGlu E{HID}; pg8::gemm_phase(lds, g, S, E); }
    SEAM(6);
    if (IN(7)) { pg8::Gemm g{HID, (const bf16_t*)(ws + WS_W_DN0), MTOK, 1024, FFH, FFH, 0}; pg8::StaticOrder S; S.init(MTOK, 1024, G, bx);
        pg8::EpiPlain E{MIX, 1024}; pg8::gemm_phase(lds, g, S, E); }
    SEAM(7);
    if (IN(8)) for (int m = gw; m < MTOK; m += NGW) resnorm_row(X + (size_t)m * DM, MIX + (size_t)m * DM, g_ffn_post, X + (size_t)m * DM, g_mix_pre + DM, HN + (size_t)m * DM, lane);
    SEAM(8);
    if (IN(9)) { pg8::Gemm g{HN, (const bf16_t*)(ws + WS_W_IN1), MTOK, 2048, 1024, 1024, 0}; pg8::StaticOrder S; S.init(MTOK, 2048, G, bx);
        pg8::EpiIn1 E{Z}; pg8::gemm_phase(lds, g, S, E); }
    SEAM(9);
    if (IN(10)) {
        const float* cw = a.in[19]; const float* cb = a.in[20];
        for (int idx = gt; idx < (MTOK / 8) * 128; idx += NGT) { const int c8 = idx & 127, tb = idx >> 7, row0 = tb * 8, c0 = c8 * 8; const int t0 = row0 & (SEQ - 1);
            float w[4][8], bias[8];
#pragma unroll
            for (int k = 0; k < 4; ++k) { const f32x4 wa = *(const f32x4*)(cw + k * 1024 + c0), wb = *(const f32x4*)(cw + k * 1024 + c0 + 4);
                w[k][0] = wa.x; w[k][1] = wa.y; w[k][2] = wa.z; w[k][3] = wa.w; w[k][4] = wb.x; w[k][5] = wb.y; w[k][6] = wb.z; w[k][7] = wb.w; }
            { const f32x4 ba = *(const f32x4*)(cb + c0), bb = *(const f32x4*)(cb + c0 + 4); bias[0] = ba.x; bias[1] = ba.y; bias[2] = ba.z; bias[3] = ba.w; bias[4] = bb.x; bias[5] = bb.y; bias[6] = bb.z; bias[7] = bb.w; }
            float xm[3][8];
#pragma unroll
            for (int k = 0; k < 3; ++k) { u32x4 v = {0u, 0u, 0u, 0u}; if (t0 - 3 + k >= 0) v = *(const u32x4*)(Z + (size_t)(row0 - 3 + k) * 2048 + c0);
                xm[k][0] = bflo(v.x); xm[k][1] = bfhi(v.x); xm[k][2] = bflo(v.y); xm[k][3] = bfhi(v.y); xm[k][4] = bflo(v.z); xm[k][5] = bfhi(v.z); xm[k][6] = bflo(v.w); xm[k][7] = bfhi(v.w); }
#pragma unroll
            for (int r = 0; r < 8; ++r) { const u32x4 v = *(const u32x4*)(Z + (size_t)(row0 + r) * 2048 + c0);
                const float xc[8] = {bflo(v.x), bfhi(v.x), bflo(v.y), bfhi(v.y), bflo(v.z), bfhi(v.z), bflo(v.w), bfhi(v.w)};
                f32x4 o0, o1;
#pragma unroll
                for (int i = 0; i < 8; ++i) { const float o = bias[i] + w[0][i] * xm[0][i] + w[1][i] * xm[1][i] + w[2][i] * xm[2][i] + w[3][i] * xc[i];
                    if (i < 4) o0[i] = o; else o1[i - 4] = o; xm[0][i] = xm[1][i]; xm[1][i] = xm[2][i]; xm[2][i] = xc[i]; }
                pg8::st8(XC + (size_t)(row0 + r) * 1024 + c0, o0, o1); } }
    }
    SEAM(10);
    if (IN(11)) { pg8::Gemm g{XC, (const bf16_t*)(ws + WS_W_GATE), MTOK, 2048, 256, 1024, 1}; pg8::StaticOrder S; S.init(MTOK, 2048, G, bx);
        pg8::EpiGates E{XC, LA, BB, a.in[22], a.in[24], SP}; pg8::gemm_phase(lds, g, S, E); }
    SEAM(11);
    if (IN(12)) {
        LAS float* car = (LAS float*)lds;
        for (int u = bx; u < 256; u += G) { const int b = u >> 3, c0 = (u & 7) * 128 + 2 * lane; const size_t rbase = (size_t)b * SEQ + wave * 256;
            const bf16_t* la = LA + rbase * 1024 + c0; const bf16_t* bb = BB + rbase * 1024 + c0;
            float h0 = 0.f, h1 = 0.f, s0 = 0.f, s1 = 0.f;
#pragma unroll 8
            for (int t = 0; t < 256; ++t) { const unsigned lw = *(const unsigned*)(la + (size_t)t * 1024), bw = *(const unsigned*)(bb + (size_t)t * 1024);
                const float l0 = bflo(lw), l1 = bfhi(lw); s0 += l0; s1 += l1;
                h0 = fast_exp2(l0 * LOG2E) * h0 + bflo(bw); h1 = fast_exp2(l1 * LOG2E) * h1 + bfhi(bw); }
            __syncthreads();
            car[(wave * 64 + lane) * 4 + 0] = fast_exp2(s0 * LOG2E); car[(wave * 64 + lane) * 4 + 1] = fast_exp2(s1 * LOG2E); car[(wave * 64 + lane) * 4 + 2] = h0; car[(wave * 64 + lane) * 4 + 3] = h1;
            __syncthreads();
            h0 = 0.f; h1 = 0.f;
            for (int j = 0; j < wave; ++j) { const f32x4 cv = *(const LAS f32x4*)(car + (j * 64 + lane) * 4); h0 = cv.x * h0 + cv.z; h1 = cv.y * h1 + cv.w; }
            const bf16_t* gb = Z + rbase * 2048 + 1024 + c0; bf16_t* yo = Y1 + rbase * 1024 + c0;
#pragma unroll 8
            for (int t = 0; t < 256; ++t) { const unsigned lw = *(const unsigned*)(la + (size_t)t * 1024), bw = *(const unsigned*)(bb + (size_t)t * 1024), gwv = *(const unsigned*)(gb + (size_t)t * 2048);
                h0 = fast_exp2(bflo(lw) * LOG2E) * h0 + bflo(bw); h1 = fast_exp2(bfhi(lw) * LOG2E) * h1 + bfhi(bw);
                *(unsigned*)(yo + (size_t)t * 1024) = pk2(h0 * bflo(gwv), h1 * bfhi(gwv)); }
        }
    }
    SEAM(12);
    if (IN(13)) { pg8::Gemm g{Y1, (const bf16_t*)(ws + WS_W_OUT1), MTOK, 1024, 1024, 1024, 0}; pg8::StaticOrder S; S.init(MTOK, 1024, G, bx);
        pg8::EpiPlain E{MIX, 1024}; pg8::gemm_phase(lds, g, S, E); }
    SEAM(13);
    if (IN(14)) for (int m = gw; m < MTOK; m += NGW) resnorm_row(X + (size_t)m * DM, MIX + (size_t)m * DM, g_mix_post + DM, X + (size_t)m * DM, g_ffn_pre + DM, HN + (size_t)m * DM, lane);
    SEAM(14);
    if (IN(15)) { pg8::Gemm g{HN, (const bf16_t*)(ws + WS_W_UP1), MTOK, 2 * FFH, 1024, 1024, 0}; pg8::StaticOrder S; S.init(MTOK, 2 * FFH, G, bx);
        pg8::EpiSwiGlu E{HID}; pg8::gemm_phase(lds, g, S, E); }
    SEAM(15);
    if (IN(16)) { pg8::Gemm g{HID, (const bf16_t*)(ws + WS_W_DN1), MTOK, 1024, FFH, FFH, 0}; pg8::StaticOrder S; S.init(MTOK, 1024, G, bx);
        pg8::EpiPlain E{MIX, 1024}; pg8::gemm_phase(lds, g, S, E); }
    SEAM(16);
    if (IN(17)) for (int m = gw; m < MTOK; m += NGW) resnorm_row(X + (size_t)m * DM, MIX + (size_t)m * DM, g_ffn_post + DM, X + (size_t)m * DM, nullptr, nullptr, lane);
#undef IN
#undef SEAM
}
constexpr int NPHASES = 18;

extern "C" void kernel_launch(void* const* d_in, const int* in_sizes, int n_in, void* d_out, int out_size, void* d_ws, size_t ws_size, hipStream_t stream) {
    static int grid = 0;
    if (grid == 0) {
        if (n_in != 29 || in_sizes[0] != MTOK * DM || out_size != MTOK * DM || ws_size < WS_END) {
            fprintf(stderr, "kernel_launch: unexpected shapes: n_in %d in0 %d out %d ws %zu (need %zu)\n", n_in, n_in > 0 ? in_sizes[0] : -1, out_size, ws_size, (size_t)WS_END); grid = -1; return; }
        int dev = 0, cus = 0, per_cu = 0;
        hipGetDevice(&dev); hipDeviceGetAttribute(&cus, hipDeviceAttributeMultiprocessorCount, dev);
        if (hipFuncSetAttribute((const void*)mega, hipFuncAttributeMaxDynamicSharedMemorySize, LDS_BYTES) != hipSuccess) { fprintf(stderr, "kernel_launch: hipFuncSetAttribute failed\n"); grid = -1; return; }
        if (hipOccupancyMaxActiveBlocksPerMultiprocessor(&per_cu, (const void*)mega, NTHREADS, LDS_BYTES) != hipSuccess || per_cu < 1) { fprintf(stderr, "kernel_launch: occupancy query says %d\n", per_cu); per_cu = 1; }
        (void)hipGetLastError();
        grid = cus;
    }
    if (grid < 0) return;
    Args a{};
    for (int i = 0; i < 29; ++i) a.in[i] = (const float*)d_in[i];
    a.out = (float*)d_out; a.ws = (unsigned char*)d_ws;
#if N_LAUNCH_MODE == 1
    a.ph_lo = 0; a.ph_hi = NPHASES;
    void* args[] = {&a};
    hipError_t e = hipLaunchCooperativeKernel((const void*)mega, dim3(grid), dim3(NTHREADS), args, LDS_BYTES, stream);
    if (e != hipSuccess) fprintf(stderr, "cooperative launch failed: %s (grid %d)\n", hipGetErrorString(e), grid);
#else
    for (int ph = 0; ph < NPHASES; ++ph) { a.ph_lo = ph; a.ph_hi = ph + 1; hipLaunchKernelGGL(mega, dim3(grid), dim3(NTHREADS), LDS_BYTES, stream, a); }
#endif
}
```

```cpp
#include <hip/hip_runtime.h>
#include <hip/hip_cooperative_groups.h>
#include <cstdio>
#include <cstdint>
namespace cg = cooperative_groups;

#ifndef N_LAUNCH_MODE
#define N_LAUNCH_MODE 1
#endif

#define LAS __attribute__((address_space(3)))
typedef unsigned short bf16_t;
typedef short bf16x8 __attribute__((ext_vector_type(8)));
typedef float f32x4 __attribute__((ext_vector_type(4)));
typedef unsigned u32x4 __attribute__((ext_vector_type(4)));
typedef unsigned u32x2 __attribute__((ext_vector_type(2)));

constexpr int MTOK = 65536, DM = 1024, SEQ = 2048, NBATCH = 32, FFH = 2816;
constexpr float NORM_EPS = 1e-6f;
constexpr float LOG2E = 1.4426950408889634f;
constexpr int NWAVES = 8, NTHREADS = 512;
constexpr int LDS_BYTES = 136 * 1024;

constexpr size_t MiB = 1u << 20;
constexpr size_t WS_CTL = 0;
constexpr size_t WS_W_IN0 = 1 * MiB, WS_W_OUT0 = 5 * MiB, WS_W_GLU = 7 * MiB, WS_W_IN1 = 8 * MiB, WS_W_OUT1 = 12 * MiB, WS_W_GATE = 14 * MiB;
constexpr size_t WS_W_UP0 = 15 * MiB, WS_W_UP1 = 26 * MiB, WS_W_DN0 = 37 * MiB, WS_W_DN1 = 43 * MiB;
constexpr size_t WS_ROPE = 49 * MiB;
constexpr size_t WS_S5TAB = 53 * MiB;
constexpr size_t S5_ABAR = 0, S5_BM = 16384, S5_CM = 16384 + 262144, S5_SP = 16384 + 262144 + 131072;
constexpr size_t WS_HN = 64 * MiB, WS_Z = 192 * MiB, WS_YC = 448 * MiB, WS_MIX = 576 * MiB, WS_PO = 704 * MiB, WS_PM = 896 * MiB, WS_PL = 902 * MiB, WS_Y5 = 908 * MiB;
constexpr size_t WS_HID = 192 * MiB;
constexpr size_t WS_XC = 448 * MiB, WS_BB = 576 * MiB, WS_Y1 = 704 * MiB, WS_LA = 832 * MiB;
constexpr size_t WS_END = 972 * MiB;

struct Args { const float* in[29]; float* out; unsigned char* ws; int ph_lo, ph_hi; };

__device__ __forceinline__ unsigned f2bf(float f) { unsigned u = __builtin_bit_cast(unsigned, f); return (u + 0x7fffu + ((u >> 16) & 1u)) >> 16; }
__device__ __forceinline__ unsigned pk2(float lo, float hi) { return f2bf(lo) | (f2bf(hi) << 16); }
__device__ __forceinline__ float bf2f(unsigned short h) { return __builtin_bit_cast(float, (unsigned)h << 16); }
__device__ __forceinline__ float bflo(unsigned w) { return __builtin_bit_cast(float, w << 16); }
__device__ __forceinline__ float bfhi(unsigned w) { return __builtin_bit_cast(float, w & 0xffff0000u); }
__device__ __forceinline__ float fast_exp2(float x) { return __builtin_amdgcn_exp2f(x); }
__device__ __forceinline__ float fast_rcp(float x) { return __builtin_amdgcn_rcpf(x); }
__device__ __forceinline__ float sigmoidf_(float x) { return fast_rcp(1.f + fast_exp2(-x * LOG2E)); }
__device__ __forceinline__ float gelu_tanh(float x) { const float u = 0.7978845608028654f * (x + 0.044715f * x * x * x); return x * sigmoidf_(2.f * u); }
__device__ __forceinline__ float wave_sum(float v) {
#pragma unroll
    for (int o = 1; o < 64; o <<= 1) v += __shfl_xor(v, o);
    return v;
}
#define LDS_WAIT() asm volatile("s_waitcnt lgkmcnt(0)" ::: "memory")

namespace pg8 {
constexpr int BM = 256, BK = 64, HALF = 128, HTB = HALF * BK * 2, STAGE_BYTES = 8 * HTB, NXCD = 8, WGM = 8;
__host__ __device__ __forceinline__ int lds_byte(int r, int c) { const int st = (r >> 4) * 2 + (c >> 5), rr = r & 15, cc = c & 31, ob = rr * 64 + cc * 2; return st * 1024 + (ob ^ (((ob >> 9) & 1) << 5)); }
__host__ __device__ __forceinline__ void stage_rc(int b, int& R, int& C) { const int st = b / 1024, sb = b % 1024, swz = sb ^ (((sb >> 9) & 1) << 5); R = (st >> 1) * 16 + swz / 64; C = (st & 1) * 32 + (swz % 64) / 2; }
__host__ __device__ __forceinline__ int perm32(int rho) { const int n = rho >> 4, i = rho & 15; return 8 * (i >> 2) + 4 * n + (i & 3); }
struct Unit { int pm, pn; };
struct Gemm { const bf16_t* A; const bf16_t* Bt; int M, N, K, lda, grp; };
struct StaticOrder {
    int nM, nN, nwg, G, c;
    __host__ __device__ void init(int M, int N, int G_, int c_) { nM = M / BM; nN = N / BM; nwg = nM * nN; G = G_; c = c_; }
    __host__ __device__ bool next(int i, Unit& u) const {
        const long L = (long)i * G + c; if (L >= nwg) return false;
        int wgid = (int)L; { const int q = nwg / NXCD, r = nwg % NXCD, xcd = wgid % NXCD, off = wgid / NXCD; wgid = (xcd < r ? xcd * (q + 1) : r * (q + 1) + (xcd - r) * q) + off; }
        const int nig = WGM * nN, gid = wgid / nig, fm = gid * WGM, gsz = (nM - fm) < WGM ? (nM - fm) : WGM;
        u.pm = fm + ((wgid % nig) % gsz); u.pn = (wgid % nig) / gsz; return true;
    }
};
template <class Epi>
__device__ __forceinline__ void gemm_phase(LAS unsigned char* lds, const Gemm g, const StaticOrder& S, const Epi& E) {
    int tid_ = threadIdx.x; asm volatile("" : "+v"(tid_));
    const int tid = tid_, wid = __builtin_amdgcn_readfirstlane(tid >> 6), lane = tid & 63, wr = wid >> 2, wc = wid & 3, fr = lane & 15, fq = lane >> 4;
    const int K = g.K, nt = K / BK, lda = g.lda;
    unsigned voffA[2], voffB[2];
#pragma unroll
    for (int i = 0; i < 2; ++i) { int R, C; stage_rc(tid * 16 + i * 8192, R, C); const int Rb = (R & ~31) + perm32(R & 31);
        voffA[i] = (unsigned)(R * lda + C) * 2u; voffB[i] = (unsigned)(Rb * K + C) * 2u; }
    const size_t kstep = (size_t)(BK * 2);
    const size_t hstepA = (size_t)HALF * lda * 2, hstepB = (size_t)HALF * K * 2;
    const size_t tstepA = 2 * hstepA, tstepB = 2 * hstepB;
    const unsigned ldsw = (unsigned)wid * 1024u;
    const int aoff = lds_byte(wr * 64 + fr, fq * 8), boff = lds_byte(wc * 32 + fr, fq * 8);
#define PG8_SA(b, h) (((b) * 2 + (h)) * HTB)
#define PG8_SB(b, h) ((4 + (b) * 2 + (h)) * HTB)
#define PG8_STAGE(bufoff, gbase, voff) do { _Pragma("unroll") for (int _i = 0; _i < 2; ++_i) \
        __builtin_amdgcn_global_load_lds((const unsigned*)((const char*)(gbase) + (voff)[_i]), (LAS unsigned*)(lds + (bufoff) + ldsw + _i * 8192), 16, 0, 0); } while (0)
#define PG8_LDA(dst, b, h) do { _Pragma("unroll") for (int m = 0; m < 4; ++m) _Pragma("unroll") for (int k = 0; k < 2; ++k) dst[m][k] = *(const LAS bf16x8*)(lds + PG8_SA(b, h) + aoff + m * 2048 + k * 1024); } while (0)
#define PG8_LDB(dst, b, h) do { _Pragma("unroll") for (int n = 0; n < 2; ++n) _Pragma("unroll") for (int k = 0; k < 2; ++k) dst[n][k] = *(const LAS bf16x8*)(lds + PG8_SB(b, h) + boff + n * 2048 + k * 1024); } while (0)
#define PG8_MMA(ai, bj, At, Bt) do { __builtin_amdgcn_s_setprio(1); _Pragma("unroll") for (int m = 0; m < 4; ++m) _Pragma("unroll") for (int n = 0; n < 2; ++n) _Pragma("unroll") for (int k = 0; k < 2; ++k) \
        acc[ai][bj][m][n] = __builtin_amdgcn_mfma_f32_16x16x32_bf16(Bt[n][k], At[m][k], acc[ai][bj][m][n], 0, 0, 0); __builtin_amdgcn_s_setprio(0); } while (0)
#define PG8_WAIT_V(n) asm volatile("s_waitcnt vmcnt(" #n ")" ::: "memory")
#define PG8_WAIT_L(n) asm volatile("s_waitcnt lgkmcnt(" #n ")" ::: "memory")
#define PG8_BAR __builtin_amdgcn_s_barrier()
#define PG8_SCHED __builtin_amdgcn_sched_barrier(0)
    Unit cur, nxt; int ui = 0;
    if (!S.next(0, cur)) return;
    f32x4 acc[2][2][4][2];
#pragma unroll
    for (int a = 0; a < 2; ++a)
#pragma unroll
        for (int b = 0; b < 2; ++b)
#pragma unroll
            for (int m = 0; m < 4; ++m)
#pragma unroll
                for (int n = 0; n < 2; ++n) acc[a][b][m][n] = (f32x4){0.f, 0.f, 0.f, 0.f};
    bf16x8 At[4][2], B0[2][2], B1[2][2];
    const char* cA = (const char*)g.A + (size_t)cur.pm * tstepA + (g.grp ? (size_t)(cur.pn >> 1) * K * 2 : 0); const char* cB = (const char*)g.Bt + (size_t)cur.pn * tstepB;
    PG8_STAGE(PG8_SB(0, 0), cB, voffB); PG8_STAGE(PG8_SB(0, 1), cB + hstepB, voffB); PG8_STAGE(PG8_SA(0, 0), cA, voffA); PG8_STAGE(PG8_SA(0, 1), cA + hstepA, voffA);
    if (wr == 1) PG8_BAR;
    PG8_WAIT_V(2); PG8_BAR;
    PG8_STAGE(PG8_SB(1, 0), cB + kstep, voffB); PG8_STAGE(PG8_SA(1, 0), cA + kstep, voffA); PG8_STAGE(PG8_SB(1, 1), cB + hstepB + kstep, voffB);
    PG8_WAIT_V(6); PG8_BAR;
    for (;;) {
        const bool has_next = S.next(ui + 1, nxt);
        const char* nA = has_next ? (const char*)g.A + (size_t)nxt.pm * tstepA + (g.grp ? (size_t)(nxt.pn >> 1) * K * 2 : 0) : cA; const char* nB = has_next ? (const char*)g.Bt + (size_t)nxt.pn * tstepB : cB;
        for (int t = 0; t < nt; t += 2) {
            const bool last = (t == nt - 2);
            const char* a1 = cA + (size_t)(t + 1) * kstep;
            const char* a2 = last ? nA : cA + (size_t)(t + 2) * kstep; const char* b2 = last ? nB : cB + (size_t)(t + 2) * kstep;
            const char* a3 = a2 + kstep; const char* b3 = b2 + kstep;
            PG8_LDB(B0, 0, 0); PG8_LDB(B1, 0, 1); PG8_SCHED; PG8_LDA(At, 0, 0); PG8_STAGE(PG8_SA(1, 1), a1 + hstepA, voffA);
            PG8_WAIT_V(8); PG8_WAIT_L(0); PG8_BAR; PG8_MMA(0, 0, At, B0); PG8_MMA(0, 1, At, B1); PG8_BAR; PG8_SCHED;
            PG8_LDA(At, 0, 1); PG8_STAGE(PG8_SB(0, 0), b2, voffB); PG8_STAGE(PG8_SB(0, 1), b2 + hstepB, voffB); PG8_STAGE(PG8_SA(0, 0), a2, voffA);
            PG8_WAIT_V(8); PG8_WAIT_L(0); PG8_BAR; PG8_MMA(1, 0, At, B0); PG8_MMA(1, 1, At, B1); PG8_BAR; PG8_SCHED;
            PG8_LDB(B0, 1, 0); PG8_LDB(B1, 1, 1); PG8_SCHED; PG8_LDA(At, 1, 0); PG8_STAGE(PG8_SA(0, 1), a2 + hstepA, voffA);
            PG8_WAIT_V(8); PG8_WAIT_L(0); PG8_BAR; PG8_MMA(0, 0, At, B0); PG8_MMA(0, 1, At, B1); PG8_BAR; PG8_SCHED;
            PG8_LDA(At, 1, 1); PG8_STAGE(PG8_SB(1, 0), b3, voffB); PG8_STAGE(PG8_SB(1, 1), b3 + hstepB, voffB); PG8_STAGE(PG8_SA(1, 0), a3, voffA);
            PG8_WAIT_V(8); PG8_WAIT_L(0); PG8_BAR; PG8_MMA(1, 0, At, B0); PG8_MMA(1, 1, At, B1); PG8_BAR; PG8_SCHED;
        }
        if (wr == 0) PG8_BAR;
        E(acc, cur, wr, wc, fr, fq);
        if (!has_next) break;
#pragma unroll
        for (int a = 0; a < 2; ++a)
#pragma unroll
            for (int b = 0; b < 2; ++b)
#pragma unroll
                for (int m = 0; m < 4; ++m)
#pragma unroll
                    for (int n = 0; n < 2; ++n) acc[a][b][m][n] = (f32x4){0.f, 0.f, 0.f, 0.f};
        cur = nxt; cA = nA; cB = nB; ++ui;
        if (wr == 1) PG8_BAR;
    }
    PG8_WAIT_V(0);
    PG8_BAR;
#undef PG8_SA
#undef PG8_SB
#undef PG8_STAGE
#undef PG8_LDA
#undef PG8_LDB
#undef PG8_MMA
#undef PG8_WAIT_V
#undef PG8_WAIT_L
#undef PG8_BAR
#undef PG8_SCHED
}
typedef f32x4 AccT[2][2][4][2];

__device__ __forceinline__ void st8(bf16_t* p, f32x4 v0, f32x4 v1) {
    u32x4 w; w.x = pk2(v0[0], v0[1]); w.y = pk2(v0[2], v0[3]); w.z = pk2(v1[0], v1[1]); w.w = pk2(v1[2], v1[3]); *(u32x4*)p = w;
}
struct EpiPlain {
    bf16_t* O; int ldc;
    __device__ __forceinline__ void operator()(const AccT& acc, const Unit& u, int wr, int wc, int fr, int fq) const {
        const int row0 = u.pm * BM + wr * 64 + fr, col0 = u.pn * BM + wc * 32 + 8 * fq;
#pragma unroll
        for (int ai = 0; ai < 2; ++ai)
#pragma unroll
            for (int m = 0; m < 4; ++m) { bf16_t* rowp = O + (size_t)(row0 + ai * HALF + m * 16) * ldc + col0;
#pragma unroll
                for (int bj = 0; bj < 2; ++bj) st8(rowp + bj * HALF, acc[ai][bj][m][0], acc[ai][bj][m][1]); }
    }
};
struct EpiRope {
    bf16_t* Z; const float* rope;
    __device__ __forceinline__ void operator()(const AccT& acc, const Unit& u, int wr, int wc, int fr, int fq) const {
        const int row0 = u.pm * BM + wr * 64 + fr, col0 = u.pn * BM + wc * 32 + 8 * fq;
        const bool ropew = (u.pn < 4) && !(wc & 1); const float sc = (u.pn < 2) ? 0.125f : 1.f;
#pragma unroll
        for (int ai = 0; ai < 2; ++ai)
#pragma unroll
            for (int m = 0; m < 4; ++m) { const int row = row0 + ai * HALF + m * 16; bf16_t* rowp = Z + (size_t)row * 2048 + col0;
                f32x4 c0 = {1.f, 1.f, 1.f, 1.f}, c1 = c0, s0 = {0.f, 0.f, 0.f, 0.f}, s1 = s0;
                if (ropew && fq < 2) { const f32x4* rp = (const f32x4*)(rope + (size_t)row * 16); c0 = rp[0]; c1 = rp[1]; s0 = rp[2]; s1 = rp[3]; if (fq == 0) { s0 = -s0; s1 = -s1; } }
#pragma unroll
                for (int bj = 0; bj < 2; ++bj) { f32x4 v0 = acc[ai][bj][m][0], v1 = acc[ai][bj][m][1];
                    if (ropew) { f32x4 p0, p1;
#pragma unroll
                        for (int i = 0; i < 4; ++i) { p0[i] = __shfl_xor(v0[i], 16); p1[i] = __shfl_xor(v1[i], 16); }
                        v0 = v0 * c0 + p0 * s0; v1 = v1 * c1 + p1 * s1; }
                    v0 = v0 * sc; v1 = v1 * sc; st8(rowp + bj * HALF, v0, v1); } }
    }
};
struct EpiGlu {
    const bf16_t* Y; bf16_t* O;
    __device__ __forceinline__ void operator()(const AccT& acc, const Unit& u, int wr, int wc, int fr, int fq) const {
        const int row0 = u.pm * BM + wr * 64 + fr, col0 = u.pn * BM + wc * 32 + 8 * fq;
#pragma unroll
        for (int ai = 0; ai < 2; ++ai)
#pragma unroll
            for (int m = 0; m < 4; ++m) { const int row = row0 + ai * HALF + m * 16;
#pragma unroll
                for (int bj = 0; bj < 2; ++bj) { const int col = col0 + bj * HALF; const u32x4 yw = *(const u32x4*)(Y + (size_t)row * 512 + col);
                    f32x4 a0 = acc[ai][bj][m][0], a1 = acc[ai][bj][m][1], v0, v1;
                    v0[0] = bflo(yw.x) * sigmoidf_(a0[0]); v0[1] = bfhi(yw.x) * sigmoidf_(a0[1]); v0[2] = bflo(yw.y) * sigmoidf_(a0[2]); v0[3] = bfhi(yw.y) * sigmoidf_(a0[3]);
                    v1[0] = bflo(yw.z) * sigmoidf_(a1[0]); v1[1] = bfhi(yw.z) * sigmoidf_(a1[1]); v1[2] = bflo(yw.w) * sigmoidf_(a1[2]); v1[3] = bfhi(yw.w) * sigmoidf_(a1[3]);
                    st8(O + (size_t)row * 1024 + 512 + col, v0, v1); } }
    }
};
struct EpiSwiGlu {
    bf16_t* O;
    __device__ __forceinline__ void operator()(const AccT& acc, const Unit& u, int wr, int wc, int fr, int fq) const {
        const int row0 = u.pm * BM + wr * 64 + fr, col0 = u.pn * HALF + wc * 32 + 8 * fq;
#pragma unroll
        for (int ai = 0; ai < 2; ++ai)
#pragma unroll
            for (int m = 0; m < 4; ++m) { const int row = row0 + ai * HALF + m * 16; f32x4 v[2];
#pragma unroll
                for (int n = 0; n < 2; ++n)
#pragma unroll
                    for (int i = 0; i < 4; ++i) { const float gt = acc[ai][0][m][n][i], up = acc[ai][1][m][n][i]; v[n][i] = gt * sigmoidf_(gt) * up; }
                st8(O + (size_t)row * FFH + col0, v[0], v[1]); }
    }
};
struct EpiIn1 {
    bf16_t* Z;
    __device__ __forceinline__ void operator()(const AccT& acc, const Unit& u, int wr, int wc, int fr, int fq) const {
        const int row0 = u.pm * BM + wr * 64 + fr, col0 = u.pn * BM + wc * 32 + 8 * fq; const bool act = u.pn >= 4;
#pragma unroll
        for (int ai = 0; ai < 2; ++ai)
#pragma unroll
            for (int m = 0; m < 4; ++m) { bf16_t* rowp = Z + (size_t)(row0 + ai * HALF + m * 16) * 2048 + col0;
#pragma unroll
                for (int bj = 0; bj < 2; ++bj) { f32x4 v0 = acc[ai][bj][m][0], v1 = acc[ai][bj][m][1];
                    if (act) {
#pragma unroll
                        for (int i = 0; i < 4; ++i) { v0[i] = gelu_tanh(v0[i]); v1[i] = gelu_tanh(v1[i]); } }
                    st8(rowp + bj * HALF, v0, v1); } }
    }
};
struct EpiGates {
    const bf16_t* XC; bf16_t* LA; bf16_t* BB; const float* b_r; const float* b_i; const float* sp;
    __device__ __forceinline__ void operator()(const AccT& acc, const Unit& u, int wr, int wc, int fr, int fq) const {
        const int row0 = u.pm * BM + wr * 64 + fr, c0 = (u.pn >> 1) * 256 + (u.pn & 1) * 128 + wc * 32 + 8 * fq;
#pragma unroll
        for (int ai = 0; ai < 2; ++ai)
#pragma unroll
            for (int m = 0; m < 4; ++m) { const int row = row0 + ai * HALF + m * 16;
#pragma unroll
                for (int n = 0; n < 2; ++n) { const int c = c0 + 4 * n; const u32x2 xw = *(const u32x2*)(XC + (size_t)row * 1024 + c);
                    const f32x4 br = *(const f32x4*)(b_r + c), bi = *(const f32x4*)(b_i + c), spv = *(const f32x4*)(sp + c);
                    const float xv[4] = {bflo(xw.x), bfhi(xw.x), bflo(xw.y), bfhi(xw.y)}; float la[4], bb[4];
#pragma unroll
                    for (int i = 0; i < 4; ++i) { const float gr = sigmoidf_(acc[ai][0][m][n][i] + br[i]), gi = sigmoidf_(acc[ai][1][m][n][i] + bi[i]);
                        const float l = -8.f * gr * spv[i]; const float a2 = fast_exp2(2.f * l * LOG2E); const float mult = sqrtf(fmaxf(1.f - a2, 0.f));
                        la[i] = l; bb[i] = mult * gi * xv[i]; }
                    u32x2 w0, w1; w0.x = pk2(la[0], la[1]); w0.y = pk2(la[2], la[3]); w1.x = pk2(bb[0], bb[1]); w1.y = pk2(bb[2], bb[3]);
                    *(u32x2*)(LA + (size_t)row * 1024 + c) = w0; *(u32x2*)(BB + (size_t)row * 1024 + c) = w1; __builtin_amdgcn_sched_barrier(0); } }
    }
};
}

__device__ __forceinline__ void transpose_item(const float* W, int ld, int K, bf16_t* dst, int k0, LAS float* scr, int lane) {
#pragma unroll 8
    for (int i = 0; i < 32; ++i) { const int kk = 2 * i + (lane >> 5); scr[kk * 33 + (lane & 31)] = W[(size_t)(k0 + kk) * ld + (lane & 31)]; }
    LDS_WAIT();
    const int c = lane & 7;
#pragma unroll
    for (int j = 0; j < 4; ++j) { const int n = (lane >> 3) + 8 * j; const LAS float* s = scr + (8 * c) * 33 + n;
        u32x4 o; o.x = pk2(s[0 * 33], s[1 * 33]); o.y = pk2(s[2 * 33], s[3 * 33]); o.z = pk2(s[4 * 33], s[5 * 33]); o.w = pk2(s[6 * 33], s[7 * 33]);
        *(u32x4*)(dst + (size_t)n * K + k0 + 8 * c) = o; }
    LDS_WAIT();
}
__device__ __forceinline__ void sincos_rr(float ang, float& s, float& c) {
    const double r = (double)ang * 0.15915494309189535; const double fr = r - __builtin_rint(r); const float f = (float)fr;
    s = __builtin_amdgcn_sinf(f); c = __builtin_amdgcn_cosf(f);
}
__device__ __forceinline__ void rms_row_to_bf16(const float* xrow, const float* g, bf16_t* orow, int lane) {
    const f32x4* xr = (const f32x4*)xrow + lane; const f32x4* gr = (const f32x4*)g + lane;
    f32x4 v[4]; float s = 0.f;
#pragma unroll
    for (int j = 0; j < 4; ++j) { v[j] = xr[64 * j]; s += (v[j].x * v[j].x + v[j].y * v[j].y) + (v[j].z * v[j].z + v[j].w * v[j].w); }
    const float rstd = 1.f / sqrtf(wave_sum(s) * (1.f / DM) + NORM_EPS);
    u32x2* o8 = (u32x2*)orow + lane;
#pragma unroll
    for (int j = 0; j < 4; ++j) { const f32x4 gg = gr[64 * j]; u32x2 w; w.x = pk2(v[j].x * rstd * gg.x, v[j].y * rstd * gg.y); w.y = pk2(v[j].z * rstd * gg.z, v[j].w * rstd * gg.w); o8[64 * j] = w; }
}
__device__ __forceinline__ void resnorm_row(const float* xin, const bf16_t* mix, const float* gpost, float* xout, const float* gpre, bf16_t* hn, int lane) {
    const f32x4* xr = (const f32x4*)xin + lane; const u32x2* mr = (const u32x2*)mix + lane; const f32x4* gp = (const f32x4*)gpost + lane;
    f32x4 v[4]; float s = 0.f;
#pragma unroll
    for (int j = 0; j < 4; ++j) { const u32x2 w = mr[64 * j]; v[j] = (f32x4){bflo(w.x), bfhi(w.x), bflo(w.y), bfhi(w.y)}; s += (v[j].x * v[j].x + v[j].y * v[j].y) + (v[j].z * v[j].z + v[j].w * v[j].w); }
    const float rstd = 1.f / sqrtf(wave_sum(s) * (1.f / DM) + NORM_EPS);
    float s2 = 0.f;
#pragma unroll
    for (int j = 0; j < 4; ++j) { const f32x4 gg = gp[64 * j]; v[j] = xr[64 * j] + v[j] * rstd * gg; s2 += (v[j].x * v[j].x + v[j].y * v[j].y) + (v[j].z * v[j].z + v[j].w * v[j].w);
        ((f32x4*)xout + lane)[64 * j] = v[j]; }
    if (hn) { const float rstd2 = 1.f / sqrtf(wave_sum(s2) * (1.f / DM) + NORM_EPS); const f32x4* gq = (const f32x4*)gpre + lane; u32x2* o8 = (u32x2*)hn + lane;
#pragma unroll
        for (int j = 0; j < 4; ++j) { const f32x4 gg = gq[64 * j]; u32x2 w; w.x = pk2(v[j].x * rstd2 * gg.x, v[j].y * rstd2 * gg.y); w.y = pk2(v[j].z * rstd2 * gg.z, v[j].w * rstd2 * gg.w); o8[64 * j] = w; } }
}

constexpr int AT_KPITCH = 144, AT_VPITCH = 528, AT_VOFF = 256 * AT_KPITCH;
__device__ __forceinline__ void attn_unit(const bf16_t* Z, bf16_t* PO, float* PM, float* PL, LAS unsigned char* lds, int unit, int tid, int wave, int lane) {
    const int sub = unit & 15, br = (unit >> 4) % 3, bh = unit / 48, h = bh & 7, b = bh >> 3;
    const int dil = br == 0 ? 1 : (br == 1 ? 4 : 16), nb = 16 / dil, rho = sub / nb, n = sub % nb;
    const bf16_t* Zb = Z + (size_t)b * SEQ * 2048;
    __syncthreads();
#pragma unroll
    for (int it = 0; it < 4; ++it) { const int idx = tid + it * NTHREADS, kb = idx >> 3, ch = idx & 7;
        int sidx = n * 128 - 128 + kb; if (sidx < 0) sidx = 0; const int tok = sidx * dil + rho;
        const bf16_t* rowp = Zb + (size_t)tok * 2048 + h * 64 + ch * 8;
        const u32x4 kv = *(const u32x4*)(rowp + 512); const u32x4 vv = *(const u32x4*)(rowp + 1024);
        *(LAS u32x4*)(lds + kb * AT_KPITCH + ch * 16) = kv;
        LAS bf16_t* vt = (LAS bf16_t*)(lds + AT_VOFF) + (ch * 8) * (AT_VPITCH / 2) + kb;
        vt[0 * (AT_VPITCH / 2)] = (bf16_t)(vv.x & 0xffff); vt[1 * (AT_VPITCH / 2)] = (bf16_t)(vv.x >> 16);
        vt[2 * (AT_VPITCH / 2)] = (bf16_t)(vv.y & 0xffff); vt[3 * (AT_VPITCH / 2)] = (bf16_t)(vv.y >> 16);
        vt[4 * (AT_VPITCH / 2)] = (bf16_t)(vv.z & 0xffff); vt[5 * (AT_VPITCH / 2)] = (bf16_t)(vv.z >> 16);
        vt[6 * (AT_VPITCH / 2)] = (bf16_t)(vv.w & 0xffff); vt[7 * (AT_VPITCH / 2)] = (bf16_t)(vv.w >> 16); }
    const int q = lane & 15, kq = lane >> 4, qi = 16 * wave + q;
    const int tokq = (n * 128 + qi) * dil + rho;
    const bf16_t* qrow = Zb + (size_t)tokq * 2048 + h * 64;
    const bf16x8 qf0 = *(const bf16x8*)(qrow + 8 * kq), qf1 = *(const bf16x8*)(qrow + 32 + 8 * kq);
    __syncthreads();
    f32x4 o[4];
#pragma unroll
    for (int mm = 0; mm < 4; ++mm) o[mm] = (f32x4){0.f, 0.f, 0.f, 0.f};
    float mrun = -1e30f, lrun = 0.f;
    const int kstart = (16 * wave < 96) ? 16 * wave : 96;
    for (int p = 0; p < 5; ++p) {
        const int ks = kstart + 32 * p;
        if (n == 0 && ks + 32 <= 128) continue;
        if (ks + 31 < 16 * wave) continue;
        const LAS unsigned char* kp = lds + (ks + q) * AT_KPITCH + kq * 16;
        const bf16x8 k00 = *(const LAS bf16x8*)(kp), k01 = *(const LAS bf16x8*)(kp + 64);
        const bf16x8 k10 = *(const LAS bf16x8*)(kp + 16 * AT_KPITCH), k11 = *(const LAS bf16x8*)(kp + 16 * AT_KPITCH + 64);
        f32x4 s0 = {0.f, 0.f, 0.f, 0.f}, s1 = {0.f, 0.f, 0.f, 0.f};
        s0 = __builtin_amdgcn_mfma_f32_16x16x32_bf16(k00, qf0, s0, 0, 0, 0); s0 = __builtin_amdgcn_mfma_f32_16x16x32_bf16(k01, qf1, s0, 0, 0, 0);
        s1 = __builtin_amdgcn_mfma_f32_16x16x32_bf16(k10, qf0, s1, 0, 0, 0); s1 = __builtin_amdgcn_mfma_f32_16x16x32_bf16(k11, qf1, s1, 0, 0, 0);
        float sv[8]; float mx = -1e30f;
#pragma unroll
        for (int i = 0; i < 8; ++i) { const int kb = ks + (i >> 2) * 16 + 4 * kq + (i & 3); const bool ok = (kb >= qi) && (kb <= qi + 128) && (n * 128 + kb >= 128);
            const float sraw = (i < 4) ? s0[i & 3] : s1[i & 3]; sv[i] = ok ? sraw * LOG2E : -1e30f; mx = fmaxf(mx, sv[i]); }
        mx = fmaxf(mx, __shfl_xor(mx, 16)); mx = fmaxf(mx, __shfl_xor(mx, 32));
        const float mn = fmaxf(mrun, mx); const float alpha = fast_exp2(mrun - mn);
        float ps = 0.f; float pv[8];
#pragma unroll
        for (int i = 0; i < 8; ++i) { pv[i] = (sv[i] > -1e29f) ? fast_exp2(sv[i] - mn) : 0.f; ps += pv[i]; }
        ps += __shfl_xor(ps, 16); ps += __shfl_xor(ps, 32);
        lrun = lrun * alpha + ps; mrun = mn;
        u32x4 pw; pw.x = pk2(pv[0], pv[1]); pw.y = pk2(pv[2], pv[3]); pw.z = pk2(pv[4], pv[5]); pw.w = pk2(pv[6], pv[7]);
        const bf16x8 pf = __builtin_bit_cast(bf16x8, pw);
#pragma unroll
        for (int mm = 0; mm < 4; ++mm) { const LAS unsigned char* vp = lds + AT_VOFF + (16 * mm + q) * AT_VPITCH + (ks + 4 * kq) * 2;
            const u32x2 lo = *(const LAS u32x2*)vp, hi = *(const LAS u32x2*)(vp + 32);
            u32x4 vw; vw.x = lo.x; vw.y = lo.y; vw.z = hi.x; vw.w = hi.y;
            o[mm] = o[mm] * alpha;
            o[mm] = __builtin_amdgcn_mfma_f32_16x16x32_bf16(__builtin_bit_cast(bf16x8, vw), pf, o[mm], 0, 0, 0); }
    }
    const float inv = 1.f / lrun; const size_t row = (size_t)b * SEQ + tokq;
    bf16_t* orow = PO + ((size_t)br * MTOK + row) * 512 + h * 64 + 4 * kq;
#pragma unroll
    for (int mm = 0; mm < 4; ++mm) { u32x2 w; w.x = pk2(o[mm][0] * inv, o[mm][1] * inv); w.y = pk2(o[mm][2] * inv, o[mm][3] * inv); *(u32x2*)(orow + 16 * mm) = w; }
    if (kq == 0) { PM[((size_t)br * MTOK + row) * 8 + h] = mrun; PL[((size_t)br * MTOK + row) * 8 + h] = lrun; }
}

constexpr int S5_WAVE_BYTES = 12544;
__device__ __forceinline__ void s5_unit(const bf16_t* Z, const unsigned char* tab, const float* dskip, bf16_t* Y5, LAS unsigned char* lds, int unit, int wave, int lane) {
    const int b = unit >> 2, g = (unit & 3) * 8 + wave;
    LAS float* bus = (LAS float*)(lds + wave * S5_WAVE_BYTES);
    LAS bf16_t* hs = (LAS bf16_t*)(lds + wave * S5_WAVE_BYTES + 8192);
    const int n = lane & 15, kg = lane >> 4;
    const bf16_t* BMt = (const bf16_t*)(tab + S5_BM); const bf16_t* CMt = (const bf16_t*)(tab + S5_CM); const float* AB = (const float*)(tab + S5_ABAR);
    bf16x8 bm[8], cm[4];
#pragma unroll
    for (int nt = 0; nt < 8; ++nt) bm[nt] = *(const bf16x8*)(BMt + ((size_t)(g * 128 + 16 * nt + n)) * 32 + 8 * kg);
#pragma unroll
    for (int kk = 0; kk < 4; ++kk) cm[kk] = *(const bf16x8*)(CMt + ((size_t)(g * 16 + n)) * 128 + 32 * kk + 8 * kg);
    const float dsk = dskip[g * 16 + n];
    const float ar = AB[(g * 64 + lane) * 2], ai = AB[(g * 64 + lane) * 2 + 1];
    float hr = 0.f, hi = 0.f;
    const bf16_t* ub = Z + (size_t)b * SEQ * 2048 + 1536 + g * 16;
    bf16_t* yb = Y5 + (size_t)b * SEQ * 512 + g * 16 + n;
    for (int t0 = 0; t0 < SEQ; t0 += 16) {
        bf16x8 uf = {0, 0, 0, 0, 0, 0, 0, 0};
        if (kg < 2) uf = *(const bf16x8*)(ub + (size_t)(t0 + n) * 2048 + 8 * kg);
#pragma unroll
        for (int nt = 0; nt < 8; ++nt) { f32x4 d = {0.f, 0.f, 0.f, 0.f}; d = __builtin_amdgcn_mfma_f32_16x16x32_bf16(uf, bm[nt], d, 0, 0, 0);
#pragma unroll
            for (int i = 0; i < 4; ++i) bus[(4 * kg + i) * 128 + 16 * nt + n] = d[i]; }
        LDS_WAIT();
#pragma unroll
        for (int t = 0; t < 16; ++t) { const float bre = bus[t * 128 + lane], bim = bus[t * 128 + 64 + lane];
            const float nr = ar * hr - ai * hi + bre, ni = ar * hi + ai * hr + bim; hr = nr; hi = ni;
            hs[t * 136 + lane] = (bf16_t)f2bf(hr); hs[t * 136 + 64 + lane] = (bf16_t)f2bf(hi); }
        LDS_WAIT();
        f32x4 y = {0.f, 0.f, 0.f, 0.f};
#pragma unroll
        for (int kk = 0; kk < 4; ++kk) { const bf16x8 hf = *(const LAS bf16x8*)(hs + n * 136 + 32 * kk + 8 * kg); y = __builtin_amdgcn_mfma_f32_16x16x32_bf16(hf, cm[kk], y, 0, 0, 0); }
#pragma unroll
        for (int i = 0; i < 4; ++i) { const int t = t0 + 4 * kg + i; const float u = bf2f(ub[(size_t)t * 2048 + n]); const float v = gelu_tanh(y[i] + dsk * u); yb[(size_t)t * 512] = (bf16_t)f2bf(v); }
        LDS_WAIT();
    }
}

#define XB_TMO      128
#define XB_XCNT(j)  (256  + 64 * (j))
#define XB_XSUB(j)  (1280 + 64 * (j))
#define XB_XGEN(j)  (2304 + 64 * (j))
#define XB_TOP      3328
#define XB_TOPGEN   3392
#define XCD_BAR_WORDS 3456
#define XB_SPIN_CAP (1u << 22)
__device__ __forceinline__ unsigned xb_ld(unsigned* p)              { return __hip_atomic_load(p, __ATOMIC_RELAXED, __HIP_MEMORY_SCOPE_AGENT); }
__device__ __forceinline__ unsigned xb_add(unsigned* p, unsigned v) { return __hip_atomic_fetch_add(p, v, __ATOMIC_RELAXED, __HIP_MEMORY_SCOPE_AGENT); }
__device__ __forceinline__ unsigned xb_xcc_id() { return (unsigned)__builtin_amdgcn_s_getreg((3 << 11) | 20) & 0xFu; }
#define XB_SPIN(cond, bar) do { unsigned _sp = 0; while (cond) { __builtin_amdgcn_s_sleep(1); \
    if ((++_sp & 255u) == 0u) { if (xb_ld(&(bar)[XB_TMO])) break; if (_sp > XB_SPIN_CAP) { atomicAdd(&(bar)[XB_TMO], 1u); break; } } } } while (0)
__device__ __forceinline__ void xcd_barrier_complete(unsigned* bar, unsigned x, unsigned& nloc, unsigned& nx) {
    const unsigned G = gridDim.x * gridDim.y * gridDim.z;
    unsigned sum, cnt, mine, sp = 0u;
    for (;;) {
        sum = 0u; cnt = 0u; mine = 0u;
#pragma unroll
        for (unsigned j = 0; j < 16; ++j) { const unsigned c = xb_ld(&bar[XB_XCNT(j)]); sum += c; cnt += (c > 0u) ? 1u : 0u; mine = (j == x) ? c : mine; }
        if (sum == G) break;
        __builtin_amdgcn_s_sleep(1);
        if ((++sp & 255u) == 0u) { if (xb_ld(&bar[XB_TMO])) break; if (sp > XB_SPIN_CAP) { atomicAdd(&bar[XB_TMO], 1u); break; } }
    }
    nloc = mine > 0u ? mine : 1u; nx = cnt > 0u ? cnt : 1u;
}
__device__ __forceinline__ void xcd_barrier(unsigned* bar, volatile LAS unsigned* st) {
    asm volatile("s_waitcnt vmcnt(0)" ::: "memory");
    __syncthreads();
    if (threadIdx.x == 0) {
        const unsigned x = xb_xcc_id();
        __builtin_amdgcn_s_waitcnt(0);
        unsigned nloc = st[0], nx = st[1];
        if (nloc == 0u) { xcd_barrier_complete(bar, x, nloc, nx); st[0] = nloc; st[1] = nx; }
        const unsigned old = xb_add(&bar[XB_XSUB(x)], 1u);
        const unsigned gen = old / nloc;
        if (old + 1u == (gen + 1u) * nloc) {
            __builtin_amdgcn_fence(__ATOMIC_RELEASE, "agent");
            asm volatile("s_waitcnt vmcnt(0)" ::: "memory");
            const unsigned og = xb_add(&bar[XB_TOP], 1u);
            const unsigned tg = og / nx;
            if (og + 1u == (tg + 1u) * nx) xb_add(&bar[XB_TOPGEN], 1u);
            else XB_SPIN(xb_ld(&bar[XB_TOPGEN]) == tg, bar);
            __builtin_amdgcn_fence(__ATOMIC_ACQUIRE, "agent");
            xb_add(&bar[XB_XGEN(x)], 1u);
            asm volatile("s_waitcnt vmcnt(0)" ::: "memory");
        } else {
            XB_SPIN(xb_ld(&bar[XB_XGEN(x)]) == gen, bar);
            __builtin_amdgcn_fence(__ATOMIC_ACQUIRE, "agent");
            asm volatile("s_waitcnt vmcnt(0)" ::: "memory");
        }
    }
    __syncthreads();
}
constexpr int LDS_MISC = 135 * 1024;
constexpr size_t CTL_BYTES = 16384;

typedef const __attribute__((address_space(4))) Args* ArgsP;
__global__ void __launch_bounds__(NTHREADS, 2) mega(Args a_kern) {
    extern __shared__ __attribute__((aligned(16))) unsigned char lds_raw[];
    LAS unsigned char* lds = (LAS unsigned char*)lds_raw;
    cg::grid_group grid = cg::this_grid();
    ArgsP ap = (ArgsP)__builtin_amdgcn_kernarg_segment_ptr();
#define a (*ap)
#define ws (a.ws)
    int tid, lane, wave, gw, gt;
    const int G = gridDim.x, bx = blockIdx.x;
    const int NGW = G * NWAVES, NGT = G * NTHREADS;
#define RELOAD() do { asm volatile("" : "+s"(ap)); tid = threadIdx.x; asm volatile("" : "+v"(tid)); lane = tid & 63; wave = __builtin_amdgcn_readfirstlane(tid >> 6); gw = bx * NWAVES + wave; gt = bx * NTHREADS + tid; } while (0)
    RELOAD();
    volatile LAS unsigned* bst = (volatile LAS unsigned*)(lds + LDS_MISC);
    if (tid == 0) { bst[0] = 0u; bst[1] = 0u; (void)xb_add((unsigned*)(ws + WS_CTL) + XB_XCNT(xb_xcc_id()), 1u); }
    __syncthreads();
#define x_in (a.in[0])
#define positions ((const int*)a.in[1])
#define g_mix_pre (a.in[2])
#define g_mix_post (a.in[3])
#define g_ffn_pre (a.in[4])
#define g_ffn_post (a.in[5])
#define HN ((bf16_t*)(ws + WS_HN))
#define Z ((bf16_t*)(ws + WS_Z))
#define YC ((bf16_t*)(ws + WS_YC))
#define MIX ((bf16_t*)(ws + WS_MIX))
#define PO ((bf16_t*)(ws + WS_PO))
#define PM ((float*)(ws + WS_PM))
#define PL ((float*)(ws + WS_PL))
#define Y5 ((bf16_t*)(ws + WS_Y5))
#define HID ((bf16_t*)(ws + WS_HID))
#define XC ((bf16_t*)(ws + WS_XC))
#define BB ((bf16_t*)(ws + WS_BB))
#define Y1 ((bf16_t*)(ws + WS_Y1))
#define LA ((bf16_t*)(ws + WS_LA))
#define ROPE ((float*)(ws + WS_ROPE))
#define S5T (ws + WS_S5TAB)
#define SP ((float*)(ws + WS_S5TAB + S5_SP))
#define X (a.out)
#ifndef PHMASK
#define PHMASK 0xFFFFFFFFu
#endif
#define IN(k) (((PHMASK >> (k)) & 1u) && a.ph_lo <= (k) && (k) < a.ph_hi)
#ifndef REPMASK
#define REPMASK 0x0u
#endif
#define REPS(k) (1 + (int)((REPMASK >> (k)) & 1u))
#define REPSYNC do { if (rep) grid.sync(); } while (0)
#define SEAM(k) do { if (IN(k) && IN((k) + 1)) { if ((k) == 0) grid.sync(); else xcd_barrier((unsigned*)(ws + WS_CTL), bst); } RELOAD(); } while (0)

    if (IN(0)) _Pragma("unroll") for (int rep = 0; rep < REPS(0); ++rep) {
        LAS float* scr = (LAS float*)(lds + wave * 8448);
        constexpr int I_IN = 16 * 64, I_OUT = 16 * 32, I_GLU = 8 * 16, I_GATE = 4 * 64, I_UP = 16 * 176, I_DN = 44 * 32;
        constexpr int NITEMS = 2 * I_IN + 2 * I_OUT + I_GLU + I_GATE + 2 * I_UP + 2 * I_DN;
        for (int it = gw; it < NITEMS; it += NGW) {
            int r = it;
            if (r < I_IN) { const int kb = r / 64, nb = r % 64; transpose_item(a.in[6] + nb * 32, 2048, 1024, (bf16_t*)(ws + WS_W_IN0) + (size_t)nb * 32 * 1024, kb * 64, scr, lane); continue; } r -= I_IN;
            if (r < I_IN) { const int kb = r / 64, nb = r % 64; transpose_item(a.in[17] + nb * 32, 2048, 1024, (bf16_t*)(ws + WS_W_IN1) + (size_t)nb * 32 * 1024, kb * 64, scr, lane); continue; } r -= I_IN;
            if (r < I_OUT) { const int kb = r / 32, nb = r % 32; transpose_item(a.in[7] + nb * 32, 1024, 1024, (bf16_t*)(ws + WS_W_OUT0) + (size_t)nb * 32 * 1024, kb * 64, scr, lane); continue; } r -= I_OUT;
            if (r < I_OUT) { const int kb = r / 32, nb = r % 32; transpose_item(a.in[18] + nb * 32, 1024, 1024, (bf16_t*)(ws + WS_W_OUT1) + (size_t)nb * 32 * 1024, kb * 64, scr, lane); continue; } r -= I_OUT;
            if (r < I_GLU) { const int kb = r / 16, nb = r % 16; transpose_item(a.in[16] + nb * 32, 512, 512, (bf16_t*)(ws + WS_W_GLU) + (size_t)nb * 32 * 512, kb * 64, scr, lane); continue; } r -= I_GLU;
            if (r < I_GATE) { const int kb = r / 64, nb = r % 64; const int n0 = nb * 32, pn = n0 >> 8, half = (n0 >> 7) & 1, j = n0 & 127, hh = pn >> 1, colg = (pn & 1) * 128 + j;
                const float* src = (half ? a.in[23] : a.in[21]) + (size_t)hh * 256 * 256 + colg;
                transpose_item(src, 256, 256, (bf16_t*)(ws + WS_W_GATE) + (size_t)n0 * 256, kb * 64, scr, lane); continue; } r -= I_GATE;
            if (r < 2 * I_UP) { const int layer = r / I_UP; r -= layer * I_UP; const int kb = r / 176, nb = r % 176; const int n0 = nb * 32, t = n0 >> 8, half = (n0 >> 7) & 1, j = n0 & 127;
                const float* src = (half ? a.in[27] : a.in[26]) + (size_t)layer * 1024 * FFH + t * 128 + j;
                transpose_item(src, FFH, 1024, (bf16_t*)(ws + (layer ? WS_W_UP1 : WS_W_UP0)) + (size_t)n0 * 1024, kb * 64, scr, lane); continue; } r -= 2 * I_UP;
            { const int layer = r / I_DN; r -= layer * I_DN; const int kb = r / 32, nb = r % 32;
                transpose_item(a.in[28] + (size_t)layer * FFH * 1024 + nb * 32, 1024, FFH, (bf16_t*)(ws + (layer ? WS_W_DN1 : WS_W_DN0)) + (size_t)nb * 32 * FFH, kb * 64, scr, lane); }
        }
        for (int idx = gt; idx < MTOK * 8; idx += NGT) { const int tok = idx >> 3, j = idx & 7; const float inv_freq = powf(500000.0f, -(float)j * 0.125f);
            const float ang = (float)positions[tok] * inv_freq; float s, c; sincos_rr(ang, s, c); ROPE[(size_t)tok * 16 + j] = c; ROPE[(size_t)tok * 16 + 8 + j] = s; }
        for (int idx = gt; idx < 32 * 64; idx += NGT) { const int g = idx >> 6, p = idx & 63;
            const float are = a.in[8][idx], aim = a.in[9][idx], dt = expf(a.in[10][g]);
            const float xr = are * dt, yi = aim * dt; const float ex = expf(xr); float sn, cs; sincos_rr(yi, sn, cs);
            const float abr = ex * cs, abi = ex * sn;
            float sh, ch; sincos_rr(0.5f * yi, sh, ch); (void)ch;
            const float nre = expm1f(xr) * cs - 2.f * sh * sh, nim = abi;
            const float den = 1.f / (are * are + aim * aim);
            const float cre = (nre * are + nim * aim) * den, cim = (nim * are - nre * aim) * den;
            float* AB = (float*)(S5T + S5_ABAR); AB[idx * 2] = abr; AB[idx * 2 + 1] = abi;
            bf16_t* BMt = (bf16_t*)(S5T + S5_BM); bf16_t* CMt = (bf16_t*)(S5T + S5_CM);
            for (int c = 0; c < 16; ++c) { const float bre = a.in[11][(size_t)idx * 16 + c], bim = a.in[12][(size_t)idx * 16 + c];
                BMt[((size_t)g * 128 + p) * 32 + c] = (bf16_t)f2bf(cre * bre - cim * bim); BMt[((size_t)g * 128 + 64 + p) * 32 + c] = (bf16_t)f2bf(cre * bim + cim * bre);
                BMt[((size_t)g * 128 + p) * 32 + 16 + c] = 0; BMt[((size_t)g * 128 + 64 + p) * 32 + 16 + c] = 0;
                CMt[((size_t)g * 16 + c) * 128 + p] = (bf16_t)f2bf(a.in[13][((size_t)g * 16 + c) * 64 + p]); CMt[((size_t)g * 16 + c) * 128 + 64 + p] = (bf16_t)f2bf(-a.in[14][((size_t)g * 16 + c) * 64 + p]); } }
        for (int idx = gt; idx < 1024; idx += NGT) SP[idx] = log1pf(expf(-a.in[25][idx]));
        for (int m = gw; m < MTOK; m += NGW) rms_row_to_bf16(x_in + (size_t)m * DM, g_mix_pre, HN + (size_t)m * DM, lane);
    }
    SEAM(0);
    if (IN(1)) _Pragma("unroll") for (int rep = 0; rep < REPS(1); ++rep) { pg8::Gemm g{HN, (const bf16_t*)(ws + WS_W_IN0), MTOK, 2048, 1024, 1024, 0}; pg8::StaticOrder S; S.init(MTOK, 2048, G, bx);
        pg8::EpiRope E{Z, ROPE}; pg8::gemm_phase(lds, g, S, E); }
    SEAM(1);
    if (IN(2)) _Pragma("unroll") for (int rep = 0; rep < REPS(2); ++rep) {
        if (bx < 128) s5_unit(Z, S5T, a.in[15], Y5, lds, bx, wave, lane);
        for (int u = bx; u < 12288; u += G) attn_unit(Z, PO, PM, PL, lds, u, tid, wave, lane);
    }
    SEAM(2);
    if (IN(3)) _Pragma("unroll") for (int rep = 0; rep < REPS(3); ++rep) {
        for (int idx = gt; idx < MTOK * 64; idx += NGT) { const int row = idx >> 6, c8 = idx & 63, h = c8 >> 3;
            float mv[3], lv[3]; u32x4 ow[3];
#pragma unroll
            for (int i = 0; i < 3; ++i) { mv[i] = PM[((size_t)i * MTOK + row) * 8 + h]; lv[i] = PL[((size_t)i * MTOK + row) * 8 + h]; ow[i] = *(const u32x4*)(PO + ((size_t)i * MTOK + row) * 512 + c8 * 8); }
            const float mx = fmaxf(mv[0], fmaxf(mv[1], mv[2]));
            float w[3]; float den = 0.f;
#pragma unroll
            for (int i = 0; i < 3; ++i) { w[i] = fast_exp2(mv[i] - mx) * lv[i]; den += w[i]; }
            const float inv = 1.f / den; f32x4 v0 = {0.f, 0.f, 0.f, 0.f}, v1 = v0;
#pragma unroll
            for (int i = 0; i < 3; ++i) { const float ww = w[i] * inv;
                v0[0] += ww * bflo(ow[i].x); v0[1] += ww * bfhi(ow[i].x); v0[2] += ww * bflo(ow[i].y); v0[3] += ww * bfhi(ow[i].y);
                v1[0] += ww * bflo(ow[i].z); v1[1] += ww * bfhi(ow[i].z); v1[2] += ww * bflo(ow[i].w); v1[3] += ww * bfhi(ow[i].w); }
            pg8::st8(YC + (size_t)row * 1024 + c8 * 8, v0, v1); }
        __syncthreads();
        pg8::Gemm g{Y5, (const bf16_t*)(ws + WS_W_GLU), MTOK, 512, 512, 512, 0}; pg8::StaticOrder S; S.init(MTOK, 512, G, bx);
        pg8::EpiGlu E{Y5, YC}; pg8::gemm_phase(lds, g, S, E);
    }
    SEAM(3);
    if (IN(4)) _Pragma("unroll") for (int rep = 0; rep < REPS(4); ++rep) { pg8::Gemm g{YC, (const bf16_t*)(ws + WS_W_OUT0), MTOK, 1024, 1024, 1024, 0}; pg8::StaticOrder S; S.init(MTOK, 1024, G, bx);
        pg8::EpiPlain E{MIX, 1024}; pg8::gemm_phase(lds, g, S, E); }
    SEAM(4);
    if (IN(5)) _Pragma("unroll") for (int rep = 0; rep < REPS(5); ++rep) for (int m = gw; m < MTOK; m += NGW) resnorm_row(x_in + (size_t)m * DM, MIX + (size_t)m * DM, g_mix_post, X + (size_t)m * DM, g_ffn_pre, HN + (size_t)m * DM, lane);
    SEAM(5);
    if (IN(6)) _Pragma("unroll") for (int rep = 0; rep < REPS(6); ++rep) { pg8::Gemm g{HN, (const bf16_t*)(ws + WS_W_UP0), MTOK, 2 * FFH, 1024, 1024, 0}; pg8::StaticOrder S; S.init(MTOK, 2 * FFH, G, bx);
        pg8::EpiSwiGlu E{HID}; pg8::gemm_phase(lds, g, S, E); }
    SEAM(6);
    if (IN(7)) _Pragma("unroll") for (int rep = 0; rep < REPS(7); ++rep) { pg8::Gemm g{HID, (const bf16_t*)(ws + WS_W_DN0), MTOK, 1024, FFH, FFH, 0}; pg8::StaticOrder S; S.init(MTOK, 1024, G, bx);
        pg8::EpiPlain E{MIX, 1024}; pg8::gemm_phase(lds, g, S, E); }
    SEAM(7);
    if (IN(8)) _Pragma("unroll") for (int rep = 0; rep < REPS(8); ++rep) for (int m = gw; m < MTOK; m += NGW) resnorm_row(X + (size_t)m * DM, MIX + (size_t)m * DM, g_ffn_post, X + (size_t)m * DM, g_mix_pre + DM, HN + (size_t)m * DM, lane);
    SEAM(8);
    if (IN(9)) _Pragma("unroll") for (int rep = 0; rep < REPS(9); ++rep) { pg8::Gemm g{HN, (const bf16_t*)(ws + WS_W_IN1), MTOK, 2048, 1024, 1024, 0}; pg8::StaticOrder S; S.init(MTOK, 2048, G, bx);
        pg8::EpiIn1 E{Z}; pg8::gemm_phase(lds, g, S, E); }
    SEAM(9);
    if (IN(10)) _Pragma("unroll") for (int rep = 0; rep < REPS(10); ++rep) {
        const float* cw = a.in[19]; const float* cb = a.in[20];
        for (int idx = gt; idx < (MTOK / 8) * 128; idx += NGT) { const int c8 = idx & 127, tb = idx >> 7, row0 = tb * 8, c0 = c8 * 8; const int t0 = row0 & (SEQ - 1);
            float w[4][8], bias[8];
#pragma unroll
            for (int k = 0; k < 4; ++k) { const f32x4 wa = *(const f32x4*)(cw + k * 1024 + c0), wb = *(const f32x4*)(cw + k * 1024 + c0 + 4);
                w[k][0] = wa.x; w[k][1] = wa.y; w[k][2] = wa.z; w[k][3] = wa.w; w[k][4] = wb.x; w[k][5] = wb.y; w[k][6] = wb.z; w[k][7] = wb.w; }
            { const f32x4 ba = *(const f32x4*)(cb + c0), bb = *(const f32x4*)(cb + c0 + 4); bias[0] = ba.x; bias[1] = ba.y; bias[2] = ba.z; bias[3] = ba.w; bias[4] = bb.x; bias[5] = bb.y; bias[6] = bb.z; bias[7] = bb.w; }
            float xm[3][8];
#pragma unroll
            for (int k = 0; k < 3; ++k) { u32x4 v = {0u, 0u, 0u, 0u}; if (t0 - 3 + k >= 0) v = *(const u32x4*)(Z + (size_t)(row0 - 3 + k) * 2048 + c0);
                xm[k][0] = bflo(v.x); xm[k][1] = bfhi(v.x); xm[k][2] = bflo(v.y); xm[k][3] = bfhi(v.y); xm[k][4] = bflo(v.z); xm[k][5] = bfhi(v.z); xm[k][6] = bflo(v.w); xm[k][7] = bfhi(v.w); }
#pragma unroll
            for (int r = 0; r < 8; ++r) { const u32x4 v = *(const u32x4*)(Z + (size_t)(row0 + r) * 2048 + c0);
                const float xc[8] = {bflo(v.x), bfhi(v.x), bflo(v.y), bfhi(v.y), bflo(v.z), bfhi(v.z), bflo(v.w), bfhi(v.w)};
                f32x4 o0, o1;
#pragma unroll
                for (int i = 0; i < 8; ++i) { const float o = bias[i] + w[0][i] * xm[0][i] + w[1][i] * xm[1][i] + w[2][i] * xm[2][i] + w[3][i] * xc[i];
                    if (i < 4) o0[i] = o; else o1[i - 4] = o; xm[0][i] = xm[1][i]; xm[1][i] = xm[2][i]; xm[2][i] = xc[i]; }
                pg8::st8(XC + (size_t)(row0 + r) * 1024 + c0, o0, o1); } }
    }
    SEAM(10);
    if (IN(11)) _Pragma("unroll") for (int rep = 0; rep < REPS(11); ++rep) { pg8::Gemm g{XC, (const bf16_t*)(ws + WS_W_GATE), MTOK, 2048, 256, 1024, 1}; pg8::StaticOrder S; S.init(MTOK, 2048, G, bx);
        pg8::EpiGates E{XC, LA, BB, a.in[22], a.in[24], SP}; pg8::gemm_phase(lds, g, S, E); }
    SEAM(11);
    if (IN(12)) _Pragma("unroll") for (int rep = 0; rep < REPS(12); ++rep) {
        LAS float* car = (LAS float*)lds;
        for (int u = bx; u < 256; u += G) { const int b = u >> 3, c0 = (u & 7) * 128 + 2 * lane; const size_t rbase = (size_t)b * SEQ + wave * 256;
            const bf16_t* la = LA + rbase * 1024 + c0; const bf16_t* bb = BB + rbase * 1024 + c0;
            float h0 = 0.f, h1 = 0.f, s0 = 0.f, s1 = 0.f;
#pragma unroll 8
            for (int t = 0; t < 256; ++t) { const unsigned lw = *(const unsigned*)(la + (size_t)t * 1024), bw = *(const unsigned*)(bb + (size_t)t * 1024);
                const float l0 = bflo(lw), l1 = bfhi(lw); s0 += l0; s1 += l1;
                h0 = fast_exp2(l0 * LOG2E) * h0 + bflo(bw); h1 = fast_exp2(l1 * LOG2E) * h1 + bfhi(bw); }
            __syncthreads();
            car[(wave * 64 + lane) * 4 + 0] = fast_exp2(s0 * LOG2E); car[(wave * 64 + lane) * 4 + 1] = fast_exp2(s1 * LOG2E); car[(wave * 64 + lane) * 4 + 2] = h0; car[(wave * 64 + lane) * 4 + 3] = h1;
            __syncthreads();
            h0 = 0.f; h1 = 0.f;
            for (int j = 0; j < wave; ++j) { const f32x4 cv = *(const LAS f32x4*)(car + (j * 64 + lane) * 4); h0 = cv.x * h0 + cv.z; h1 = cv.y * h1 + cv.w; }
            const bf16_t* gb = Z + rbase * 2048 + 1024 + c0; bf16_t* yo = Y1 + rbase * 1024 + c0;
#pragma unroll 8
            for (int t = 0; t < 256; ++t) { const unsigned lw = *(const unsigned*)(la + (size_t)t * 1024), bw = *(const unsigned*)(bb + (size_t)t * 1024), gwv = *(const unsigned*)(gb + (size_t)t * 2048);
                h0 = fast_exp2(bflo(lw) * LOG2E) * h0 + bflo(bw); h1 = fast_exp2(bfhi(lw) * LOG2E) * h1 + bfhi(bw);
                *(unsigned*)(yo + (size_t)t * 1024) = pk2(h0 * bflo(gwv), h1 * bfhi(gwv)); }
        }
    }
    SEAM(12);
    if (IN(13)) _Pragma("unroll") for (int rep = 0; rep < REPS(13); ++rep) { pg8::Gemm g{Y1, (const bf16_t*)(ws + WS_W_OUT1), MTOK, 1024, 1024, 1024, 0}; pg8::StaticOrder S; S.init(MTOK, 1024, G, bx);
        pg8::EpiPlain E{MIX, 1024}; pg8::gemm_phase(lds, g, S, E); }
    SEAM(13);
    if (IN(14)) _Pragma("unroll") for (int rep = 0; rep < REPS(14); ++rep) for (int m = gw; m < MTOK; m += NGW) resnorm_row(X + (size_t)m * DM, MIX + (size_t)m * DM, g_mix_post + DM, X + (size_t)m * DM, g_ffn_pre + DM, HN + (size_t)m * DM, lane);
    SEAM(14);
    if (IN(15)) _Pragma("unroll") for (int rep = 0; rep < REPS(15); ++rep) { pg8::Gemm g{HN, (const bf16_t*)(ws + WS_W_UP1), MTOK, 2 * FFH, 1024, 1024, 0}; pg8::StaticOrder S; S.init(MTOK, 2 * FFH, G, bx);
        pg8::EpiSwiGlu E{HID}; pg8::gemm_phase(lds, g, S, E); }
    SEAM(15);
    if (IN(16)) _Pragma("unroll") for (int rep = 0; rep < REPS(16); ++rep) { pg8::Gemm g{HID, (const bf16_t*)(ws + WS_W_DN1), MTOK, 1024, FFH, FFH, 0}; pg8::StaticOrder S; S.init(MTOK, 1024, G, bx);
        pg8::EpiPlain E{MIX, 1024}; pg8::gemm_phase(lds, g, S, E); }
    SEAM(16);
    if (IN(17)) _Pragma("unroll") for (int rep = 0; rep < REPS(17); ++rep) for (int m = gw; m < MTOK; m += NGW) resnorm_row(X + (size_t)m * DM, MIX + (size_t)m * DM, g_ffn_post + DM, X + (size_t)m * DM, nullptr, nullptr, lane);
#undef IN
#undef SEAM
#undef a
#undef ws
}
constexpr int NPHASES = 18;

extern "C" void kernel_launch(void* const* d_in, const int* in_sizes, int n_in, void* d_out, int out_size, void* d_ws, size_t ws_size, hipStream_t stream) {
    static int grid = 0;
    if (grid == 0) {
        if (n_in != 29 || in_sizes[0] != MTOK * DM || out_size != MTOK * DM || ws_size < WS_END) {
            fprintf(stderr, "kernel_launch: unexpected shapes: n_in %d in0 %d out %d ws %zu (need %zu)\n", n_in, n_in > 0 ? in_sizes[0] : -1, out_size, ws_size, (size_t)WS_END); grid = -1; return; }
        int dev = 0, cus = 0, per_cu = 0;
        hipGetDevice(&dev); hipDeviceGetAttribute(&cus, hipDeviceAttributeMultiprocessorCount, dev);
        if (hipFuncSetAttribute((const void*)mega, hipFuncAttributeMaxDynamicSharedMemorySize, LDS_BYTES) != hipSuccess) { fprintf(stderr, "kernel_launch: hipFuncSetAttribute failed\n"); grid = -1; return; }
        if (hipOccupancyMaxActiveBlocksPerMultiprocessor(&per_cu, (const void*)mega, NTHREADS, LDS_BYTES) != hipSuccess || per_cu < 1) { fprintf(stderr, "kernel_launch: occupancy query says %d\n", per_cu); per_cu = 1; }
        (void)hipGetLastError();
        grid = cus;
    }
    if (grid < 0) return;
    if (hipMemsetAsync((char*)d_ws + WS_CTL, 0, CTL_BYTES, stream) != hipSuccess) { fprintf(stderr, "kernel_launch: memset failed\n"); return; }
    Args a{};
    for (int i = 0; i < 29; ++i) a.in[i] = (const float*)d_in[i];
    a.out = (float*)d_out; a.ws = (unsigned char*)d_ws;
#if N_LAUNCH_MODE == 1
    a.ph_lo = 0; a.ph_hi = NPHASES;
    void* args[] = {&a};
    hipError_t e = hipLaunchCooperativeKernel((const void*)mega, dim3(grid), dim3(NTHREADS), args, LDS_BYTES, stream);
    if (e != hipSuccess) fprintf(stderr, "cooperative launch failed: %s (grid %d)\n", hipGetErrorString(e), grid);
#else
    for (int ph = 0; ph < NPHASES; ++ph) { a.ph_lo = ph; a.ph_hi = ph + 1; hipLaunchKernelGGL(mega, dim3(grid), dim3(NTHREADS), LDS_BYTES, stream, a); }
#endif
}
```

```cpp
#include <hip/hip_runtime.h>
#include <hip/hip_cooperative_groups.h>
#include <cstdio>
#include <cstdint>
namespace cg = cooperative_groups;

#ifndef N_LAUNCH_MODE
#define N_LAUNCH_MODE 1
#endif

#define LAS __attribute__((address_space(3)))
typedef unsigned short bf16_t;
typedef short bf16x8 __attribute__((ext_vector_type(8)));
typedef float f32x4 __attribute__((ext_vector_type(4)));
typedef unsigned u32x4 __attribute__((ext_vector_type(4)));
typedef unsigned u32x2 __attribute__((ext_vector_type(2)));

constexpr int MTOK = 65536, DM = 1024, SEQ = 2048, NBATCH = 32, FFH = 2816;
constexpr float NORM_EPS = 1e-6f;
constexpr float LOG2E = 1.4426950408889634f;
constexpr int NWAVES = 8, NTHREADS = 512;
constexpr int LDS_BYTES = 136 * 1024;

constexpr size_t MiB = 1u << 20;
constexpr size_t WS_CTL = 0;
constexpr size_t WS_W_IN0 = 1 * MiB, WS_W_OUT0 = 5 * MiB, WS_W_GLU = 7 * MiB, WS_W_IN1 = 8 * MiB, WS_W_OUT1 = 12 * MiB, WS_W_GATE = 14 * MiB;
constexpr size_t WS_W_UP0 = 15 * MiB, WS_W_UP1 = 26 * MiB, WS_W_DN0 = 37 * MiB, WS_W_DN1 = 43 * MiB;
constexpr size_t WS_ROPE = 49 * MiB;
constexpr size_t WS_S5TAB = 53 * MiB;
constexpr size_t S5_ABAR = 0, S5_BM = 16384, S5_CM = 16384 + 262144, S5_SP = 16384 + 262144 + 131072;
constexpr size_t WS_HN = 64 * MiB, WS_Z = 192 * MiB, WS_YC = 448 * MiB, WS_MIX = 576 * MiB, WS_PO = 704 * MiB, WS_PM = 896 * MiB, WS_PL = 902 * MiB, WS_Y5 = 908 * MiB;
constexpr size_t WS_HID = 192 * MiB;
constexpr size_t WS_XC = 448 * MiB, WS_BB = 576 * MiB, WS_Y1 = 704 * MiB, WS_LA = 832 * MiB;
constexpr size_t WS_END = 972 * MiB;

struct Args { const float* in[29]; float* out; unsigned char* ws; int ph_lo, ph_hi; };

__device__ __forceinline__ unsigned f2bf(float f) { unsigned u = __builtin_bit_cast(unsigned, f); return (u + 0x7fffu + ((u >> 16) & 1u)) >> 16; }
__device__ __forceinline__ unsigned pk2(float lo, float hi) { unsigned r; asm("v_cvt_pk_bf16_f32 %0, %1, %2" : "=v"(r) : "v"(lo), "v"(hi)); return r; }
__device__ __forceinline__ float bf2f(unsigned short h) { return __builtin_bit_cast(float, (unsigned)h << 16); }
__device__ __forceinline__ float bflo(unsigned w) { return __builtin_bit_cast(float, w << 16); }
__device__ __forceinline__ float bfhi(unsigned w) { return __builtin_bit_cast(float, w & 0xffff0000u); }
__device__ __forceinline__ float fast_exp2(float x) { return __builtin_amdgcn_exp2f(x); }
__device__ __forceinline__ float fast_rcp(float x) { return __builtin_amdgcn_rcpf(x); }
__device__ __forceinline__ float sigmoidf_(float x) { return fast_rcp(1.f + fast_exp2(-x * LOG2E)); }
__device__ __forceinline__ float gelu_tanh(float x) { const float u = 0.7978845608028654f * (x + 0.044715f * x * x * x); return x * sigmoidf_(2.f * u); }
__device__ __forceinline__ float wave_sum(float v) {
#pragma unroll
    for (int o = 1; o < 64; o <<= 1) v += __shfl_xor(v, o);
    return v;
}
#define LDS_WAIT() asm volatile("s_waitcnt lgkmcnt(0)" ::: "memory")

namespace pg8 {
constexpr int BM = 256, BK = 64, HALF = 128, HTB = HALF * BK * 2, STAGE_BYTES = 8 * HTB, NXCD = 8, WGM = 8;
__host__ __device__ __forceinline__ int lds_byte(int r, int c) { const int st = (r >> 4) * 2 + (c >> 5), rr = r & 15, cc = c & 31, ob = rr * 64 + cc * 2; return st * 1024 + (ob ^ (((ob >> 9) & 1) << 5)); }
__host__ __device__ __forceinline__ void stage_rc(int b, int& R, int& C) { const int st = b / 1024, sb = b % 1024, swz = sb ^ (((sb >> 9) & 1) << 5); R = (st >> 1) * 16 + swz / 64; C = (st & 1) * 32 + (swz % 64) / 2; }
__host__ __device__ __forceinline__ int perm32(int rho) { const int n = rho >> 4, i = rho & 15; return 8 * (i >> 2) + 4 * n + (i & 3); }
struct Unit { int pm, pn; };
struct Gemm { const bf16_t* A; const bf16_t* Bt; int M, N, K, lda, grp; };
struct StaticOrder {
    int nM, nN, nwg, G, c;
    __host__ __device__ void init(int M, int N, int G_, int c_) { nM = M / BM; nN = N / BM; nwg = nM * nN; G = G_; c = c_; }
    __host__ __device__ bool next(int i, Unit& u) const {
        const long L = (long)i * G + c; if (L >= nwg) return false;
        int wgid = (int)L; { const int q = nwg / NXCD, r = nwg % NXCD, xcd = wgid % NXCD, off = wgid / NXCD; wgid = (xcd < r ? xcd * (q + 1) : r * (q + 1) + (xcd - r) * q) + off; }
        const int nig = WGM * nN, gid = wgid / nig, fm = gid * WGM, gsz = (nM - fm) < WGM ? (nM - fm) : WGM;
        u.pm = fm + ((wgid % nig) % gsz); u.pn = (wgid % nig) / gsz; return true;
    }
};
template <class Epi>
__device__ __forceinline__ void gemm_phase(LAS unsigned char* lds, const Gemm g, const StaticOrder& S, const Epi& E) {
    int tid_ = threadIdx.x; asm volatile("" : "+v"(tid_));
    const int tid = tid_, wid = __builtin_amdgcn_readfirstlane(tid >> 6), lane = tid & 63, wr = wid >> 2, wc = wid & 3, fr = lane & 15, fq = lane >> 4;
    const int K = g.K, nt = K / BK, lda = g.lda;
    unsigned voffA[2], voffB[2];
#pragma unroll
    for (int i = 0; i < 2; ++i) { int R, C; stage_rc(tid * 16 + i * 8192, R, C); const int Rb = (R & ~31) + perm32(R & 31);
        voffA[i] = (unsigned)(R * lda + C) * 2u; voffB[i] = (unsigned)(Rb * K + C) * 2u; }
    const size_t kstep = (size_t)(BK * 2);
    const size_t hstepA = (size_t)HALF * lda * 2, hstepB = (size_t)HALF * K * 2;
    const size_t tstepA = 2 * hstepA, tstepB = 2 * hstepB;
    const unsigned ldsw = (unsigned)wid * 1024u;
    const int aoff = lds_byte(wr * 64 + fr, fq * 8), boff = lds_byte(wc * 32 + fr, fq * 8);
#define PG8_SA(b, h) (((b) * 2 + (h)) * HTB)
#define PG8_SB(b, h) ((4 + (b) * 2 + (h)) * HTB)
#define PG8_STAGE(bufoff, gbase, voff) do { _Pragma("unroll") for (int _i = 0; _i < 2; ++_i) \
        __builtin_amdgcn_global_load_lds((const unsigned*)((const char*)(gbase) + (voff)[_i]), (LAS unsigned*)(lds + (bufoff) + ldsw + _i * 8192), 16, 0, 0); } while (0)
#define PG8_LDA(dst, b, h) do { _Pragma("unroll") for (int m = 0; m < 4; ++m) _Pragma("unroll") for (int k = 0; k < 2; ++k) dst[m][k] = *(const LAS bf16x8*)(lds + PG8_SA(b, h) + aoff + m * 2048 + k * 1024); } while (0)
#define PG8_LDB(dst, b, h) do { _Pragma("unroll") for (int n = 0; n < 2; ++n) _Pragma("unroll") for (int k = 0; k < 2; ++k) dst[n][k] = *(const LAS bf16x8*)(lds + PG8_SB(b, h) + boff + n * 2048 + k * 1024); } while (0)
#define PG8_MMA(ai, bj, At, Bt) do { __builtin_amdgcn_s_setprio(1); _Pragma("unroll") for (int m = 0; m < 4; ++m) _Pragma("unroll") for (int n = 0; n < 2; ++n) _Pragma("unroll") for (int k = 0; k < 2; ++k) \
        acc[ai][bj][m][n] = __builtin_amdgcn_mfma_f32_16x16x32_bf16(Bt[n][k], At[m][k], acc[ai][bj][m][n], 0, 0, 0); __builtin_amdgcn_s_setprio(0); } while (0)
#define PG8_WAIT_V(n) asm volatile("s_waitcnt vmcnt(" #n ")" ::: "memory")
#define PG8_WAIT_L(n) asm volatile("s_waitcnt lgkmcnt(" #n ")" ::: "memory")
#define PG8_BAR __builtin_amdgcn_s_barrier()
#define PG8_SCHED __builtin_amdgcn_sched_barrier(0)
    Unit cur, nxt; int ui = 0;
    if (!S.next(0, cur)) return;
    f32x4 acc[2][2][4][2];
#pragma unroll
    for (int a = 0; a < 2; ++a)
#pragma unroll
        for (int b = 0; b < 2; ++b)
#pragma unroll
            for (int m = 0; m < 4; ++m)
#pragma unroll
                for (int n = 0; n < 2; ++n) acc[a][b][m][n] = (f32x4){0.f, 0.f, 0.f, 0.f};
    bf16x8 At[4][2], B0[2][2], B1[2][2];
    const char* cA = (const char*)g.A + (size_t)cur.pm * tstepA + (g.grp ? (size_t)(cur.pn >> 1) * K * 2 : 0); const char* cB = (const char*)g.Bt + (size_t)cur.pn * tstepB;
    PG8_STAGE(PG8_SB(0, 0), cB, voffB); PG8_STAGE(PG8_SB(0, 1), cB + hstepB, voffB); PG8_STAGE(PG8_SA(0, 0), cA, voffA); PG8_STAGE(PG8_SA(0, 1), cA + hstepA, voffA);
    if (wr == 1) PG8_BAR;
    PG8_WAIT_V(2); PG8_BAR;
    PG8_STAGE(PG8_SB(1, 0), cB + kstep, voffB); PG8_STAGE(PG8_SA(1, 0), cA + kstep, voffA); PG8_STAGE(PG8_SB(1, 1), cB + hstepB + kstep, voffB);
    PG8_WAIT_V(6); PG8_BAR;
    for (;;) {
        const bool has_next = S.next(ui + 1, nxt);
        const char* nA = has_next ? (const char*)g.A + (size_t)nxt.pm * tstepA + (g.grp ? (size_t)(nxt.pn >> 1) * K * 2 : 0) : cA; const char* nB = has_next ? (const char*)g.Bt + (size_t)nxt.pn * tstepB : cB;
        for (int t = 0; t < nt; t += 2) {
            const bool last = (t == nt - 2);
            const char* a1 = cA + (size_t)(t + 1) * kstep;
            const char* a2 = last ? nA : cA + (size_t)(t + 2) * kstep; const char* b2 = last ? nB : cB + (size_t)(t + 2) * kstep;
            const char* a3 = a2 + kstep; const char* b3 = b2 + kstep;
            PG8_LDB(B0, 0, 0); PG8_LDB(B1, 0, 1); PG8_SCHED; PG8_LDA(At, 0, 0); PG8_STAGE(PG8_SA(1, 1), a1 + hstepA, voffA);
            PG8_WAIT_V(8); PG8_WAIT_L(0); PG8_BAR; PG8_MMA(0, 0, At, B0); PG8_MMA(0, 1, At, B1); PG8_BAR; PG8_SCHED;
            PG8_LDA(At, 0, 1); PG8_STAGE(PG8_SB(0, 0), b2, voffB); PG8_STAGE(PG8_SB(0, 1), b2 + hstepB, voffB); PG8_STAGE(PG8_SA(0, 0), a2, voffA);
            PG8_WAIT_V(8); PG8_WAIT_L(0); PG8_BAR; PG8_MMA(1, 0, At, B0); PG8_MMA(1, 1, At, B1); PG8_BAR; PG8_SCHED;
            PG8_LDB(B0, 1, 0); PG8_LDB(B1, 1, 1); PG8_SCHED; PG8_LDA(At, 1, 0); PG8_STAGE(PG8_SA(0, 1), a2 + hstepA, voffA);
            PG8_WAIT_V(8); PG8_WAIT_L(0); PG8_BAR; PG8_MMA(0, 0, At, B0); PG8_MMA(0, 1, At, B1); PG8_BAR; PG8_SCHED;
            PG8_LDA(At, 1, 1); PG8_STAGE(PG8_SB(1, 0), b3, voffB); PG8_STAGE(PG8_SB(1, 1), b3 + hstepB, voffB); PG8_STAGE(PG8_SA(1, 0), a3, voffA);
            PG8_WAIT_V(8); PG8_WAIT_L(0); PG8_BAR; PG8_MMA(1, 0, At, B0); PG8_MMA(1, 1, At, B1); PG8_BAR; PG8_SCHED;
        }
        if (wr == 0) PG8_BAR;
        E(acc, cur, wr, wc, fr, fq);
        if (!has_next) break;
#pragma unroll
        for (int a = 0; a < 2; ++a)
#pragma unroll
            for (int b = 0; b < 2; ++b)
#pragma unroll
                for (int m = 0; m < 4; ++m)
#pragma unroll
                    for (int n = 0; n < 2; ++n) acc[a][b][m][n] = (f32x4){0.f, 0.f, 0.f, 0.f};
        cur = nxt; cA = nA; cB = nB; ++ui;
        if (wr == 1) PG8_BAR;
    }
    PG8_WAIT_V(0);
    PG8_BAR;
#undef PG8_SA
#undef PG8_SB
#undef PG8_STAGE
#undef PG8_LDA
#undef PG8_LDB
#undef PG8_MMA
#undef PG8_WAIT_V
#undef PG8_WAIT_L
#undef PG8_BAR
#undef PG8_SCHED
}
typedef f32x4 AccT[2][2][4][2];

__device__ __forceinline__ void st8(bf16_t* p, f32x4 v0, f32x4 v1) {
    u32x4 w; w.x = pk2(v0[0], v0[1]); w.y = pk2(v0[2], v0[3]); w.z = pk2(v1[0], v1[1]); w.w = pk2(v1[2], v1[3]); *(u32x4*)p = w;
}
struct EpiPlain {
    bf16_t* O; int ldc;
    __device__ __forceinline__ void operator()(const AccT& acc, const Unit& u, int wr, int wc, int fr, int fq) const {
        const int row0 = u.pm * BM + wr * 64 + fr, col0 = u.pn * BM + wc * 32 + 8 * fq;
#pragma unroll
        for (int ai = 0; ai < 2; ++ai)
#pragma unroll
            for (int m = 0; m < 4; ++m) { bf16_t* rowp = O + (size_t)(row0 + ai * HALF + m * 16) * ldc + col0;
#pragma unroll
                for (int bj = 0; bj < 2; ++bj) st8(rowp + bj * HALF, acc[ai][bj][m][0], acc[ai][bj][m][1]); }
    }
};
struct EpiRope {
    bf16_t* Z; const float* rope;
    __device__ __forceinline__ void operator()(const AccT& acc, const Unit& u, int wr, int wc, int fr, int fq) const {
        const int row0 = u.pm * BM + wr * 64 + fr, col0 = u.pn * BM + wc * 32 + 8 * fq;
        const bool ropew = (u.pn < 4) && !(wc & 1); const float sc = (u.pn < 2) ? 0.125f * LOG2E : 1.f;
#pragma unroll
        for (int ai = 0; ai < 2; ++ai)
#pragma unroll
            for (int m = 0; m < 4; ++m) { const int row = row0 + ai * HALF + m * 16; bf16_t* rowp = Z + (size_t)row * 2048 + col0;
                f32x4 c0 = {1.f, 1.f, 1.f, 1.f}, c1 = c0, s0 = {0.f, 0.f, 0.f, 0.f}, s1 = s0;
                if (ropew && fq < 2) { const f32x4* rp = (const f32x4*)(rope + (size_t)row * 16); c0 = rp[0]; c1 = rp[1]; s0 = rp[2]; s1 = rp[3]; if (fq == 0) { s0 = -s0; s1 = -s1; } }
#pragma unroll
                for (int bj = 0; bj < 2; ++bj) { f32x4 v0 = acc[ai][bj][m][0], v1 = acc[ai][bj][m][1];
                    if (ropew) { f32x4 p0, p1;
#pragma unroll
                        for (int i = 0; i < 4; ++i) { p0[i] = __shfl_xor(v0[i], 16); p1[i] = __shfl_xor(v1[i], 16); }
                        v0 = v0 * c0 + p0 * s0; v1 = v1 * c1 + p1 * s1; }
                    v0 = v0 * sc; v1 = v1 * sc; st8(rowp + bj * HALF, v0, v1); } }
    }
};
struct EpiGlu {
    const bf16_t* Y; bf16_t* O;
    __device__ __forceinline__ void operator()(const AccT& acc, const Unit& u, int wr, int wc, int fr, int fq) const {
        const int row0 = u.pm * BM + wr * 64 + fr, col0 = u.pn * BM + wc * 32 + 8 * fq;
#pragma unroll
        for (int ai = 0; ai < 2; ++ai)
#pragma unroll
            for (int m = 0; m < 4; ++m) { const int row = row0 + ai * HALF + m * 16;
#pragma unroll
                for (int bj = 0; bj < 2; ++bj) { const int col = col0 + bj * HALF; const u32x4 yw = *(const u32x4*)(Y + (size_t)row * 512 + col);
                    f32x4 a0 = acc[ai][bj][m][0], a1 = acc[ai][bj][m][1], v0, v1;
                    v0[0] = bflo(yw.x) * sigmoidf_(a0[0]); v0[1] = bfhi(yw.x) * sigmoidf_(a0[1]); v0[2] = bflo(yw.y) * sigmoidf_(a0[2]); v0[3] = bfhi(yw.y) * sigmoidf_(a0[3]);
                    v1[0] = bflo(yw.z) * sigmoidf_(a1[0]); v1[1] = bfhi(yw.z) * sigmoidf_(a1[1]); v1[2] = bflo(yw.w) * sigmoidf_(a1[2]); v1[3] = bfhi(yw.w) * sigmoidf_(a1[3]);
                    st8(O + (size_t)row * 1024 + 512 + col, v0, v1); } }
    }
};
struct EpiSwiGlu {
    bf16_t* O;
    __device__ __forceinline__ void operator()(const AccT& acc, const Unit& u, int wr, int wc, int fr, int fq) const {
        const int row0 = u.pm * BM + wr * 64 + fr, col0 = u.pn * HALF + wc * 32 + 8 * fq;
#pragma unroll
        for (int ai = 0; ai < 2; ++ai)
#pragma unroll
            for (int m = 0; m < 4; ++m) { const int row = row0 + ai * HALF + m * 16; f32x4 v[2];
#pragma unroll
                for (int n = 0; n < 2; ++n)
#pragma unroll
                    for (int i = 0; i < 4; ++i) { const float gt = acc[ai][0][m][n][i], up = acc[ai][1][m][n][i]; v[n][i] = gt * sigmoidf_(gt) * up; }
                st8(O + (size_t)row * FFH + col0, v[0], v[1]); }
    }
};
struct EpiIn1 {
    bf16_t* Z;
    __device__ __forceinline__ void operator()(const AccT& acc, const Unit& u, int wr, int wc, int fr, int fq) const {
        const int row0 = u.pm * BM + wr * 64 + fr, col0 = u.pn * BM + wc * 32 + 8 * fq; const bool act = u.pn >= 4;
#pragma unroll
        for (int ai = 0; ai < 2; ++ai)
#pragma unroll
            for (int m = 0; m < 4; ++m) { bf16_t* rowp = Z + (size_t)(row0 + ai * HALF + m * 16) * 2048 + col0;
#pragma unroll
                for (int bj = 0; bj < 2; ++bj) { f32x4 v0 = acc[ai][bj][m][0], v1 = acc[ai][bj][m][1];
                    if (act) {
#pragma unroll
                        for (int i = 0; i < 4; ++i) { v0[i] = gelu_tanh(v0[i]); v1[i] = gelu_tanh(v1[i]); } }
                    st8(rowp + bj * HALF, v0, v1); } }
    }
};
struct EpiGates {
    const bf16_t* XC; bf16_t* LA; bf16_t* BB; const float* b_r; const float* b_i; const float* sp;
    __device__ __forceinline__ void operator()(const AccT& acc, const Unit& u, int wr, int wc, int fr, int fq) const {
        const int row0 = u.pm * BM + wr * 64 + fr, c0 = (u.pn >> 1) * 256 + (u.pn & 1) * 128 + wc * 32 + 8 * fq;
#pragma unroll
        for (int ai = 0; ai < 2; ++ai)
#pragma unroll
            for (int m = 0; m < 4; ++m) { const int row = row0 + ai * HALF + m * 16;
#pragma unroll
                for (int n = 0; n < 2; ++n) { const int c = c0 + 4 * n; const u32x2 xw = *(const u32x2*)(XC + (size_t)row * 1024 + c);
                    const f32x4 br = *(const f32x4*)(b_r + c), bi = *(const f32x4*)(b_i + c), spv = *(const f32x4*)(sp + c);
                    const float xv[4] = {bflo(xw.x), bfhi(xw.x), bflo(xw.y), bfhi(xw.y)}; float la[4], bb[4];
#pragma unroll
                    for (int i = 0; i < 4; ++i) { const float gr = sigmoidf_(acc[ai][0][m][n][i] + br[i]), gi = sigmoidf_(acc[ai][1][m][n][i] + bi[i]);
                        const float l = -8.f * gr * spv[i]; const float a2 = fast_exp2(2.f * l * LOG2E); const float mult = sqrtf(fmaxf(1.f - a2, 0.f));
                        la[i] = l; bb[i] = mult * gi * xv[i]; }
                    u32x2 w0, w1; w0.x = pk2(la[0], la[1]); w0.y = pk2(la[2], la[3]); w1.x = pk2(bb[0], bb[1]); w1.y = pk2(bb[2], bb[3]);
                    *(u32x2*)(LA + (size_t)row * 1024 + c) = w0; *(u32x2*)(BB + (size_t)row * 1024 + c) = w1; __builtin_amdgcn_sched_barrier(0); } }
    }
};
}

__device__ __forceinline__ void transpose_item(const float* W, int ld, int K, bf16_t* dst, int k0, LAS float* scr, int lane) {
#pragma unroll 8
    for (int i = 0; i < 32; ++i) { const int kk = 2 * i + (lane >> 5); scr[kk * 33 + (lane & 31)] = W[(size_t)(k0 + kk) * ld + (lane & 31)]; }
    LDS_WAIT();
    const int c = lane & 7;
#pragma unroll
    for (int j = 0; j < 4; ++j) { const int n = (lane >> 3) + 8 * j; const LAS float* s = scr + (8 * c) * 33 + n;
        u32x4 o; o.x = pk2(s[0 * 33], s[1 * 33]); o.y = pk2(s[2 * 33], s[3 * 33]); o.z = pk2(s[4 * 33], s[5 * 33]); o.w = pk2(s[6 * 33], s[7 * 33]);
        *(u32x4*)(dst + (size_t)n * K + k0 + 8 * c) = o; }
    LDS_WAIT();
}
__device__ __forceinline__ void sincos_rr(float ang, float& s, float& c) {
    const double r = (double)ang * 0.15915494309189535; const double fr = r - __builtin_rint(r); const float f = (float)fr;
    s = __builtin_amdgcn_sinf(f); c = __builtin_amdgcn_cosf(f);
}
__device__ __forceinline__ void rms_row_to_bf16(const float* xrow, const float* g, bf16_t* orow, int lane) {
    const f32x4* xr = (const f32x4*)xrow + lane; const f32x4* gr = (const f32x4*)g + lane;
    f32x4 v[4]; float s = 0.f;
#pragma unroll
    for (int j = 0; j < 4; ++j) { v[j] = xr[64 * j]; s += (v[j].x * v[j].x + v[j].y * v[j].y) + (v[j].z * v[j].z + v[j].w * v[j].w); }
    const float rstd = 1.f / sqrtf(wave_sum(s) * (1.f / DM) + NORM_EPS);
    u32x2* o8 = (u32x2*)orow + lane;
#pragma unroll
    for (int j = 0; j < 4; ++j) { const f32x4 gg = gr[64 * j]; u32x2 w; w.x = pk2(v[j].x * rstd * gg.x, v[j].y * rstd * gg.y); w.y = pk2(v[j].z * rstd * gg.z, v[j].w * rstd * gg.w); o8[64 * j] = w; }
}
__device__ __forceinline__ void resnorm_row(const float* xin, const bf16_t* mix, const float* gpost, float* xout, const float* gpre, bf16_t* hn, int lane) {
    const f32x4* xr = (const f32x4*)xin + lane; const u32x2* mr = (const u32x2*)mix + lane; const f32x4* gp = (const f32x4*)gpost + lane;
    f32x4 v[4]; float s = 0.f;
#pragma unroll
    for (int j = 0; j < 4; ++j) { const u32x2 w = mr[64 * j]; v[j] = (f32x4){bflo(w.x), bfhi(w.x), bflo(w.y), bfhi(w.y)}; s += (v[j].x * v[j].x + v[j].y * v[j].y) + (v[j].z * v[j].z + v[j].w * v[j].w); }
    const float rstd = 1.f / sqrtf(wave_sum(s) * (1.f / DM) + NORM_EPS);
    float s2 = 0.f;
#pragma unroll
    for (int j = 0; j < 4; ++j) { const f32x4 gg = gp[64 * j]; v[j] = xr[64 * j] + v[j] * rstd * gg; s2 += (v[j].x * v[j].x + v[j].y * v[j].y) + (v[j].z * v[j].z + v[j].w * v[j].w);
        ((f32x4*)xout + lane)[64 * j] = v[j]; }
    if (hn) { const float rstd2 = 1.f / sqrtf(wave_sum(s2) * (1.f / DM) + NORM_EPS); const f32x4* gq = (const f32x4*)gpre + lane; u32x2* o8 = (u32x2*)hn + lane;
#pragma unroll
        for (int j = 0; j < 4; ++j) { const f32x4 gg = gq[64 * j]; u32x2 w; w.x = pk2(v[j].x * rstd2 * gg.x, v[j].y * rstd2 * gg.y); w.y = pk2(v[j].z * rstd2 * gg.z, v[j].w * rstd2 * gg.w); o8[64 * j] = w; } }
}

constexpr int AT_KPITCH = 144, AT_VPITCH = 160, AT_VOFF = 256 * AT_KPITCH;
constexpr int AT_UNITS = 12288, AT_HEAD = 12;
typedef short s16x4 __attribute__((ext_vector_type(4)));
__device__ __forceinline__ int attn_seq(int bx, int G, int i) {
    if (G != 256) { const int u = bx + i * G; return u < AT_UNITS ? u : -1; }
    if (bx >= 128) { if (i < AT_HEAD) return (bx - 128) + 128 * i; i -= AT_HEAD; }
    const int u = 128 * AT_HEAD + i * 256 + bx; return u < AT_UNITS ? u : -1;
}
#define AT_DECODE(u) const int sub = (u) & 15, br = ((u) >> 4) % 3, bh = (u) / 48, h = bh & 7, b = bh >> 3; \
    const int dil = br == 0 ? 1 : (br == 1 ? 4 : 16), nb = 16 / dil, rho = sub / nb, n = sub % nb; const bf16_t* Zb = Zp + (size_t)b * SEQ * 2048;
__device__ __forceinline__ void attn_issue(const bf16_t* Zp, int u, int tid, int wave, int lane, u32x4 (&rk)[4], u32x4 (&rv)[4], bf16x8& q0, bf16x8& q1) {
    AT_DECODE(u)
#pragma unroll
    for (int it = 0; it < 4; ++it) { if (n == 0 && it < 2) continue; const int idx = tid + it * NTHREADS, kb = idx >> 3, ch = idx & 7;
        const int tok = (n * 128 - 128 + kb) * dil + rho;
        const bf16_t* rowp = Zb + (size_t)tok * 2048 + h * 64 + ch * 8;
        rk[it] = *(const u32x4*)(rowp + 512); rv[it] = *(const u32x4*)(rowp + 1024); }
    const int kq = lane >> 4, qi = 16 * wave + (lane & 15); const int tokq = (n * 128 + qi) * dil + rho;
    const bf16_t* qrow = Zb + (size_t)tokq * 2048 + h * 64;
    q0 = *(const bf16x8*)(qrow + 8 * kq); q1 = *(const bf16x8*)(qrow + 32 + 8 * kq);
}
__device__ __forceinline__ void attn_phase(const bf16_t* Zp, bf16_t* POp, float* PMp, float* PLp, LAS unsigned char* lds, int bx, int G, int tid, int wave, int lane) {
    int ui = 0; int u = attn_seq(bx, G, 0); if (u < 0) return;
    u32x4 rk[4], rv[4]; bf16x8 q0n, q1n;
    attn_issue(Zp, u, tid, wave, lane, rk, rv, q0n, q1n);
    const int q = lane & 15, kq = lane >> 4, qi = 16 * wave + q;
    for (;;) {
        AT_DECODE(u)
        (void)Zb;
        __syncthreads();
#pragma unroll
        for (int it = 0; it < 4; ++it) { if (n == 0 && it < 2) continue; const int idx = tid + it * NTHREADS, kb = idx >> 3, ch = idx & 7;
            *(LAS u32x4*)(lds + kb * AT_KPITCH + ch * 16) = rk[it]; *(LAS u32x4*)(lds + AT_VOFF + kb * AT_VPITCH + ch * 16) = rv[it]; }
        if (n == 0 && tid < 128) *(LAS u32x4*)(lds + AT_VOFF + (112 + (tid >> 3)) * AT_VPITCH + (tid & 7) * 16) = (u32x4){0u, 0u, 0u, 0u};
        const bf16x8 qf0 = q0n, qf1 = q1n;
        __syncthreads();
        const int un = attn_seq(bx, G, ui + 1);
        if (un >= 0) attn_issue(Zp, un, tid, wave, lane, rk, rv, q0n, q1n);
        f32x4 o[4];
#pragma unroll
        for (int mm = 0; mm < 4; ++mm) o[mm] = (f32x4){0.f, 0.f, 0.f, 0.f};
        float mrun = -1e30f, lrun = 0.f;
        const int kstart = (16 * wave < 96) ? 16 * wave : 96;
        for (int p = 0; p < 5; ++p) {
            const int ks = kstart + 32 * p;
            if (n == 0 && ks + 32 <= 128) continue;
            if (ks + 31 < 16 * wave) continue;
            const LAS unsigned char* kp = lds + (ks + q) * AT_KPITCH + kq * 16;
            const bf16x8 k00 = *(const LAS bf16x8*)(kp), k01 = *(const LAS bf16x8*)(kp + 64);
            const bf16x8 k10 = *(const LAS bf16x8*)(kp + 16 * AT_KPITCH), k11 = *(const LAS bf16x8*)(kp + 16 * AT_KPITCH + 64);
            const LAS unsigned char* vp = lds + AT_VOFF + (ks + 4 * kq + (q >> 2)) * AT_VPITCH + (q & 3) * 8;
            s16x4 vlo[4], vhi[4];
#pragma unroll
            for (int mm = 0; mm < 4; ++mm) { vlo[mm] = __builtin_bit_cast(s16x4, __builtin_amdgcn_ds_read_tr16_b64_v4i16((LAS s16x4*)(vp + 32 * mm)));
                vhi[mm] = __builtin_bit_cast(s16x4, __builtin_amdgcn_ds_read_tr16_b64_v4i16((LAS s16x4*)(vp + 16 * AT_VPITCH + 32 * mm))); }
            f32x4 s0 = {0.f, 0.f, 0.f, 0.f}, s1 = {0.f, 0.f, 0.f, 0.f};
            s0 = __builtin_amdgcn_mfma_f32_16x16x32_bf16(k00, qf0, s0, 0, 0, 0); s0 = __builtin_amdgcn_mfma_f32_16x16x32_bf16(k01, qf1, s0, 0, 0, 0);
            s1 = __builtin_amdgcn_mfma_f32_16x16x32_bf16(k10, qf0, s1, 0, 0, 0); s1 = __builtin_amdgcn_mfma_f32_16x16x32_bf16(k11, qf1, s1, 0, 0, 0);
            float sv[8]; float mx = -1e30f; float ps = 0.f; float pv[8];
            const bool need_mask = !(ks >= 16 * wave + 15 && ks + 31 <= 16 * wave + 128) || (n == 0 && ks < 128);
            if (need_mask) { const int d0 = ks + 4 * kq - qi, kmin = (n == 0) ? 128 : 0, kb0 = ks + 4 * kq;
#pragma unroll
                for (int i = 0; i < 8; ++i) { const int c = (i >> 2) * 16 + (i & 3); const bool ok = ((unsigned)(d0 + c) <= 128u) && (kb0 + c >= kmin);
                    const float sraw = (i < 4) ? s0[i & 3] : s1[i & 3]; sv[i] = ok ? sraw : -1e30f; mx = fmaxf(mx, sv[i]); }
            } else {
#pragma unroll
                for (int i = 0; i < 8; ++i) { sv[i] = (i < 4) ? s0[i & 3] : s1[i & 3]; mx = fmaxf(mx, sv[i]); }
            }
            mx = fmaxf(mx, __shfl_xor(mx, 16)); mx = fmaxf(mx, __shfl_xor(mx, 32));
            const float mn = fmaxf(mrun, mx); const float alpha = fast_exp2(mrun - mn);
#pragma unroll
            for (int i = 0; i < 8; ++i) { pv[i] = (sv[i] > -1e29f) ? fast_exp2(sv[i] - mn) : 0.f; ps += pv[i]; }
            lrun = lrun * alpha + ps; mrun = mn;
            u32x4 pw; pw.x = pk2(pv[0], pv[1]); pw.y = pk2(pv[2], pv[3]); pw.z = pk2(pv[4], pv[5]); pw.w = pk2(pv[6], pv[7]);
            const bf16x8 pf = __builtin_bit_cast(bf16x8, pw);
#pragma unroll
            for (int mm = 0; mm < 4; ++mm) { bf16x8 vf; vf[0] = vlo[mm][0]; vf[1] = vlo[mm][1]; vf[2] = vlo[mm][2]; vf[3] = vlo[mm][3]; vf[4] = vhi[mm][0]; vf[5] = vhi[mm][1]; vf[6] = vhi[mm][2]; vf[7] = vhi[mm][3];
                o[mm] = o[mm] * alpha;
                o[mm] = __builtin_amdgcn_mfma_f32_16x16x32_bf16(vf, pf, o[mm], 0, 0, 0); }
        }
        lrun += __shfl_xor(lrun, 16); lrun += __shfl_xor(lrun, 32);
        const float inv = 1.f / lrun; const int tokq = (n * 128 + qi) * dil + rho; const size_t row = (size_t)b * SEQ + tokq;
        bf16_t* orow = POp + ((size_t)br * MTOK + row) * 512 + h * 64 + 4 * kq;
#pragma unroll
        for (int mm = 0; mm < 4; ++mm) { u32x2 w; w.x = pk2(o[mm][0] * inv, o[mm][1] * inv); w.y = pk2(o[mm][2] * inv, o[mm][3] * inv); *(u32x2*)(orow + 16 * mm) = w; }
        if (kq == 0) { PMp[((size_t)br * MTOK + row) * 8 + h] = mrun; PLp[((size_t)br * MTOK + row) * 8 + h] = lrun; }
        if (un < 0) break;
        u = un; ++ui;
    }
}

constexpr int S5_BUSP = 132, S5_HSP = 136;
constexpr int S5_WAVE_BYTES = 16 * S5_BUSP * 4 + 16 * S5_HSP * 2;
__device__ __forceinline__ void s5_unit(const bf16_t* Zp, const unsigned char* tab, const float* dskip, bf16_t* Y5p, LAS unsigned char* lds, int unit, int wave, int lane) {
    const int b = unit >> 2, g = (unit & 3) * 8 + wave;
    LAS float* bus = (LAS float*)(lds + wave * S5_WAVE_BYTES);
    LAS bf16_t* hs = (LAS bf16_t*)(lds + wave * S5_WAVE_BYTES + 16 * S5_BUSP * 4);
    const int n = lane & 15, kg = lane >> 4;
    const bf16_t* BMt = (const bf16_t*)(tab + S5_BM); const bf16_t* CMt = (const bf16_t*)(tab + S5_CM); const float* AB = (const float*)(tab + S5_ABAR);
    bf16x8 bm[8], cm[4];
#pragma unroll
    for (int nt = 0; nt < 8; ++nt) bm[nt] = *(const bf16x8*)(BMt + ((size_t)(g * 128 + 16 * nt + n)) * 32 + 8 * kg);
#pragma unroll
    for (int kk = 0; kk < 4; ++kk) cm[kk] = *(const bf16x8*)(CMt + ((size_t)(g * 16 + n)) * 128 + 32 * kk + 8 * kg);
    const float dsk = dskip[g * 16 + n];
    const float ar = AB[(g * 64 + lane) * 2], ai = AB[(g * 64 + lane) * 2 + 1];
    float hr = 0.f, hi = 0.f;
    const bf16_t* ub = Zp + (size_t)b * SEQ * 2048 + 1536 + g * 16;
    bf16_t* yb = Y5p + (size_t)b * SEQ * 512 + g * 16 + n;
    bf16x8 ufn = {0, 0, 0, 0, 0, 0, 0, 0};
    if (kg < 2) ufn = *(const bf16x8*)(ub + (size_t)n * 2048 + 8 * kg);
    for (int t0 = 0; t0 < SEQ; t0 += 16) {
        const bf16x8 uf = ufn;
        if (kg < 2 && t0 + 16 < SEQ) ufn = *(const bf16x8*)(ub + (size_t)(t0 + 16 + n) * 2048 + 8 * kg);
        unsigned short us[4];
#pragma unroll
        for (int i = 0; i < 4; ++i) us[i] = ub[(size_t)(t0 + 4 * kg + i) * 2048 + n];
#pragma unroll
        for (int nt = 0; nt < 8; ++nt) { f32x4 d = {0.f, 0.f, 0.f, 0.f}; d = __builtin_amdgcn_mfma_f32_16x16x32_bf16(bm[nt], uf, d, 0, 0, 0);
            *(LAS f32x4*)(bus + n * S5_BUSP + 16 * nt + 4 * kg) = d; }
        LDS_WAIT();
#pragma unroll
        for (int t = 0; t < 16; ++t) { const float bre = bus[t * S5_BUSP + 2 * lane], bim = bus[t * S5_BUSP + 2 * lane + 1];
            const float nr = ar * hr - ai * hi + bre, ni = ar * hi + ai * hr + bim; hr = nr; hi = ni;
            *(LAS unsigned*)(hs + t * S5_HSP + 2 * lane) = pk2(hr, hi); }
        LDS_WAIT();
        f32x4 y = {0.f, 0.f, 0.f, 0.f};
#pragma unroll
        for (int kk = 0; kk < 4; ++kk) { const bf16x8 hf = *(const LAS bf16x8*)(hs + n * S5_HSP + 32 * kk + 8 * kg); y = __builtin_amdgcn_mfma_f32_16x16x32_bf16(hf, cm[kk], y, 0, 0, 0); }
#pragma unroll
        for (int i = 0; i < 4; ++i) { const int t = t0 + 4 * kg + i; const float v = gelu_tanh(y[i] + dsk * bf2f(us[i])); yb[(size_t)t * 512] = (bf16_t)f2bf(v); }
        LDS_WAIT();
    }
}

#define XB_TMO      128
#define XB_XCNT(j)  (256  + 64 * (j))
#define XB_XSUB(j)  (1280 + 64 * (j))
#define XB_XGEN(j)  (2304 + 64 * (j))
#define XB_TOP      3328
#define XB_TOPGEN   3392
#define XCD_BAR_WORDS 3456
#define XB_SPIN_CAP (1u << 22)
__device__ __forceinline__ unsigned xb_ld(unsigned* p)              { return __hip_atomic_load(p, __ATOMIC_RELAXED, __HIP_MEMORY_SCOPE_AGENT); }
__device__ __forceinline__ unsigned xb_add(unsigned* p, unsigned v) { return __hip_atomic_fetch_add(p, v, __ATOMIC_RELAXED, __HIP_MEMORY_SCOPE_AGENT); }
__device__ __forceinline__ unsigned xb_xcc_id() { return (unsigned)__builtin_amdgcn_s_getreg((3 << 11) | 20) & 0xFu; }
#define XB_SPIN(cond, bar) do { unsigned _sp = 0; while (cond) { __builtin_amdgcn_s_sleep(1); \
    if ((++_sp & 255u) == 0u) { if (xb_ld(&(bar)[XB_TMO])) break; if (_sp > XB_SPIN_CAP) { atomicAdd(&(bar)[XB_TMO], 1u); break; } } } } while (0)
__device__ __forceinline__ void xcd_barrier_complete(unsigned* bar, unsigned x, unsigned& nloc, unsigned& nx) {
    const unsigned G = gridDim.x * gridDim.y * gridDim.z;
    unsigned sum, cnt, mine, sp = 0u;
    for (;;) {
        sum = 0u; cnt = 0u; mine = 0u;
#pragma unroll
        for (unsigned j = 0; j < 16; ++j) { const unsigned c = xb_ld(&bar[XB_XCNT(j)]); sum += c; cnt += (c > 0u) ? 1u : 0u; mine = (j == x) ? c : mine; }
        if (sum == G) break;
        __builtin_amdgcn_s_sleep(1);
        if ((++sp & 255u) == 0u) { if (xb_ld(&bar[XB_TMO])) break; if (sp > XB_SPIN_CAP) { atomicAdd(&bar[XB_TMO], 1u); break; } }
    }
    nloc = mine > 0u ? mine : 1u; nx = cnt > 0u ? cnt : 1u;
}
__device__ __forceinline__ void xcd_barrier(unsigned* bar, volatile LAS unsigned* st) {
    asm volatile("s_waitcnt vmcnt(0)" ::: "memory");
    __syncthreads();
    if (threadIdx.x == 0) {
        const unsigned x = xb_xcc_id();
        __builtin_amdgcn_s_waitcnt(0);
        unsigned nloc = st[0], nx = st[1];
        if (nloc == 0u) { xcd_barrier_complete(bar, x, nloc, nx); st[0] = nloc; st[1] = nx; }
        const unsigned old = xb_add(&bar[XB_XSUB(x)], 1u);
        const unsigned gen = old / nloc;
        if (old + 1u == (gen + 1u) * nloc) {
            __builtin_amdgcn_fence(__ATOMIC_RELEASE, "agent");
            asm volatile("s_waitcnt vmcnt(0)" ::: "memory");
            const unsigned og = xb_add(&bar[XB_TOP], 1u);
            const unsigned tg = og / nx;
            if (og + 1u == (tg + 1u) * nx) xb_add(&bar[XB_TOPGEN], 1u);
            else XB_SPIN(xb_ld(&bar[XB_TOPGEN]) == tg, bar);
            __builtin_amdgcn_fence(__ATOMIC_ACQUIRE, "agent");
            xb_add(&bar[XB_XGEN(x)], 1u);
            asm volatile("s_waitcnt vmcnt(0)" ::: "memory");
        } else {
            XB_SPIN(xb_ld(&bar[XB_XGEN(x)]) == gen, bar);
            __builtin_amdgcn_fence(__ATOMIC_ACQUIRE, "agent");
            asm volatile("s_waitcnt vmcnt(0)" ::: "memory");
        }
    }
    __syncthreads();
}
constexpr int LDS_MISC = 135 * 1024;
constexpr size_t CTL_BYTES = 16384;

typedef const __attribute__((address_space(4))) Args* ArgsP;
__global__ void __launch_bounds__(NTHREADS, 2) mega(Args a_kern) {
    extern __shared__ __attribute__((aligned(16))) unsigned char lds_raw[];
    LAS unsigned char* lds = (LAS unsigned char*)lds_raw;
    cg::grid_group grid = cg::this_grid();
    ArgsP ap = (ArgsP)__builtin_amdgcn_kernarg_segment_ptr();
#define a (*ap)
#define ws (a.ws)
    int tid, lane, wave, gw, gt;
    const int G = gridDim.x, bx = blockIdx.x;
    const int NGW = G * NWAVES, NGT = G * NTHREADS;
#define RELOAD() do { asm volatile("" : "+s"(ap)); tid = threadIdx.x; asm volatile("" : "+v"(tid)); lane = tid & 63; wave = __builtin_amdgcn_readfirstlane(tid >> 6); gw = bx * NWAVES + wave; gt = bx * NTHREADS + tid; } while (0)
    RELOAD();
    volatile LAS unsigned* bst = (volatile LAS unsigned*)(lds + LDS_MISC);
    if (tid == 0) { bst[0] = 0u; bst[1] = 0u; (void)xb_add((unsigned*)(ws + WS_CTL) + XB_XCNT(xb_xcc_id()), 1u); }
    __syncthreads();
#define x_in (a.in[0])
#define positions ((const int*)a.in[1])
#define g_mix_pre (a.in[2])
#define g_mix_post (a.in[3])
#define g_ffn_pre (a.in[4])
#define g_ffn_post (a.in[5])
#define HN ((bf16_t*)(ws + WS_HN))
#define Z ((bf16_t*)(ws + WS_Z))
#define YC ((bf16_t*)(ws + WS_YC))
#define MIX ((bf16_t*)(ws + WS_MIX))
#define PO ((bf16_t*)(ws + WS_PO))
#define PM ((float*)(ws + WS_PM))
#define PL ((float*)(ws + WS_PL))
#define Y5 ((bf16_t*)(ws + WS_Y5))
#define HID ((bf16_t*)(ws + WS_HID))
#define XC ((bf16_t*)(ws + WS_XC))
#define BB ((bf16_t*)(ws + WS_BB))
#define Y1 ((bf16_t*)(ws + WS_Y1))
#define LA ((bf16_t*)(ws + WS_LA))
#define ROPE ((float*)(ws + WS_ROPE))
#define S5T (ws + WS_S5TAB)
#define SP ((float*)(ws + WS_S5TAB + S5_SP))
#define X (a.out)
#ifndef PHMASK
#define PHMASK 0xFFFFFFFFu
#endif
#define IN(k) (((PHMASK >> (k)) & 1u) && a.ph_lo <= (k) && (k) < a.ph_hi)
#ifndef REPMASK
#define REPMASK 0x0u
#endif
#define REPS(k) (1 + (int)((REPMASK >> (k)) & 1u))
#define REPSYNC do { if (rep) grid.sync(); } while (0)
#define SEAM(k) do { if (IN(k) && IN((k) + 1)) { if ((k) == 0) grid.sync(); else xcd_barrier((unsigned*)(ws + WS_CTL), bst); } RELOAD(); } while (0)

    if (IN(0)) _Pragma("unroll") for (int rep = 0; rep < REPS(0); ++rep) {
        LAS float* scr = (LAS float*)(lds + wave * 8448);
        constexpr int I_IN = 16 * 64, I_OUT = 16 * 32, I_GLU = 8 * 16, I_GATE = 4 * 64, I_UP = 16 * 176, I_DN = 44 * 32;
        constexpr int NITEMS = 2 * I_IN + 2 * I_OUT + I_GLU + I_GATE + 2 * I_UP + 2 * I_DN;
        for (int it = gw; it < NITEMS; it += NGW) {
            int r = it;
            if (r < I_IN) { const int kb = r / 64, nb = r % 64; transpose_item(a.in[6] + nb * 32, 2048, 1024, (bf16_t*)(ws + WS_W_IN0) + (size_t)nb * 32 * 1024, kb * 64, scr, lane); continue; } r -= I_IN;
            if (r < I_IN) { const int kb = r / 64, nb = r % 64; transpose_item(a.in[17] + nb * 32, 2048, 1024, (bf16_t*)(ws + WS_W_IN1) + (size_t)nb * 32 * 1024, kb * 64, scr, lane); continue; } r -= I_IN;
            if (r < I_OUT) { const int kb = r / 32, nb = r % 32; transpose_item(a.in[7] + nb * 32, 1024, 1024, (bf16_t*)(ws + WS_W_OUT0) + (size_t)nb * 32 * 1024, kb * 64, scr, lane); continue; } r -= I_OUT;
            if (r < I_OUT) { const int kb = r / 32, nb = r % 32; transpose_item(a.in[18] + nb * 32, 1024, 1024, (bf16_t*)(ws + WS_W_OUT1) + (size_t)nb * 32 * 1024, kb * 64, scr, lane); continue; } r -= I_OUT;
            if (r < I_GLU) { const int kb = r / 16, nb = r % 16; transpose_item(a.in[16] + nb * 32, 512, 512, (bf16_t*)(ws + WS_W_GLU) + (size_t)nb * 32 * 512, kb * 64, scr, lane); continue; } r -= I_GLU;
            if (r < I_GATE) { const int kb = r / 64, nb = r % 64; const int n0 = nb * 32, pn = n0 >> 8, half = (n0 >> 7) & 1, j = n0 & 127, hh = pn >> 1, colg = (pn & 1) * 128 + j;
                const float* src = (half ? a.in[23] : a.in[21]) + (size_t)hh * 256 * 256 + colg;
                transpose_item(src, 256, 256, (bf16_t*)(ws + WS_W_GATE) + (size_t)n0 * 256, kb * 64, scr, lane); continue; } r -= I_GATE;
            if (r < 2 * I_UP) { const int layer = r / I_UP; r -= layer * I_UP; const int kb = r / 176, nb = r % 176; const int n0 = nb * 32, t = n0 >> 8, half = (n0 >> 7) & 1, j = n0 & 127;
                const float* src = (half ? a.in[27] : a.in[26]) + (size_t)layer * 1024 * FFH + t * 128 + j;
                transpose_item(src, FFH, 1024, (bf16_t*)(ws + (layer ? WS_W_UP1 : WS_W_UP0)) + (size_t)n0 * 1024, kb * 64, scr, lane); continue; } r -= 2 * I_UP;
            { const int layer = r / I_DN; r -= layer * I_DN; const int kb = r / 32, nb = r % 32;
                transpose_item(a.in[28] + (size_t)layer * FFH * 1024 + nb * 32, 1024, FFH, (bf16_t*)(ws + (layer ? WS_W_DN1 : WS_W_DN0)) + (size_t)nb * 32 * FFH, kb * 64, scr, lane); }
        }
        for (int idx = gt; idx < MTOK * 8; idx += NGT) { const int tok = idx >> 3, j = idx & 7; const float inv_freq = powf(500000.0f, -(float)j * 0.125f);
            const float ang = (float)positions[tok] * inv_freq; float s, c; sincos_rr(ang, s, c); ROPE[(size_t)tok * 16 + j] = c; ROPE[(size_t)tok * 16 + 8 + j] = s; }
        for (int idx = gt; idx < 32 * 64; idx += NGT) { const int g = idx >> 6, p = idx & 63;
            const float are = a.in[8][idx], aim = a.in[9][idx], dt = expf(a.in[10][g]);
            const float xr = are * dt, yi = aim * dt; const float ex = expf(xr); float sn, cs; sincos_rr(yi, sn, cs);
            const float abr = ex * cs, abi = ex * sn;
            float sh, ch; sincos_rr(0.5f * yi, sh, ch); (void)ch;
            const float nre = expm1f(xr) * cs - 2.f * sh * sh, nim = abi;
            const float den = 1.f / (are * are + aim * aim);
            const float cre = (nre * are + nim * aim) * den, cim = (nim * are - nre * aim) * den;
            float* AB = (float*)(S5T + S5_ABAR); AB[idx * 2] = abr; AB[idx * 2 + 1] = abi;
            bf16_t* BMt = (bf16_t*)(S5T + S5_BM); bf16_t* CMt = (bf16_t*)(S5T + S5_CM);
            for (int c = 0; c < 16; ++c) { const float bre = a.in[11][(size_t)idx * 16 + c], bim = a.in[12][(size_t)idx * 16 + c];
                BMt[((size_t)g * 128 + 2 * p) * 32 + c] = (bf16_t)f2bf(cre * bre - cim * bim); BMt[((size_t)g * 128 + 2 * p + 1) * 32 + c] = (bf16_t)f2bf(cre * bim + cim * bre);
                BMt[((size_t)g * 128 + 2 * p) * 32 + 16 + c] = 0; BMt[((size_t)g * 128 + 2 * p + 1) * 32 + 16 + c] = 0;
                CMt[((size_t)g * 16 + c) * 128 + 2 * p] = (bf16_t)f2bf(a.in[13][((size_t)g * 16 + c) * 64 + p]); CMt[((size_t)g * 16 + c) * 128 + 2 * p + 1] = (bf16_t)f2bf(-a.in[14][((size_t)g * 16 + c) * 64 + p]); } }
        for (int idx = gt; idx < 1024; idx += NGT) SP[idx] = log1pf(expf(-a.in[25][idx]));
        for (int m = gw; m < MTOK; m += NGW) rms_row_to_bf16(x_in + (size_t)m * DM, g_mix_pre, HN + (size_t)m * DM, lane);
    }
    SEAM(0);
    if (IN(1)) _Pragma("unroll") for (int rep = 0; rep < REPS(1); ++rep) { pg8::Gemm g{HN, (const bf16_t*)(ws + WS_W_IN0), MTOK, 2048, 1024, 1024, 0}; pg8::StaticOrder S; S.init(MTOK, 2048, G, bx);
        pg8::EpiRope E{Z, ROPE}; pg8::gemm_phase(lds, g, S, E); }
    SEAM(1);
    if (IN(2)) _Pragma("unroll") for (int rep = 0; rep < REPS(2); ++rep) {
        if (bx < 128) s5_unit(Z, S5T, a.in[15], Y5, lds, bx, wave, lane);
        attn_phase(Z, PO, PM, PL, lds, bx, G, tid, wave, lane);
    }
    SEAM(2);
    if (IN(3)) _Pragma("unroll") for (int rep = 0; rep < REPS(3); ++rep) {
        for (int idx = gt; idx < MTOK * 64; idx += NGT) { const int row = idx >> 6, c8 = idx & 63, h = c8 >> 3;
            float mv[3], lv[3]; u32x4 ow[3];
#pragma unroll
            for (int i = 0; i < 3; ++i) { mv[i] = PM[((size_t)i * MTOK + row) * 8 + h]; lv[i] = PL[((size_t)i * MTOK + row) * 8 + h]; ow[i] = *(const u32x4*)(PO + ((size_t)i * MTOK + row) * 512 + c8 * 8); }
            const float mx = fmaxf(mv[0], fmaxf(mv[1], mv[2]));
            float w[3]; float den = 0.f;
#pragma unroll
            for (int i = 0; i < 3; ++i) { w[i] = fast_exp2(mv[i] - mx) * lv[i]; den += w[i]; }
            const float inv = 1.f / den; f32x4 v0 = {0.f, 0.f, 0.f, 0.f}, v1 = v0;
#pragma unroll
            for (int i = 0; i < 3; ++i) { const float ww = w[i] * inv;
                v0[0] += ww * bflo(ow[i].x); v0[1] += ww * bfhi(ow[i].x); v0[2] += ww * bflo(ow[i].y); v0[3] += ww * bfhi(ow[i].y);
                v1[0] += ww * bflo(ow[i].z); v1[1] += ww * bfhi(ow[i].z); v1[2] += ww * bflo(ow[i].w); v1[3] += ww * bfhi(ow[i].w); }
            pg8::st8(YC + (size_t)row * 1024 + c8 * 8, v0, v1); }
        __syncthreads();
        pg8::Gemm g{Y5, (const bf16_t*)(ws + WS_W_GLU), MTOK, 512, 512, 512, 0}; pg8::StaticOrder S; S.init(MTOK, 512, G, bx);
        pg8::EpiGlu E{Y5, YC}; pg8::gemm_phase(lds, g, S, E);
    }
    SEAM(3);
    if (IN(4)) _Pragma("unroll") for (int rep = 0; rep < REPS(4); ++rep) { pg8::Gemm g{YC, (const bf16_t*)(ws + WS_W_OUT0), MTOK, 1024, 1024, 1024, 0}; pg8::StaticOrder S; S.init(MTOK, 1024, G, bx);
        pg8::EpiPlain E{MIX, 1024}; pg8::gemm_phase(lds, g, S, E); }
    SEAM(4);
    if (IN(5)) _Pragma("unroll") for (int rep = 0; rep < REPS(5); ++rep) for (int m = gw; m < MTOK; m += NGW) resnorm_row(x_in + (size_t)m * DM, MIX + (size_t)m * DM, g_mix_post, X + (size_t)m * DM, g_ffn_pre, HN + (size_t)m * DM, lane);
    SEAM(5);
    if (IN(6)) _Pragma("unroll") for (int rep = 0; rep < REPS(6); ++rep) { pg8::Gemm g{HN, (const bf16_t*)(ws + WS_W_UP0), MTOK, 2 * FFH, 1024, 1024, 0}; pg8::StaticOrder S; S.init(MTOK, 2 * FFH, G, bx);
        pg8::EpiSwiGlu E{HID}; pg8::gemm_phase(lds, g, S, E); }
    SEAM(6);
    if (IN(7)) _Pragma("unroll") for (int rep = 0; rep < REPS(7); ++rep) { pg8::Gemm g{HID, (const bf16_t*)(ws + WS_W_DN0), MTOK, 1024, FFH, FFH, 0}; pg8::StaticOrder S; S.init(MTOK, 1024, G, bx);
        pg8::EpiPlain E{MIX, 1024}; pg8::gemm_phase(lds, g, S, E); }
    SEAM(7);
    if (IN(8)) _Pragma("unroll") for (int rep = 0; rep < REPS(8); ++rep) for (int m = gw; m < MTOK; m += NGW) resnorm_row(X + (size_t)m * DM, MIX + (size_t)m * DM, g_ffn_post, X + (size_t)m * DM, g_mix_pre + DM, HN + (size_t)m * DM, lane);
    SEAM(8);
    if (IN(9)) _Pragma("unroll") for (int rep = 0; rep < REPS(9); ++rep) { pg8::Gemm g{HN, (const bf16_t*)(ws + WS_W_IN1), MTOK, 2048, 1024, 1024, 0}; pg8::StaticOrder S; S.init(MTOK, 2048, G, bx);
        pg8::EpiIn1 E{Z}; pg8::gemm_phase(lds, g, S, E); }
    SEAM(9);
    if (IN(10)) _Pragma("unroll") for (int rep = 0; rep < REPS(10); ++rep) {
        const float* cw = a.in[19]; const float* cb = a.in[20];
        for (int idx = gt; idx < (MTOK / 8) * 128; idx += NGT) { const int c8 = idx & 127, tb = idx >> 7, row0 = tb * 8, c0 = c8 * 8; const int t0 = row0 & (SEQ - 1);
            float w[4][8], bias[8];
#pragma unroll
            for (int k = 0; k < 4; ++k) { const f32x4 wa = *(const f32x4*)(cw + k * 1024 + c0), wb = *(const f32x4*)(cw + k * 1024 + c0 + 4);
                w[k][0] = wa.x; w[k][1] = wa.y; w[k][2] = wa.z; w[k][3] = wa.w; w[k][4] = wb.x; w[k][5] = wb.y; w[k][6] = wb.z; w[k][7] = wb.w; }
            { const f32x4 ba = *(const f32x4*)(cb + c0), bb = *(const f32x4*)(cb + c0 + 4); bias[0] = ba.x; bias[1] = ba.y; bias[2] = ba.z; bias[3] = ba.w; bias[4] = bb.x; bias[5] = bb.y; bias[6] = bb.z; bias[7] = bb.w; }
            float xm[3][8];
#pragma unroll
            for (int k = 0; k < 3; ++k) { u32x4 v = {0u, 0u, 0u, 0u}; if (t0 - 3 + k >= 0) v = *(const u32x4*)(Z + (size_t)(row0 - 3 + k) * 2048 + c0);
                xm[k][0] = bflo(v.x); xm[k][1] = bfhi(v.x); xm[k][2] = bflo(v.y); xm[k][3] = bfhi(v.y); xm[k][4] = bflo(v.z); xm[k][5] = bfhi(v.z); xm[k][6] = bflo(v.w); xm[k][7] = bfhi(v.w); }
#pragma unroll
            for (int r = 0; r < 8; ++r) { const u32x4 v = *(const u32x4*)(Z + (size_t)(row0 + r) * 2048 + c0);
                const float xc[8] = {bflo(v.x), bfhi(v.x), bflo(v.y), bfhi(v.y), bflo(v.z), bfhi(v.z), bflo(v.w), bfhi(v.w)};
                f32x4 o0, o1;
#pragma unroll
                for (int i = 0; i < 8; ++i) { const float o = bias[i] + w[0][i] * xm[0][i] + w[1][i] * xm[1][i] + w[2][i] * xm[2][i] + w[3][i] * xc[i];
                    if (i < 4) o0[i] = o; else o1[i - 4] = o; xm[0][i] = xm[1][i]; xm[1][i] = xm[2][i]; xm[2][i] = xc[i]; }
                pg8::st8(XC + (size_t)(row0 + r) * 1024 + c0, o0, o1); } }
    }
    SEAM(10);
    if (IN(11)) _Pragma("unroll") for (int rep = 0; rep < REPS(11); ++rep) { pg8::Gemm g{XC, (const bf16_t*)(ws + WS_W_GATE), MTOK, 2048, 256, 1024, 1}; pg8::StaticOrder S; S.init(MTOK, 2048, G, bx);
        pg8::EpiGates E{XC, LA, BB, a.in[22], a.in[24], SP}; pg8::gemm_phase(lds, g, S, E); }
    SEAM(11);
    if (IN(12)) _Pragma("unroll") for (int rep = 0; rep < REPS(12); ++rep) {
        LAS float* car = (LAS float*)lds;
        for (int u = bx; u < 256; u += G) { const int b = u >> 3, c0 = (u & 7) * 128 + 2 * lane; const size_t rbase = (size_t)b * SEQ + wave * 256;
            const bf16_t* la = LA + rbase * 1024 + c0; const bf16_t* bb = BB + rbase * 1024 + c0;
            float h0 = 0.f, h1 = 0.f, s0 = 0.f, s1 = 0.f;
#pragma unroll 8
            for (int t = 0; t < 256; ++t) { const unsigned lw = *(const unsigned*)(la + (size_t)t * 1024), bw = *(const unsigned*)(bb + (size_t)t * 1024);
                const float l0 = bflo(lw), l1 = bfhi(lw); s0 += l0; s1 += l1;
                h0 = fast_exp2(l0 * LOG2E) * h0 + bflo(bw); h1 = fast_exp2(l1 * LOG2E) * h1 + bfhi(bw); }
            __syncthreads();
            car[(wave * 64 + lane) * 4 + 0] = fast_exp2(s0 * LOG2E); car[(wave * 64 + lane) * 4 + 1] = fast_exp2(s1 * LOG2E); car[(wave * 64 + lane) * 4 + 2] = h0; car[(wave * 64 + lane) * 4 + 3] = h1;
            __syncthreads();
            h0 = 0.f; h1 = 0.f;
            for (int j = 0; j < wave; ++j) { const f32x4 cv = *(const LAS f32x4*)(car + (j * 64 + lane) * 4); h0 = cv.x * h0 + cv.z; h1 = cv.y * h1 + cv.w; }
            const bf16_t* gb = Z + rbase * 2048 + 1024 + c0; bf16_t* yo = Y1 + rbase * 1024 + c0;
#pragma unroll 8
            for (int t = 0; t < 256; ++t) { const unsigned lw = *(const unsigned*)(la + (size_t)t * 1024), bw = *(const unsigned*)(bb + (size_t)t * 1024), gwv = *(const unsigned*)(gb + (size_t)t * 2048);
                h0 = fast_exp2(bflo(lw) * LOG2E) * h0 + bflo(bw); h1 = fast_exp2(bfhi(lw) * LOG2E) * h1 + bfhi(bw);
                *(unsigned*)(yo + (size_t)t * 1024) = pk2(h0 * bflo(gwv), h1 * bfhi(gwv)); }
        }
    }
    SEAM(12);
    if (IN(13)) _Pragma("unroll") for (int rep = 0; rep < REPS(13); ++rep) { pg8::Gemm g{Y1, (const bf16_t*)(ws + WS_W_OUT1), MTOK, 1024, 1024, 1024, 0}; pg8::StaticOrder S; S.init(MTOK, 1024, G, bx);
        pg8::EpiPlain E{MIX, 1024}; pg8::gemm_phase(lds, g, S, E); }
    SEAM(13);
    if (IN(14)) _Pragma("unroll") for (int rep = 0; rep < REPS(14); ++rep) for (int m = gw; m < MTOK; m += NGW) resnorm_row(X + (size_t)m * DM, MIX + (size_t)m * DM, g_mix_post + DM, X + (size_t)m * DM, g_ffn_pre + DM, HN + (size_t)m * DM, lane);
    SEAM(14);
    if (IN(15)) _Pragma("unroll") for (int rep = 0; rep < REPS(15); ++rep) { pg8::Gemm g{HN, (const bf16_t*)(ws + WS_W_UP1), MTOK, 2 * FFH, 1024, 1024, 0}; pg8::StaticOrder S; S.init(MTOK, 2 * FFH, G, bx);
        pg8::EpiSwiGlu E{HID}; pg8::gemm_phase(lds, g, S, E); }
    SEAM(15);
    if (IN(16)) _Pragma("unroll") for (int rep = 0; rep < REPS(16); ++rep) { pg8::Gemm g{HID, (const bf16_t*)(ws + WS_W_DN1), MTOK, 1024, FFH, FFH, 0}; pg8::StaticOrder S; S.init(MTOK, 1024, G, bx);
        pg8::EpiPlain E{MIX, 1024}; pg8::gemm_phase(lds, g, S, E); }
    SEAM(16);
    if (IN(17)) _Pragma("unroll") for (int rep = 0; rep < REPS(17); ++rep) for (int m = gw; m < MTOK; m += NGW) resnorm_row(X + (size_t)m * DM, MIX + (size_t)m * DM, g_ffn_post + DM, X + (size_t)m * DM, nullptr, nullptr, lane);
#undef IN
#undef SEAM
#undef a
#undef ws
}
constexpr int NPHASES = 18;

extern "C" void kernel_launch(void* const* d_in, const int* in_sizes, int n_in, void* d_out, int out_size, void* d_ws, size_t ws_size, hipStream_t stream) {
    static int grid = 0;
    if (grid == 0) {
        if (n_in != 29 || in_sizes[0] != MTOK * DM || out_size != MTOK * DM || ws_size < WS_END) {
            fprintf(stderr, "kernel_launch: unexpected shapes: n_in %d in0 %d out %d ws %zu (need %zu)\n", n_in, n_in > 0 ? in_sizes[0] : -1, out_size, ws_size, (size_t)WS_END); grid = -1; return; }
        int dev = 0, cus = 0, per_cu = 0;
        hipGetDevice(&dev); hipDeviceGetAttribute(&cus, hipDeviceAttributeMultiprocessorCount, dev);
        if (hipFuncSetAttribute((const void*)mega, hipFuncAttributeMaxDynamicSharedMemorySize, LDS_BYTES) != hipSuccess) { fprintf(stderr, "kernel_launch: hipFuncSetAttribute failed\n"); grid = -1; return; }
        if (hipOccupancyMaxActiveBlocksPerMultiprocessor(&per_cu, (const void*)mega, NTHREADS, LDS_BYTES) != hipSuccess || per_cu < 1) { fprintf(stderr, "kernel_launch: occupancy query says %d\n", per_cu); per_cu = 1; }
        (void)hipGetLastError();
        grid = cus;
    }
    if (grid < 0) return;
    if (hipMemsetAsync((char*)d_ws + WS_CTL, 0, CTL_BYTES, stream) != hipSuccess) { fprintf(stderr, "kernel_launch: memset failed\n"); return; }
    Args a{};
    for (int i = 0; i < 29; ++i) a.in[i] = (const float*)d_in[i];
    a.out = (float*)d_out; a.ws = (unsigned char*)d_ws;
#if N_LAUNCH_MODE == 1
    a.ph_lo = 0; a.ph_hi = NPHASES;
    void* args[] = {&a};
    hipError_t e = hipLaunchCooperativeKernel((const void*)mega, dim3(grid), dim3(NTHREADS), args, LDS_BYTES, stream);
    if (e != hipSuccess) fprintf(stderr, "cooperative launch failed: %s (grid %d)\n", hipGetErrorString(e), grid);
#else
    for (int ph = 0; ph < NPHASES; ++ph) { a.ph_lo = ph; a.ph_hi = ph + 1; hipLaunchKernelGGL(mega, dim3(grid), dim3(NTHREADS), LDS_BYTES, stream, a); }
#endif
}
```

```cpp
#include <hip/hip_runtime.h>
#include <hip/hip_cooperative_groups.h>
#include <cstdio>
#include <cstdint>
namespace cg = cooperative_groups;

#ifndef N_LAUNCH_MODE
#define N_LAUNCH_MODE 1
#endif

#define LAS __attribute__((address_space(3)))
typedef unsigned short bf16_t;
typedef short bf16x8 __attribute__((ext_vector_type(8)));
typedef float f32x4 __attribute__((ext_vector_type(4)));
typedef unsigned u32x4 __attribute__((ext_vector_type(4)));
typedef unsigned u32x2 __attribute__((ext_vector_type(2)));

constexpr int MTOK = 65536, DM = 1024, SEQ = 2048, NBATCH = 32, FFH = 2816;
constexpr float NORM_EPS = 1e-6f;
constexpr float LOG2E = 1.4426950408889634f;
constexpr int NWAVES = 8, NTHREADS = 512;
constexpr int LDS_BYTES = 136 * 1024;

constexpr size_t MiB = 1u << 20;
constexpr size_t WS_CTL = 0;
constexpr size_t WS_W_IN0 = 1 * MiB, WS_W_OUT0 = 5 * MiB, WS_W_GLU = 7 * MiB, WS_W_IN1 = 8 * MiB, WS_W_OUT1 = 12 * MiB, WS_W_GATE = 14 * MiB;
constexpr size_t WS_W_UP0 = 15 * MiB, WS_W_UP1 = 26 * MiB, WS_W_DN0 = 37 * MiB, WS_W_DN1 = 43 * MiB;
constexpr size_t WS_ROPE = 49 * MiB;
constexpr size_t WS_S5TAB = 53 * MiB;
constexpr size_t S5_ABAR = 0, S5_BM = 16384, S5_CM = 16384 + 262144, S5_SP = 16384 + 262144 + 131072;
constexpr size_t WS_HN = 64 * MiB, WS_Z = 192 * MiB, WS_YC = 448 * MiB, WS_MIX = 576 * MiB, WS_PO = 704 * MiB, WS_PM = 896 * MiB, WS_PL = 902 * MiB, WS_Y5 = 908 * MiB;
constexpr size_t WS_HID = 192 * MiB;
constexpr size_t WS_XC = 448 * MiB, WS_BB = 576 * MiB, WS_Y1 = 704 * MiB, WS_LA = 832 * MiB;
constexpr size_t WS_END = 972 * MiB;

struct Args { const float* in[29]; float* out; unsigned char* ws; int ph_lo, ph_hi; };

__device__ __forceinline__ unsigned f2bf(float f) { unsigned u = __builtin_bit_cast(unsigned, f); return (u + 0x7fffu + ((u >> 16) & 1u)) >> 16; }
__device__ __forceinline__ unsigned pk2(float lo, float hi) { unsigned r; asm("v_cvt_pk_bf16_f32 %0, %1, %2" : "=v"(r) : "v"(lo), "v"(hi)); return r; }
__device__ __forceinline__ float bf2f(unsigned short h) { return __builtin_bit_cast(float, (unsigned)h << 16); }
__device__ __forceinline__ float bflo(unsigned w) { return __builtin_bit_cast(float, w << 16); }
__device__ __forceinline__ float bfhi(unsigned w) { return __builtin_bit_cast(float, w & 0xffff0000u); }
__device__ __forceinline__ float fast_exp2(float x) { return __builtin_amdgcn_exp2f(x); }
__device__ __forceinline__ float fast_rcp(float x) { return __builtin_amdgcn_rcpf(x); }
__device__ __forceinline__ float sigmoidf_(float x) { return fast_rcp(1.f + fast_exp2(-x * LOG2E)); }
__device__ __forceinline__ float gelu_tanh(float x) { const float u = 0.7978845608028654f * (x + 0.044715f * x * x * x); return x * sigmoidf_(2.f * u); }
__device__ __forceinline__ float wave_sum(float v) {
#pragma unroll
    for (int o = 1; o < 64; o <<= 1) v += __shfl_xor(v, o);
    return v;
}
#define LDS_WAIT() asm volatile("s_waitcnt lgkmcnt(0)" ::: "memory")

namespace pg8 {
constexpr int BM = 256, BK = 64, HALF = 128, HTB = HALF * BK * 2, STAGE_BYTES = 8 * HTB, NXCD = 8, WGM = 8;
__host__ __device__ __forceinline__ int lds_byte(int r, int c) { const int st = (r >> 4) * 2 + (c >> 5), rr = r & 15, cc = c & 31, ob = rr * 64 + cc * 2; return st * 1024 + (ob ^ (((ob >> 9) & 1) << 5)); }
__host__ __device__ __forceinline__ void stage_rc(int b, int& R, int& C) { const int st = b / 1024, sb = b % 1024, swz = sb ^ (((sb >> 9) & 1) << 5); R = (st >> 1) * 16 + swz / 64; C = (st & 1) * 32 + (swz % 64) / 2; }
__host__ __device__ __forceinline__ int perm32(int rho) { const int n = rho >> 4, i = rho & 15; return 8 * (i >> 2) + 4 * n + (i & 3); }
struct Unit { int pm, pn; };
struct Gemm { const bf16_t* A; const bf16_t* Bt; int M, N, K, lda, grp; };
struct StaticOrder {
    int nM, nN, nwg, G, c;
    __host__ __device__ void init(int M, int N, int G_, int c_) { nM = M / BM; nN = N / BM; nwg = nM * nN; G = G_; c = c_; }
    __host__ __device__ bool next(int i, Unit& u) const {
        const long L = (long)i * G + c; if (L >= nwg) return false;
        int wgid = (int)L; { const int q = nwg / NXCD, r = nwg % NXCD, xcd = wgid % NXCD, off = wgid / NXCD; wgid = (xcd < r ? xcd * (q + 1) : r * (q + 1) + (xcd - r) * q) + off; }
        const int nig = WGM * nN, gid = wgid / nig, fm = gid * WGM, gsz = (nM - fm) < WGM ? (nM - fm) : WGM;
        u.pm = fm + ((wgid % nig) % gsz); u.pn = (wgid % nig) / gsz; return true;
    }
};
template <class Epi>
__device__ __forceinline__ void gemm_phase(LAS unsigned char* lds, const Gemm g, const StaticOrder& S, const Epi& E) {
    int tid_ = threadIdx.x; asm volatile("" : "+v"(tid_));
    const int tid = tid_, wid = __builtin_amdgcn_readfirstlane(tid >> 6), lane = tid & 63, wr = wid >> 2, wc = wid & 3, fr = lane & 15, fq = lane >> 4;
    const int K = g.K, nt = K / BK, lda = g.lda;
    unsigned voffA[2], voffB[2];
#pragma unroll
    for (int i = 0; i < 2; ++i) { int R, C; stage_rc(tid * 16 + i * 8192, R, C); const int Rb = (R & ~31) + perm32(R & 31);
        voffA[i] = (unsigned)(R * lda + C) * 2u; voffB[i] = (unsigned)(Rb * K + C) * 2u; }
    const size_t kstep = (size_t)(BK * 2);
    const size_t hstepA = (size_t)HALF * lda * 2, hstepB = (size_t)HALF * K * 2;
    const size_t tstepA = 2 * hstepA, tstepB = 2 * hstepB;
    const unsigned ldsw = (unsigned)wid * 1024u;
    const int aoff = lds_byte(wr * 64 + fr, fq * 8), boff = lds_byte(wc * 32 + fr, fq * 8);
#define PG8_SA(b, h) (((b) * 2 + (h)) * HTB)
#define PG8_SB(b, h) ((4 + (b) * 2 + (h)) * HTB)
#define PG8_STAGE(bufoff, gbase, voff) do { _Pragma("unroll") for (int _i = 0; _i < 2; ++_i) \
        __builtin_amdgcn_global_load_lds((const unsigned*)((const char*)(gbase) + (voff)[_i]), (LAS unsigned*)(lds + (bufoff) + ldsw + _i * 8192), 16, 0, 0); } while (0)
#define PG8_LDA(dst, b, h) do { _Pragma("unroll") for (int m = 0; m < 4; ++m) _Pragma("unroll") for (int k = 0; k < 2; ++k) dst[m][k] = *(const LAS bf16x8*)(lds + PG8_SA(b, h) + aoff + m * 2048 + k * 1024); } while (0)
#define PG8_LDB(dst, b, h) do { _Pragma("unroll") for (int n = 0; n < 2; ++n) _Pragma("unroll") for (int k = 0; k < 2; ++k) dst[n][k] = *(const LAS bf16x8*)(lds + PG8_SB(b, h) + boff + n * 2048 + k * 1024); } while (0)
#define PG8_MMA(ai, bj, At, Bt) do { __builtin_amdgcn_s_setprio(1); _Pragma("unroll") for (int m = 0; m < 4; ++m) _Pragma("unroll") for (int n = 0; n < 2; ++n) _Pragma("unroll") for (int k = 0; k < 2; ++k) \
        acc[ai][bj][m][n] = __builtin_amdgcn_mfma_f32_16x16x32_bf16(Bt[n][k], At[m][k], acc[ai][bj][m][n], 0, 0, 0); __builtin_amdgcn_s_setprio(0); } while (0)
#define PG8_WAIT_V(n) asm volatile("s_waitcnt vmcnt(" #n ")" ::: "memory")
#define PG8_WAIT_L(n) asm volatile("s_waitcnt lgkmcnt(" #n ")" ::: "memory")
#define PG8_BAR __builtin_amdgcn_s_barrier()
#define PG8_SCHED __builtin_amdgcn_sched_barrier(0)
    Unit cur, nxt; int ui = 0;
    if (!S.next(0, cur)) return;
    f32x4 acc[2][2][4][2];
#pragma unroll
    for (int a = 0; a < 2; ++a)
#pragma unroll
        for (int b = 0; b < 2; ++b)
#pragma unroll
            for (int m = 0; m < 4; ++m)
#pragma unroll
                for (int n = 0; n < 2; ++n) acc[a][b][m][n] = (f32x4){0.f, 0.f, 0.f, 0.f};
    bf16x8 At[4][2], B0[2][2], B1[2][2];
    const char* cA = (const char*)g.A + (size_t)cur.pm * tstepA + (g.grp ? (size_t)(cur.pn >> 1) * K * 2 : 0); const char* cB = (const char*)g.Bt + (size_t)cur.pn * tstepB;
    PG8_STAGE(PG8_SB(0, 0), cB, voffB); PG8_STAGE(PG8_SB(0, 1), cB + hstepB, voffB); PG8_STAGE(PG8_SA(0, 0), cA, voffA); PG8_STAGE(PG8_SA(0, 1), cA + hstepA, voffA);
    if (wr == 1) PG8_BAR;
    PG8_WAIT_V(2); PG8_BAR;
    PG8_STAGE(PG8_SB(1, 0), cB + kstep, voffB); PG8_STAGE(PG8_SA(1, 0), cA + kstep, voffA); PG8_STAGE(PG8_SB(1, 1), cB + hstepB + kstep, voffB);
    PG8_WAIT_V(6); PG8_BAR;
    for (;;) {
        const bool has_next = S.next(ui + 1, nxt);
        const char* nA = has_next ? (const char*)g.A + (size_t)nxt.pm * tstepA + (g.grp ? (size_t)(nxt.pn >> 1) * K * 2 : 0) : cA; const char* nB = has_next ? (const char*)g.Bt + (size_t)nxt.pn * tstepB : cB;
        for (int t = 0; t < nt; t += 2) {
            const bool last = (t == nt - 2);
            const char* a1 = cA + (size_t)(t + 1) * kstep;
            const char* a2 = last ? nA : cA + (size_t)(t + 2) * kstep; const char* b2 = last ? nB : cB + (size_t)(t + 2) * kstep;
            const char* a3 = a2 + kstep; const char* b3 = b2 + kstep;
            PG8_LDB(B0, 0, 0); PG8_LDB(B1, 0, 1); PG8_SCHED; PG8_LDA(At, 0, 0); PG8_STAGE(PG8_SA(1, 1), a1 + hstepA, voffA);
            PG8_WAIT_V(8); PG8_WAIT_L(0); PG8_BAR; PG8_MMA(0, 0, At, B0); PG8_MMA(0, 1, At, B1); PG8_BAR; PG8_SCHED;
            PG8_LDA(At, 0, 1); PG8_STAGE(PG8_SB(0, 0), b2, voffB); PG8_STAGE(PG8_SB(0, 1), b2 + hstepB, voffB); PG8_STAGE(PG8_SA(0, 0), a2, voffA);
            PG8_WAIT_V(8); PG8_WAIT_L(0); PG8_BAR; PG8_MMA(1, 0, At, B0); PG8_MMA(1, 1, At, B1); PG8_BAR; PG8_SCHED;
            PG8_LDB(B0, 1, 0); PG8_LDB(B1, 1, 1); PG8_SCHED; PG8_LDA(At, 1, 0); PG8_STAGE(PG8_SA(0, 1), a2 + hstepA, voffA);
            PG8_WAIT_V(8); PG8_WAIT_L(0); PG8_BAR; PG8_MMA(0, 0, At, B0); PG8_MMA(0, 1, At, B1); PG8_BAR; PG8_SCHED;
            PG8_LDA(At, 1, 1); PG8_STAGE(PG8_SB(1, 0), b3, voffB); PG8_STAGE(PG8_SB(1, 1), b3 + hstepB, voffB); PG8_STAGE(PG8_SA(1, 0), a3, voffA);
            PG8_WAIT_V(8); PG8_WAIT_L(0); PG8_BAR; PG8_MMA(1, 0, At, B0); PG8_MMA(1, 1, At, B1); PG8_BAR; PG8_SCHED;
        }
        if (wr == 0) PG8_BAR;
        E(acc, cur, wr, wc, fr, fq);
        if (!has_next) break;
#pragma unroll
        for (int a = 0; a < 2; ++a)
#pragma unroll
            for (int b = 0; b < 2; ++b)
#pragma unroll
                for (int m = 0; m < 4; ++m)
#pragma unroll
                    for (int n = 0; n < 2; ++n) acc[a][b][m][n] = (f32x4){0.f, 0.f, 0.f, 0.f};
        cur = nxt; cA = nA; cB = nB; ++ui;
        if (wr == 1) PG8_BAR;
    }
    PG8_WAIT_V(0);
    PG8_BAR;
#undef PG8_SA
#undef PG8_SB
#undef PG8_STAGE
#undef PG8_LDA
#undef PG8_LDB
#undef PG8_MMA
#undef PG8_WAIT_V
#undef PG8_WAIT_L
#undef PG8_BAR
#undef PG8_SCHED
}
typedef f32x4 AccT[2][2][4][2];

__device__ __forceinline__ void st8(bf16_t* p, f32x4 v0, f32x4 v1) {
    u32x4 w; w.x = pk2(v0[0], v0[1]); w.y = pk2(v0[2], v0[3]); w.z = pk2(v1[0], v1[1]); w.w = pk2(v1[2], v1[3]); *(u32x4*)p = w;
}
struct EpiPlain {
    bf16_t* O; int ldc;
    __device__ __forceinline__ void operator()(const AccT& acc, const Unit& u, int wr, int wc, int fr, int fq) const {
        const int row0 = u.pm * BM + wr * 64 + fr, col0 = u.pn * BM + wc * 32 + 8 * fq;
#pragma unroll
        for (int ai = 0; ai < 2; ++ai)
#pragma unroll
            for (int m = 0; m < 4; ++m) { bf16_t* rowp = O + (size_t)(row0 + ai * HALF + m * 16) * ldc + col0;
#pragma unroll
                for (int bj = 0; bj < 2; ++bj) st8(rowp + bj * HALF, acc[ai][bj][m][0], acc[ai][bj][m][1]); }
    }
};
struct EpiRope {
    bf16_t* Z; const float* rope; const float* rstd;
    __device__ __forceinline__ void operator()(const AccT& acc, const Unit& u, int wr, int wc, int fr, int fq) const {
        const int row0 = u.pm * BM + wr * 64 + fr, col0 = u.pn * BM + wc * 32 + 8 * fq;
        const bool ropew = (u.pn < 4) && !(wc & 1); const float sc = (u.pn < 2) ? 0.125f * LOG2E : 1.f;
#pragma unroll
        for (int ai = 0; ai < 2; ++ai)
#pragma unroll
            for (int m = 0; m < 4; ++m) { const int row = row0 + ai * HALF + m * 16; bf16_t* rowp = Z + (size_t)row * 2048 + col0;
                f32x4 c0 = {1.f, 1.f, 1.f, 1.f}, c1 = c0, s0 = {0.f, 0.f, 0.f, 0.f}, s1 = s0;
                if (ropew && fq < 2) { const f32x4* rp = (const f32x4*)(rope + (size_t)row * 16); c0 = rp[0]; c1 = rp[1]; s0 = rp[2]; s1 = rp[3]; if (fq == 0) { s0 = -s0; s1 = -s1; } }
                const float rs = rstd[row] * sc;
#pragma unroll
                for (int bj = 0; bj < 2; ++bj) { f32x4 v0 = acc[ai][bj][m][0] * rs, v1 = acc[ai][bj][m][1] * rs;
                    if (ropew) { f32x4 p0, p1;
#pragma unroll
                        for (int i = 0; i < 4; ++i) { p0[i] = __shfl_xor(v0[i], 16); p1[i] = __shfl_xor(v1[i], 16); }
                        v0 = v0 * c0 + p0 * s0; v1 = v1 * c1 + p1 * s1; }
                    st8(rowp + bj * HALF, v0, v1); } }
    }
};
struct EpiGlu {
    const bf16_t* Y; bf16_t* O;
    __device__ __forceinline__ void operator()(const AccT& acc, const Unit& u, int wr, int wc, int fr, int fq) const {
        const int row0 = u.pm * BM + wr * 64 + fr, col0 = u.pn * BM + wc * 32 + 8 * fq;
#pragma unroll
        for (int ai = 0; ai < 2; ++ai)
#pragma unroll
            for (int m = 0; m < 4; ++m) { const int row = row0 + ai * HALF + m * 16;
#pragma unroll
                for (int bj = 0; bj < 2; ++bj) { const int col = col0 + bj * HALF; const u32x4 yw = *(const u32x4*)(Y + (size_t)row * 512 + col);
                    f32x4 a0 = acc[ai][bj][m][0], a1 = acc[ai][bj][m][1], v0, v1;
                    v0[0] = bflo(yw.x) * sigmoidf_(a0[0]); v0[1] = bfhi(yw.x) * sigmoidf_(a0[1]); v0[2] = bflo(yw.y) * sigmoidf_(a0[2]); v0[3] = bfhi(yw.y) * sigmoidf_(a0[3]);
                    v1[0] = bflo(yw.z) * sigmoidf_(a1[0]); v1[1] = bfhi(yw.z) * sigmoidf_(a1[1]); v1[2] = bflo(yw.w) * sigmoidf_(a1[2]); v1[3] = bfhi(yw.w) * sigmoidf_(a1[3]);
                    st8(O + (size_t)row * 1024 + 512 + col, v0, v1); } }
    }
};
struct EpiSwiGlu {
    bf16_t* O; const float* rstd;
    __device__ __forceinline__ void operator()(const AccT& acc, const Unit& u, int wr, int wc, int fr, int fq) const {
        const int row0 = u.pm * BM + wr * 64 + fr, col0 = u.pn * HALF + wc * 32 + 8 * fq;
#pragma unroll
        for (int ai = 0; ai < 2; ++ai)
#pragma unroll
            for (int m = 0; m < 4; ++m) { const int row = row0 + ai * HALF + m * 16; f32x4 v[2]; const float rs = rstd[row];
#pragma unroll
                for (int n = 0; n < 2; ++n)
#pragma unroll
                    for (int i = 0; i < 4; ++i) { const float gt = acc[ai][0][m][n][i] * rs, up = acc[ai][1][m][n][i] * rs; v[n][i] = gt * sigmoidf_(gt) * up; }
                st8(O + (size_t)row * FFH + col0, v[0], v[1]); }
    }
};
struct EpiIn1 {
    bf16_t* Z; const float* rstd;
    __device__ __forceinline__ void operator()(const AccT& acc, const Unit& u, int wr, int wc, int fr, int fq) const {
        const int row0 = u.pm * BM + wr * 64 + fr, col0 = u.pn * BM + wc * 32 + 8 * fq; const bool act = u.pn >= 4;
#pragma unroll
        for (int ai = 0; ai < 2; ++ai)
#pragma unroll
            for (int m = 0; m < 4; ++m) { bf16_t* rowp = Z + (size_t)(row0 + ai * HALF + m * 16) * 2048 + col0; const float rs = rstd[row0 + ai * HALF + m * 16];
#pragma unroll
                for (int bj = 0; bj < 2; ++bj) { f32x4 v0 = acc[ai][bj][m][0] * rs, v1 = acc[ai][bj][m][1] * rs;
                    if (act) {
#pragma unroll
                        for (int i = 0; i < 4; ++i) { v0[i] = gelu_tanh(v0[i]); v1[i] = gelu_tanh(v1[i]); } }
                    st8(rowp + bj * HALF, v0, v1); } }
    }
};
struct EpiGates {
    const bf16_t* XC; bf16_t* LA; bf16_t* BB; const float* b_r; const float* b_i; const float* sp;
    __device__ __forceinline__ void operator()(const AccT& acc, const Unit& u, int wr, int wc, int fr, int fq) const {
        const int row0 = u.pm * BM + wr * 64 + fr, c0 = (u.pn >> 1) * 256 + (u.pn & 1) * 128 + wc * 32 + 8 * fq;
#pragma unroll
        for (int ai = 0; ai < 2; ++ai)
#pragma unroll
            for (int m = 0; m < 4; ++m) { const int row = row0 + ai * HALF + m * 16;
#pragma unroll
                for (int n = 0; n < 2; ++n) { const int c = c0 + 4 * n; const u32x2 xw = *(const u32x2*)(XC + (size_t)row * 1024 + c);
                    const f32x4 br = *(const f32x4*)(b_r + c), bi = *(const f32x4*)(b_i + c), spv = *(const f32x4*)(sp + c);
                    const float xv[4] = {bflo(xw.x), bfhi(xw.x), bflo(xw.y), bfhi(xw.y)}; float la[4], bb[4];
#pragma unroll
                    for (int i = 0; i < 4; ++i) { const float gr = sigmoidf_(acc[ai][0][m][n][i] + br[i]), gi = sigmoidf_(acc[ai][1][m][n][i] + bi[i]);
                        const float l = -8.f * gr * spv[i]; const float a2 = fast_exp2(2.f * l * LOG2E); const float mult = sqrtf(fmaxf(1.f - a2, 0.f));
                        la[i] = l; bb[i] = mult * gi * xv[i]; }
                    u32x2 w0, w1; w0.x = pk2(la[0], la[1]); w0.y = pk2(la[2], la[3]); w1.x = pk2(bb[0], bb[1]); w1.y = pk2(bb[2], bb[3]);
                    *(u32x2*)(LA + (size_t)row * 1024 + c) = w0; *(u32x2*)(BB + (size_t)row * 1024 + c) = w1; __builtin_amdgcn_sched_barrier(0); } }
    }
};
}

__device__ __forceinline__ void transpose_item(const float* W, int ld, int K, bf16_t* dst, int k0, LAS float* scr, int lane, const float* gk = nullptr) {
#pragma unroll 8
    for (int i = 0; i < 32; ++i) { const int kk = 2 * i + (lane >> 5); const float gs = gk ? gk[k0 + kk] : 1.f; scr[kk * 33 + (lane & 31)] = W[(size_t)(k0 + kk) * ld + (lane & 31)] * gs; }
    LDS_WAIT();
    const int c = lane & 7;
#pragma unroll
    for (int j = 0; j < 4; ++j) { const int n = (lane >> 3) + 8 * j; const LAS float* s = scr + (8 * c) * 33 + n;
        u32x4 o; o.x = pk2(s[0 * 33], s[1 * 33]); o.y = pk2(s[2 * 33], s[3 * 33]); o.z = pk2(s[4 * 33], s[5 * 33]); o.w = pk2(s[6 * 33], s[7 * 33]);
        *(u32x4*)(dst + (size_t)n * K + k0 + 8 * c) = o; }
    LDS_WAIT();
}
__device__ __forceinline__ void sincos_rr(float ang, float& s, float& c) {
    const double r = (double)ang * 0.15915494309189535; const double fr = r - __builtin_rint(r); const float f = (float)fr;
    s = __builtin_amdgcn_sinf(f); c = __builtin_amdgcn_cosf(f);
}
__device__ __forceinline__ void row_to_bf16_rstd(const float* xrow, bf16_t* orow, float* rstd_out, int lane) {
    const f32x4* xr = (const f32x4*)xrow + lane;
    f32x4 v[4]; float s = 0.f;
#pragma unroll
    for (int j = 0; j < 4; ++j) { v[j] = xr[64 * j]; s += (v[j].x * v[j].x + v[j].y * v[j].y) + (v[j].z * v[j].z + v[j].w * v[j].w); }
    const float rstd = 1.f / sqrtf(wave_sum(s) * (1.f / DM) + NORM_EPS);
    u32x2* o8 = (u32x2*)orow + lane;
#pragma unroll
    for (int j = 0; j < 4; ++j) { u32x2 w; w.x = pk2(v[j].x, v[j].y); w.y = pk2(v[j].z, v[j].w); o8[64 * j] = w; }
    if (lane == 0) *rstd_out = rstd;
}
template <bool XIN_F32, bool OUT_F32>
__device__ __forceinline__ void resnorm_row(const void* xin, const bf16_t* mix, const float* gpost, void* xout, float* rstd_out, int lane) {
    const u32x2* mr = (const u32x2*)mix + lane; const f32x4* gp = (const f32x4*)gpost + lane;
    f32x4 v[4]; float s = 0.f;
#pragma unroll
    for (int j = 0; j < 4; ++j) { const u32x2 w = mr[64 * j]; v[j] = (f32x4){bflo(w.x), bfhi(w.x), bflo(w.y), bfhi(w.y)}; s += (v[j].x * v[j].x + v[j].y * v[j].y) + (v[j].z * v[j].z + v[j].w * v[j].w); }
    const float rstd = 1.f / sqrtf(wave_sum(s) * (1.f / DM) + NORM_EPS);
    float s2 = 0.f;
#pragma unroll
    for (int j = 0; j < 4; ++j) { const f32x4 gg = gp[64 * j]; f32x4 xo;
        if (XIN_F32) xo = ((const f32x4*)xin + lane)[64 * j]; else { const u32x2 w = ((const u32x2*)xin + lane)[64 * j]; xo = (f32x4){bflo(w.x), bfhi(w.x), bflo(w.y), bfhi(w.y)}; }
        v[j] = xo + v[j] * rstd * gg; s2 += (v[j].x * v[j].x + v[j].y * v[j].y) + (v[j].z * v[j].z + v[j].w * v[j].w);
        if (OUT_F32) ((f32x4*)xout + lane)[64 * j] = v[j]; else { u32x2 w; w.x = pk2(v[j].x, v[j].y); w.y = pk2(v[j].z, v[j].w); ((u32x2*)xout + lane)[64 * j] = w; } }
    if (!OUT_F32) { const float rstd2 = 1.f / sqrtf(wave_sum(s2) * (1.f / DM) + NORM_EPS); if (lane == 0) *rstd_out = rstd2; }
}

constexpr int AT_KPITCH = 144, AT_VPITCH = 160, AT_VOFF = 256 * AT_KPITCH;
constexpr int AT_UNITS = 12288, AT_HEAD = 24;
typedef short s16x4 __attribute__((ext_vector_type(4)));
__device__ __forceinline__ int attn_seq(int bx, int G, int i) {
    if (G != 256) { const int u = bx + i * G; return u < AT_UNITS ? u : -1; }
    if (bx >= 128) { if (i < AT_HEAD) return (bx - 128) + 128 * i; i -= AT_HEAD; }
    const int u = 128 * AT_HEAD + i * 256 + bx; return u < AT_UNITS ? u : -1;
}
#define AT_DECODE(u) const int sub = (u) & 15, br = ((u) >> 4) % 3, bh = (u) / 48, h = bh & 7, b = bh >> 3; \
    const int dil = br == 0 ? 1 : (br == 1 ? 4 : 16), nb = 16 / dil, rho = sub / nb, n = sub % nb; const bf16_t* Zb = Zp + (size_t)b * SEQ * 2048;
__device__ __forceinline__ void attn_issue(const bf16_t* Zp, int u, int tid, int wave, int lane, u32x4 (&rk)[4], u32x4 (&rv)[4], bf16x8& q0, bf16x8& q1) {
    AT_DECODE(u)
#pragma unroll
    for (int it = 0; it < 4; ++it) { if (n == 0 && it < 2) continue; const int idx = tid + it * NTHREADS, kb = idx >> 3, ch = idx & 7;
        const int tok = (n * 128 - 128 + kb) * dil + rho;
        const bf16_t* rowp = Zb + (size_t)tok * 2048 + h * 64 + ch * 8;
        rk[it] = *(const u32x4*)(rowp + 512); rv[it] = *(const u32x4*)(rowp + 1024); }
    const int kq = lane >> 4, qi = 16 * wave + (lane & 15); const int tokq = (n * 128 + qi) * dil + rho;
    const bf16_t* qrow = Zb + (size_t)tokq * 2048 + h * 64;
    q0 = *(const bf16x8*)(qrow + 8 * kq); q1 = *(const bf16x8*)(qrow + 32 + 8 * kq);
}
__device__ __forceinline__ void attn_phase(const bf16_t* Zp, bf16_t* POp, float* PMp, float* PLp, LAS unsigned char* lds, int bx, int G, int tid, int wave, int lane) {
    int ui = 0; int u = attn_seq(bx, G, 0); if (u < 0) return;
    u32x4 rk[4], rv[4]; bf16x8 q0n, q1n;
    attn_issue(Zp, u, tid, wave, lane, rk, rv, q0n, q1n);
    const int q = lane & 15, kq = lane >> 4, qi = 16 * wave + q;
    for (;;) {
        AT_DECODE(u)
        (void)Zb;
        __syncthreads();
#pragma unroll
        for (int it = 0; it < 4; ++it) { if (n == 0 && it < 2) continue; const int idx = tid + it * NTHREADS, kb = idx >> 3, ch = idx & 7;
            *(LAS u32x4*)(lds + kb * AT_KPITCH + ch * 16) = rk[it]; *(LAS u32x4*)(lds + AT_VOFF + kb * AT_VPITCH + ch * 16) = rv[it]; }
        if (n == 0 && tid < 128) *(LAS u32x4*)(lds + AT_VOFF + (112 + (tid >> 3)) * AT_VPITCH + (tid & 7) * 16) = (u32x4){0u, 0u, 0u, 0u};
        const bf16x8 qf0 = q0n, qf1 = q1n;
        __syncthreads();
        const int un = attn_seq(bx, G, ui + 1);
        if (un >= 0) attn_issue(Zp, un, tid, wave, lane, rk, rv, q0n, q1n);
        f32x4 o[4];
#pragma unroll
        for (int mm = 0; mm < 4; ++mm) o[mm] = (f32x4){0.f, 0.f, 0.f, 0.f};
        float mrun = -1e30f, lrun = 0.f;
        const int kstart = (16 * wave < 96) ? 16 * wave : 96;
        for (int p = 0; p < 5; ++p) {
            const int ks = kstart + 32 * p;
            if (n == 0 && ks + 32 <= 128) continue;
            if (ks + 31 < 16 * wave) continue;
            const LAS unsigned char* kp = lds + (ks + q) * AT_KPITCH + kq * 16;
            const bf16x8 k00 = *(const LAS bf16x8*)(kp), k01 = *(const LAS bf16x8*)(kp + 64);
            const bf16x8 k10 = *(const LAS bf16x8*)(kp + 16 * AT_KPITCH), k11 = *(const LAS bf16x8*)(kp + 16 * AT_KPITCH + 64);
            const LAS unsigned char* vp = lds + AT_VOFF + (ks + 4 * kq + (q >> 2)) * AT_VPITCH + (q & 3) * 8;
            s16x4 vlo[4], vhi[4];
#pragma unroll
            for (int mm = 0; mm < 4; ++mm) { vlo[mm] = __builtin_bit_cast(s16x4, __builtin_amdgcn_ds_read_tr16_b64_v4i16((LAS s16x4*)(vp + 32 * mm)));
                vhi[mm] = __builtin_bit_cast(s16x4, __builtin_amdgcn_ds_read_tr16_b64_v4i16((LAS s16x4*)(vp + 16 * AT_VPITCH + 32 * mm))); }
            f32x4 s0 = {0.f, 0.f, 0.f, 0.f}, s1 = {0.f, 0.f, 0.f, 0.f};
            s0 = __builtin_amdgcn_mfma_f32_16x16x32_bf16(k00, qf0, s0, 0, 0, 0); s0 = __builtin_amdgcn_mfma_f32_16x16x32_bf16(k01, qf1, s0, 0, 0, 0);
            s1 = __builtin_amdgcn_mfma_f32_16x16x32_bf16(k10, qf0, s1, 0, 0, 0); s1 = __builtin_amdgcn_mfma_f32_16x16x32_bf16(k11, qf1, s1, 0, 0, 0);
            float sv[8]; float mx = -1e30f; float ps = 0.f; float pv[8];
            const bool need_mask = !(ks >= 16 * wave + 15 && ks + 31 <= 16 * wave + 128) || (n == 0 && ks < 128);
            if (need_mask) { const int d0 = ks + 4 * kq - qi, kmin = (n == 0) ? 128 : 0, kb0 = ks + 4 * kq;
#pragma unroll
                for (int i = 0; i < 8; ++i) { const int c = (i >> 2) * 16 + (i & 3); const bool ok = ((unsigned)(d0 + c) <= 128u) && (kb0 + c >= kmin);
                    const float sraw = (i < 4) ? s0[i & 3] : s1[i & 3]; sv[i] = ok ? sraw : -1e30f; mx = fmaxf(mx, sv[i]); }
            } else {
#pragma unroll
                for (int i = 0; i < 8; ++i) { sv[i] = (i < 4) ? s0[i & 3] : s1[i & 3]; mx = fmaxf(mx, sv[i]); }
            }
            mx = fmaxf(mx, __shfl_xor(mx, 16)); mx = fmaxf(mx, __shfl_xor(mx, 32));
            const float mn = fmaxf(mrun, mx); const float alpha = fast_exp2(mrun - mn);
#pragma unroll
            for (int i = 0; i < 8; ++i) { pv[i] = (sv[i] > -1e29f) ? fast_exp2(sv[i] - mn) : 0.f; ps += pv[i]; }
            lrun = lrun * alpha + ps; mrun = mn;
            u32x4 pw; pw.x = pk2(pv[0], pv[1]); pw.y = pk2(pv[2], pv[3]); pw.z = pk2(pv[4], pv[5]); pw.w = pk2(pv[6], pv[7]);
            const bf16x8 pf = __builtin_bit_cast(bf16x8, pw);
#pragma unroll
            for (int mm = 0; mm < 4; ++mm) { bf16x8 vf; vf[0] = vlo[mm][0]; vf[1] = vlo[mm][1]; vf[2] = vlo[mm][2]; vf[3] = vlo[mm][3]; vf[4] = vhi[mm][0]; vf[5] = vhi[mm][1]; vf[6] = vhi[mm][2]; vf[7] = vhi[mm][3];
                o[mm] = o[mm] * alpha;
                o[mm] = __builtin_amdgcn_mfma_f32_16x16x32_bf16(vf, pf, o[mm], 0, 0, 0); }
        }
        lrun += __shfl_xor(lrun, 16); lrun += __shfl_xor(lrun, 32);
        const float inv = 1.f / lrun; const int tokq = (n * 128 + qi) * dil + rho; const size_t row = (size_t)b * SEQ + tokq;
        bf16_t* orow = POp + ((size_t)br * MTOK + row) * 512 + h * 64 + 4 * kq;
#pragma unroll
        for (int mm = 0; mm < 4; ++mm) { u32x2 w; w.x = pk2(o[mm][0] * inv, o[mm][1] * inv); w.y = pk2(o[mm][2] * inv, o[mm][3] * inv); *(u32x2*)(orow + 16 * mm) = w; }
        if (kq == 0) { PMp[((size_t)br * MTOK + row) * 8 + h] = mrun; PLp[((size_t)br * MTOK + row) * 8 + h] = lrun; }
        if (un < 0) break;
        u = un; ++ui;
    }
}

constexpr int S5_BUSP = 132, S5_HSP = 136;
constexpr int S5_WAVE_BYTES = 16 * S5_BUSP * 4 + 16 * S5_HSP * 2;
__device__ __forceinline__ void s5_unit(const bf16_t* Zp, const unsigned char* tab, const float* dskip, bf16_t* Y5p, LAS unsigned char* lds, int unit, int wave, int lane) {
    const int b = unit >> 2, g = (unit & 3) * 8 + wave;
    LAS float* bus = (LAS float*)(lds + wave * S5_WAVE_BYTES);
    LAS bf16_t* hs = (LAS bf16_t*)(lds + wave * S5_WAVE_BYTES + 16 * S5_BUSP * 4);
    const int n = lane & 15, kg = lane >> 4;
    const bf16_t* BMt = (const bf16_t*)(tab + S5_BM); const bf16_t* CMt = (const bf16_t*)(tab + S5_CM); const float* AB = (const float*)(tab + S5_ABAR);
    bf16x8 bm[8], cm[4];
#pragma unroll
    for (int nt = 0; nt < 8; ++nt) bm[nt] = *(const bf16x8*)(BMt + ((size_t)(g * 128 + 16 * nt + n)) * 32 + 8 * kg);
#pragma unroll
    for (int kk = 0; kk < 4; ++kk) cm[kk] = *(const bf16x8*)(CMt + ((size_t)(g * 16 + n)) * 128 + 32 * kk + 8 * kg);
    const float dsk = dskip[g * 16 + n];
    const float ar = AB[(g * 64 + lane) * 2], ai = AB[(g * 64 + lane) * 2 + 1];
    float hr = 0.f, hi = 0.f;
    const bf16_t* ub = Zp + (size_t)b * SEQ * 2048 + 1536 + g * 16;
    bf16_t* yb = Y5p + (size_t)b * SEQ * 512 + g * 16 + n;
    bf16x8 ufn = {0, 0, 0, 0, 0, 0, 0, 0};
    if (kg < 2) ufn = *(const bf16x8*)(ub + (size_t)n * 2048 + 8 * kg);
    for (int t0 = 0; t0 < SEQ; t0 += 16) {
        const bf16x8 uf = ufn;
        if (kg < 2 && t0 + 16 < SEQ) ufn = *(const bf16x8*)(ub + (size_t)(t0 + 16 + n) * 2048 + 8 * kg);
        unsigned short us[4];
#pragma unroll
        for (int i = 0; i < 4; ++i) us[i] = ub[(size_t)(t0 + 4 * kg + i) * 2048 + n];
#pragma unroll
        for (int nt = 0; nt < 8; ++nt) { f32x4 d = {0.f, 0.f, 0.f, 0.f}; d = __builtin_amdgcn_mfma_f32_16x16x32_bf16(bm[nt], uf, d, 0, 0, 0);
            *(LAS f32x4*)(bus + n * S5_BUSP + 16 * nt + 4 * kg) = d; }
        LDS_WAIT();
#pragma unroll
        for (int t = 0; t < 16; ++t) { const float bre = bus[t * S5_BUSP + 2 * lane], bim = bus[t * S5_BUSP + 2 * lane + 1];
            const float nr = ar * hr - ai * hi + bre, ni = ar * hi + ai * hr + bim; hr = nr; hi = ni;
            *(LAS unsigned*)(hs + t * S5_HSP + 2 * lane) = pk2(hr, hi); }
        LDS_WAIT();
        f32x4 y = {0.f, 0.f, 0.f, 0.f};
#pragma unroll
        for (int kk = 0; kk < 4; ++kk) { const bf16x8 hf = *(const LAS bf16x8*)(hs + n * S5_HSP + 32 * kk + 8 * kg); y = __builtin_amdgcn_mfma_f32_16x16x32_bf16(hf, cm[kk], y, 0, 0, 0); }
#pragma unroll
        for (int i = 0; i < 4; ++i) { const int t = t0 + 4 * kg + i; const float v = gelu_tanh(y[i] + dsk * bf2f(us[i])); yb[(size_t)t * 512] = (bf16_t)f2bf(v); }
        LDS_WAIT();
    }
}

#define XB_TMO      128
#define XB_XCNT(j)  (256  + 64 * (j))
#define XB_XSUB(j)  (1280 + 64 * (j))
#define XB_XGEN(j)  (2304 + 64 * (j))
#define XB_TOP      3328
#define XB_TOPGEN   3392
#define XCD_BAR_WORDS 3456
#define XB_SPIN_CAP (1u << 22)
__device__ __forceinline__ unsigned xb_ld(unsigned* p)              { return __hip_atomic_load(p, __ATOMIC_RELAXED, __HIP_MEMORY_SCOPE_AGENT); }
__device__ __forceinline__ unsigned xb_add(unsigned* p, unsigned v) { return __hip_atomic_fetch_add(p, v, __ATOMIC_RELAXED, __HIP_MEMORY_SCOPE_AGENT); }
__device__ __forceinline__ unsigned xb_xcc_id() { return (unsigned)__builtin_amdgcn_s_getreg((3 << 11) | 20) & 0xFu; }
#define XB_SPIN(cond, bar) do { unsigned _sp = 0; while (cond) { __builtin_amdgcn_s_sleep(1); \
    if ((++_sp & 255u) == 0u) { if (xb_ld(&(bar)[XB_TMO])) break; if (_sp > XB_SPIN_CAP) { atomicAdd(&(bar)[XB_TMO], 1u); break; } } } } while (0)
__device__ __forceinline__ void xcd_barrier_complete(unsigned* bar, unsigned x, unsigned& nloc, unsigned& nx) {
    const unsigned G = gridDim.x * gridDim.y * gridDim.z;
    unsigned sum, cnt, mine, sp = 0u;
    for (;;) {
        sum = 0u; cnt = 0u; mine = 0u;
#pragma unroll
        for (unsigned j = 0; j < 16; ++j) { const unsigned c = xb_ld(&bar[XB_XCNT(j)]); sum += c; cnt += (c > 0u) ? 1u : 0u; mine = (j == x) ? c : mine; }
        if (sum == G) break;
        __builtin_amdgcn_s_sleep(1);
        if ((++sp & 255u) == 0u) { if (xb_ld(&bar[XB_TMO])) break; if (sp > XB_SPIN_CAP) { atomicAdd(&bar[XB_TMO], 1u); break; } }
    }
    nloc = mine > 0u ? mine : 1u; nx = cnt > 0u ? cnt : 1u;
}
__device__ __forceinline__ void xcd_barrier(unsigned* bar, volatile LAS unsigned* st) {
    asm volatile("s_waitcnt vmcnt(0)" ::: "memory");
    __syncthreads();
    if (threadIdx.x == 0) {
        const unsigned x = xb_xcc_id();
        __builtin_amdgcn_s_waitcnt(0);
        unsigned nloc = st[0], nx = st[1];
        if (nloc == 0u) { xcd_barrier_complete(bar, x, nloc, nx); st[0] = nloc; st[1] = nx; }
        const unsigned old = xb_add(&bar[XB_XSUB(x)], 1u);
        const unsigned gen = old / nloc;
        if (old + 1u == (gen + 1u) * nloc) {
            __builtin_amdgcn_fence(__ATOMIC_RELEASE, "agent");
            asm volatile("s_waitcnt vmcnt(0)" ::: "memory");
            const unsigned og = xb_add(&bar[XB_TOP], 1u);
            const unsigned tg = og / nx;
            if (og + 1u == (tg + 1u) * nx) xb_add(&bar[XB_TOPGEN], 1u);
            else XB_SPIN(xb_ld(&bar[XB_TOPGEN]) == tg, bar);
            __builtin_amdgcn_fence(__ATOMIC_ACQUIRE, "agent");
            xb_add(&bar[XB_XGEN(x)], 1u);
            asm volatile("s_waitcnt vmcnt(0)" ::: "memory");
        } else {
            XB_SPIN(xb_ld(&bar[XB_XGEN(x)]) == gen, bar);
            __builtin_amdgcn_fence(__ATOMIC_ACQUIRE, "agent");
            asm volatile("s_waitcnt vmcnt(0)" ::: "memory");
        }
    }
    __syncthreads();
}
constexpr int LDS_MISC = 135 * 1024;
constexpr size_t CTL_BYTES = 16384;

typedef const __attribute__((address_space(4))) Args* ArgsP;
__global__ void __launch_bounds__(NTHREADS, 2) mega(Args a_kern) {
    extern __shared__ __attribute__((aligned(16))) unsigned char lds_raw[];
    LAS unsigned char* lds = (LAS unsigned char*)lds_raw;
    cg::grid_group grid = cg::this_grid();
    ArgsP ap = (ArgsP)__builtin_amdgcn_kernarg_segment_ptr();
#define a (*ap)
#define ws (a.ws)
    int tid, lane, wave, gw, gt;
    const int G = gridDim.x, bx = blockIdx.x;
    const int NGW = G * NWAVES, NGT = G * NTHREADS;
#define RELOAD() do { asm volatile("" : "+s"(ap)); tid = threadIdx.x; asm volatile("" : "+v"(tid)); lane = tid & 63; wave = __builtin_amdgcn_readfirstlane(tid >> 6); gw = bx * NWAVES + wave; gt = bx * NTHREADS + tid; } while (0)
    RELOAD();
    volatile LAS unsigned* bst = (volatile LAS unsigned*)(lds + LDS_MISC);
    if (tid == 0) { bst[0] = 0u; bst[1] = 0u; (void)xb_add((unsigned*)(ws + WS_CTL) + XB_XCNT(xb_xcc_id()), 1u); }
    __syncthreads();
#define x_in (a.in[0])
#define positions ((const int*)a.in[1])
#define g_mix_pre (a.in[2])
#define g_mix_post (a.in[3])
#define g_ffn_pre (a.in[4])
#define g_ffn_post (a.in[5])
#define HN ((bf16_t*)(ws + WS_HN))
#define RSTD ((float*)(ws + WS_CTL + 512 * 1024))
#define Z ((bf16_t*)(ws + WS_Z))
#define YC ((bf16_t*)(ws + WS_YC))
#define MIX ((bf16_t*)(ws + WS_MIX))
#define PO ((bf16_t*)(ws + WS_PO))
#define PM ((float*)(ws + WS_PM))
#define PL ((float*)(ws + WS_PL))
#define Y5 ((bf16_t*)(ws + WS_Y5))
#define HID ((bf16_t*)(ws + WS_HID))
#define XC ((bf16_t*)(ws + WS_XC))
#define BB ((bf16_t*)(ws + WS_BB))
#define Y1 ((bf16_t*)(ws + WS_Y1))
#define LA ((bf16_t*)(ws + WS_LA))
#define ROPE ((float*)(ws + WS_ROPE))
#define S5T (ws + WS_S5TAB)
#define SP ((float*)(ws + WS_S5TAB + S5_SP))
#define X (a.out)
#ifndef PHMASK
#define PHMASK 0xFFFFFFFFu
#endif
#define IN(k) (((PHMASK >> (k)) & 1u) && a.ph_lo <= (k) && (k) < a.ph_hi)
#ifndef REPMASK
#define REPMASK 0x0u
#endif
#define REPS(k) (1 + (int)((REPMASK >> (k)) & 1u))
#define REPSYNC do { if (rep) grid.sync(); } while (0)
#define SEAM(k) do { if (IN(k) && IN((k) + 1)) { if ((k) == 0) grid.sync(); else xcd_barrier((unsigned*)(ws + WS_CTL), bst); } RELOAD(); } while (0)

    if (IN(0)) _Pragma("unroll") for (int rep = 0; rep < REPS(0); ++rep) {
        LAS float* scr = (LAS float*)(lds + wave * 8448);
        constexpr int I_IN = 16 * 64, I_OUT = 16 * 32, I_GLU = 8 * 16, I_GATE = 4 * 64, I_UP = 16 * 176, I_DN = 44 * 32;
        constexpr int NITEMS = 2 * I_IN + 2 * I_OUT + I_GLU + I_GATE + 2 * I_UP + 2 * I_DN;
        for (int it = gw; it < NITEMS; it += NGW) {
            int r = it;
            if (r < I_IN) { const int kb = r / 64, nb = r % 64; transpose_item(a.in[6] + nb * 32, 2048, 1024, (bf16_t*)(ws + WS_W_IN0) + (size_t)nb * 32 * 1024, kb * 64, scr, lane, g_mix_pre); continue; } r -= I_IN;
            if (r < I_IN) { const int kb = r / 64, nb = r % 64; transpose_item(a.in[17] + nb * 32, 2048, 1024, (bf16_t*)(ws + WS_W_IN1) + (size_t)nb * 32 * 1024, kb * 64, scr, lane, g_mix_pre + DM); continue; } r -= I_IN;
            if (r < I_OUT) { const int kb = r / 32, nb = r % 32; transpose_item(a.in[7] + nb * 32, 1024, 1024, (bf16_t*)(ws + WS_W_OUT0) + (size_t)nb * 32 * 1024, kb * 64, scr, lane); continue; } r -= I_OUT;
            if (r < I_OUT) { const int kb = r / 32, nb = r % 32; transpose_item(a.in[18] + nb * 32, 1024, 1024, (bf16_t*)(ws + WS_W_OUT1) + (size_t)nb * 32 * 1024, kb * 64, scr, lane); continue; } r -= I_OUT;
            if (r < I_GLU) { const int kb = r / 16, nb = r % 16; transpose_item(a.in[16] + nb * 32, 512, 512, (bf16_t*)(ws + WS_W_GLU) + (size_t)nb * 32 * 512, kb * 64, scr, lane); continue; } r -= I_GLU;
            if (r < I_GATE) { const int kb = r / 64, nb = r % 64; const int n0 = nb * 32, pn = n0 >> 8, half = (n0 >> 7) & 1, j = n0 & 127, hh = pn >> 1, colg = (pn & 1) * 128 + j;
                const float* src = (half ? a.in[23] : a.in[21]) + (size_t)hh * 256 * 256 + colg;
                transpose_item(src, 256, 256, (bf16_t*)(ws + WS_W_GATE) + (size_t)n0 * 256, kb * 64, scr, lane); continue; } r -= I_GATE;
            if (r < 2 * I_UP) { const int layer = r / I_UP; r -= layer * I_UP; const int kb = r / 176, nb = r % 176; const int n0 = nb * 32, t = n0 >> 8, half = (n0 >> 7) & 1, j = n0 & 127;
                const float* src = (half ? a.in[27] : a.in[26]) + (size_t)layer * 1024 * FFH + t * 128 + j;
                transpose_item(src, FFH, 1024, (bf16_t*)(ws + (layer ? WS_W_UP1 : WS_W_UP0)) + (size_t)n0 * 1024, kb * 64, scr, lane, g_ffn_pre + layer * DM); continue; } r -= 2 * I_UP;
            { const int layer = r / I_DN; r -= layer * I_DN; const int kb = r / 32, nb = r % 32;
                transpose_item(a.in[28] + (size_t)layer * FFH * 1024 + nb * 32, 1024, FFH, (bf16_t*)(ws + (layer ? WS_W_DN1 : WS_W_DN0)) + (size_t)nb * 32 * FFH, kb * 64, scr, lane); }
        }
        for (int idx = gt; idx < MTOK * 8; idx += NGT) { const int tok = idx >> 3, j = idx & 7; const float inv_freq = powf(500000.0f, -(float)j * 0.125f);
            const float ang = (float)positions[tok] * inv_freq; float s, c; sincos_rr(ang, s, c); ROPE[(size_t)tok * 16 + j] = c; ROPE[(size_t)tok * 16 + 8 + j] = s; }
        for (int idx = gt; idx < 32 * 64; idx += NGT) { const int g = idx >> 6, p = idx & 63;
            const float are = a.in[8][idx], aim = a.in[9][idx], dt = expf(a.in[10][g]);
            const float xr = are * dt, yi = aim * dt; const float ex = expf(xr); float sn, cs; sincos_rr(yi, sn, cs);
            const float abr = ex * cs, abi = ex * sn;
            float sh, ch; sincos_rr(0.5f * yi, sh, ch); (void)ch;
            const float nre = expm1f(xr) * cs - 2.f * sh * sh, nim = abi;
            const float den = 1.f / (are * are + aim * aim);
            const float cre = (nre * are + nim * aim) * den, cim = (nim * are - nre * aim) * den;
            float* AB = (float*)(S5T + S5_ABAR); AB[idx * 2] = abr; AB[idx * 2 + 1] = abi;
            bf16_t* BMt = (bf16_t*)(S5T + S5_BM); bf16_t* CMt = (bf16_t*)(S5T + S5_CM);
            for (int c = 0; c < 16; ++c) { const float bre = a.in[11][(size_t)idx * 16 + c], bim = a.in[12][(size_t)idx * 16 + c];
                BMt[((size_t)g * 128 + 2 * p) * 32 + c] = (bf16_t)f2bf(cre * bre - cim * bim); BMt[((size_t)g * 128 + 2 * p + 1) * 32 + c] = (bf16_t)f2bf(cre * bim + cim * bre);
                BMt[((size_t)g * 128 + 2 * p) * 32 + 16 + c] = 0; BMt[((size_t)g * 128 + 2 * p + 1) * 32 + 16 + c] = 0;
                CMt[((size_t)g * 16 + c) * 128 + 2 * p] = (bf16_t)f2bf(a.in[13][((size_t)g * 16 + c) * 64 + p]); CMt[((size_t)g * 16 + c) * 128 + 2 * p + 1] = (bf16_t)f2bf(-a.in[14][((size_t)g * 16 + c) * 64 + p]); } }
        for (int idx = gt; idx < 1024; idx += NGT) SP[idx] = log1pf(expf(-a.in[25][idx]));
        for (int m = gw; m < MTOK; m += NGW) row_to_bf16_rstd(x_in + (size_t)m * DM, HN + (size_t)m * DM, RSTD + m, lane);
    }
    SEAM(0);
    if (IN(1)) _Pragma("unroll") for (int rep = 0; rep < REPS(1); ++rep) { pg8::Gemm g{HN, (const bf16_t*)(ws + WS_W_IN0), MTOK, 2048, 1024, 1024, 0}; pg8::StaticOrder S; S.init(MTOK, 2048, G, bx);
        pg8::EpiRope E{Z, ROPE, RSTD}; pg8::gemm_phase(lds, g, S, E); }
    SEAM(1);
    if (IN(2)) _Pragma("unroll") for (int rep = 0; rep < REPS(2); ++rep) {
        if (bx < 128) s5_unit(Z, S5T, a.in[15], Y5, lds, bx, wave, lane);
        attn_phase(Z, PO, PM, PL, lds, bx, G, tid, wave, lane);
    }
    SEAM(2);
    if (IN(3)) _Pragma("unroll") for (int rep = 0; rep < REPS(3); ++rep) {
        for (int idx = gt; idx < MTOK * 64; idx += NGT) { const int row = idx >> 6, c8 = idx & 63, h = c8 >> 3;
            float mv[3], lv[3]; u32x4 ow[3];
#pragma unroll
            for (int i = 0; i < 3; ++i) { mv[i] = PM[((size_t)i * MTOK + row) * 8 + h]; lv[i] = PL[((size_t)i * MTOK + row) * 8 + h]; ow[i] = *(const u32x4*)(PO + ((size_t)i * MTOK + row) * 512 + c8 * 8); }
            const float mx = fmaxf(mv[0], fmaxf(mv[1], mv[2]));
            float w[3]; float den = 0.f;
#pragma unroll
            for (int i = 0; i < 3; ++i) { w[i] = fast_exp2(mv[i] - mx) * lv[i]; den += w[i]; }
            const float inv = 1.f / den; f32x4 v0 = {0.f, 0.f, 0.f, 0.f}, v1 = v0;
#pragma unroll
            for (int i = 0; i < 3; ++i) { const float ww = w[i] * inv;
                v0[0] += ww * bflo(ow[i].x); v0[1] += ww * bfhi(ow[i].x); v0[2] += ww * bflo(ow[i].y); v0[3] += ww * bfhi(ow[i].y);
                v1[0] += ww * bflo(ow[i].z); v1[1] += ww * bfhi(ow[i].z); v1[2] += ww * bflo(ow[i].w); v1[3] += ww * bfhi(ow[i].w); }
            pg8::st8(YC + (size_t)row * 1024 + c8 * 8, v0, v1); }
        __syncthreads();
        pg8::Gemm g{Y5, (const bf16_t*)(ws + WS_W_GLU), MTOK, 512, 512, 512, 0}; pg8::StaticOrder S; S.init(MTOK, 512, G, bx);
        pg8::EpiGlu E{Y5, YC}; pg8::gemm_phase(lds, g, S, E);
    }
    SEAM(3);
    if (IN(4)) _Pragma("unroll") for (int rep = 0; rep < REPS(4); ++rep) { pg8::Gemm g{YC, (const bf16_t*)(ws + WS_W_OUT0), MTOK, 1024, 1024, 1024, 0}; pg8::StaticOrder S; S.init(MTOK, 1024, G, bx);
        pg8::EpiPlain E{MIX, 1024}; pg8::gemm_phase(lds, g, S, E); }
    SEAM(4);
    if (IN(5)) _Pragma("unroll") for (int rep = 0; rep < REPS(5); ++rep) for (int m = gw; m < MTOK; m += NGW) resnorm_row<true, false>(x_in + (size_t)m * DM, MIX + (size_t)m * DM, g_mix_post, HN + (size_t)m * DM, RSTD + m, lane);
    SEAM(5);
    if (IN(6)) _Pragma("unroll") for (int rep = 0; rep < REPS(6); ++rep) { pg8::Gemm g{HN, (const bf16_t*)(ws + WS_W_UP0), MTOK, 2 * FFH, 1024, 1024, 0}; pg8::StaticOrder S; S.init(MTOK, 2 * FFH, G, bx);
        pg8::EpiSwiGlu E{HID, RSTD}; pg8::gemm_phase(lds, g, S, E); }
    SEAM(6);
    if (IN(7)) _Pragma("unroll") for (int rep = 0; rep < REPS(7); ++rep) { pg8::Gemm g{HID, (const bf16_t*)(ws + WS_W_DN0), MTOK, 1024, FFH, FFH, 0}; pg8::StaticOrder S; S.init(MTOK, 1024, G, bx);
        pg8::EpiPlain E{MIX, 1024}; pg8::gemm_phase(lds, g, S, E); }
    SEAM(7);
    if (IN(8)) _Pragma("unroll") for (int rep = 0; rep < REPS(8); ++rep) for (int m = gw; m < MTOK; m += NGW) resnorm_row<false, false>(HN + (size_t)m * DM, MIX + (size_t)m * DM, g_ffn_post, HN + (size_t)m * DM, RSTD + m, lane);
    SEAM(8);
    if (IN(9)) _Pragma("unroll") for (int rep = 0; rep < REPS(9); ++rep) { pg8::Gemm g{HN, (const bf16_t*)(ws + WS_W_IN1), MTOK, 2048, 1024, 1024, 0}; pg8::StaticOrder S; S.init(MTOK, 2048, G, bx);
        pg8::EpiIn1 E{Z, RSTD}; pg8::gemm_phase(lds, g, S, E); }
    SEAM(9);
    if (IN(10)) _Pragma("unroll") for (int rep = 0; rep < REPS(10); ++rep) {
        const float* cw = a.in[19]; const float* cb = a.in[20];
        for (int idx = gt; idx < (MTOK / 8) * 128; idx += NGT) { const int c8 = idx & 127, tb = idx >> 7, row0 = tb * 8, c0 = c8 * 8; const int t0 = row0 & (SEQ - 1);
            float w[4][8], bias[8];
#pragma unroll
            for (int k = 0; k < 4; ++k) { const f32x4 wa = *(const f32x4*)(cw + k * 1024 + c0), wb = *(const f32x4*)(cw + k * 1024 + c0 + 4);
                w[k][0] = wa.x; w[k][1] = wa.y; w[k][2] = wa.z; w[k][3] = wa.w; w[k][4] = wb.x; w[k][5] = wb.y; w[k][6] = wb.z; w[k][7] = wb.w; }
            { const f32x4 ba = *(const f32x4*)(cb + c0), bb = *(const f32x4*)(cb + c0 + 4); bias[0] = ba.x; bias[1] = ba.y; bias[2] = ba.z; bias[3] = ba.w; bias[4] = bb.x; bias[5] = bb.y; bias[6] = bb.z; bias[7] = bb.w; }
            float xm[3][8];
#pragma unroll
            for (int k = 0; k < 3; ++k) { u32x4 v = {0u, 0u, 0u, 0u}; if (t0 - 3 + k >= 0) v = *(const u32x4*)(Z + (size_t)(row0 - 3 + k) * 2048 + c0);
                xm[k][0] = bflo(v.x); xm[k][1] = bfhi(v.x); xm[k][2] = bflo(v.y); xm[k][3] = bfhi(v.y); xm[k][4] = bflo(v.z); xm[k][5] = bfhi(v.z); xm[k][6] = bflo(v.w); xm[k][7] = bfhi(v.w); }
#pragma unroll
            for (int r = 0; r < 8; ++r) { const u32x4 v = *(const u32x4*)(Z + (size_t)(row0 + r) * 2048 + c0);
                const float xc[8] = {bflo(v.x), bfhi(v.x), bflo(v.y), bfhi(v.y), bflo(v.z), bfhi(v.z), bflo(v.w), bfhi(v.w)};
                f32x4 o0, o1;
#pragma unroll
                for (int i = 0; i < 8; ++i) { const float o = bias[i] + w[0][i] * xm[0][i] + w[1][i] * xm[1][i] + w[2][i] * xm[2][i] + w[3][i] * xc[i];
                    if (i < 4) o0[i] = o; else o1[i - 4] = o; xm[0][i] = xm[1][i]; xm[1][i] = xm[2][i]; xm[2][i] = xc[i]; }
                pg8::st8(XC + (size_t)(row0 + r) * 1024 + c0, o0, o1); } }
    }
    SEAM(10);
    if (IN(11)) _Pragma("unroll") for (int rep = 0; rep < REPS(11); ++rep) { pg8::Gemm g{XC, (const bf16_t*)(ws + WS_W_GATE), MTOK, 2048, 256, 1024, 1}; pg8::StaticOrder S; S.init(MTOK, 2048, G, bx);
        pg8::EpiGates E{XC, LA, BB, a.in[22], a.in[24], SP}; pg8::gemm_phase(lds, g, S, E); }
    SEAM(11);
    if (IN(12)) _Pragma("unroll") for (int rep = 0; rep < REPS(12); ++rep) {
        LAS float* car = (LAS float*)lds;
        for (int u = bx; u < 256; u += G) { const int b = u >> 3, c0 = (u & 7) * 128 + 2 * lane; const size_t rbase = (size_t)b * SEQ + wave * 256;
            const bf16_t* la = LA + rbase * 1024 + c0; const bf16_t* bb = BB + rbase * 1024 + c0;
            float h0 = 0.f, h1 = 0.f, s0 = 0.f, s1 = 0.f;
#pragma unroll 8
            for (int t = 0; t < 256; ++t) { const unsigned lw = *(const unsigned*)(la + (size_t)t * 1024), bw = *(const unsigned*)(bb + (size_t)t * 1024);
                const float l0 = bflo(lw), l1 = bfhi(lw); s0 += l0; s1 += l1;
                h0 = fast_exp2(l0 * LOG2E) * h0 + bflo(bw); h1 = fast_exp2(l1 * LOG2E) * h1 + bfhi(bw); }
            __syncthreads();
            car[(wave * 64 + lane) * 4 + 0] = fast_exp2(s0 * LOG2E); car[(wave * 64 + lane) * 4 + 1] = fast_exp2(s1 * LOG2E); car[(wave * 64 + lane) * 4 + 2] = h0; car[(wave * 64 + lane) * 4 + 3] = h1;
            __syncthreads();
            h0 = 0.f; h1 = 0.f;
            for (int j = 0; j < wave; ++j) { const f32x4 cv = *(const LAS f32x4*)(car + (j * 64 + lane) * 4); h0 = cv.x * h0 + cv.z; h1 = cv.y * h1 + cv.w; }
            const bf16_t* gb = Z + rbase * 2048 + 1024 + c0; bf16_t* yo = Y1 + rbase * 1024 + c0;
#pragma unroll 8
            for (int t = 0; t < 256; ++t) { const unsigned lw = *(const unsigned*)(la + (size_t)t * 1024), bw = *(const unsigned*)(bb + (size_t)t * 1024), gwv = *(const unsigned*)(gb + (size_t)t * 2048);
                h0 = fast_exp2(bflo(lw) * LOG2E) * h0 + bflo(bw); h1 = fast_exp2(bfhi(lw) * LOG2E) * h1 + bfhi(bw);
                *(unsigned*)(yo + (size_t)t * 1024) = pk2(h0 * bflo(gwv), h1 * bfhi(gwv)); }
        }
    }
    SEAM(12);
    if (IN(13)) _Pragma("unroll") for (int rep = 0; rep < REPS(13); ++rep) { pg8::Gemm g{Y1, (const bf16_t*)(ws + WS_W_OUT1), MTOK, 1024, 1024, 1024, 0}; pg8::StaticOrder S; S.init(MTOK, 1024, G, bx);
        pg8::EpiPlain E{MIX, 1024}; pg8::gemm_phase(lds, g, S, E); }
    SEAM(13);
    if (IN(14)) _Pragma("unroll") for (int rep = 0; rep < REPS(14); ++rep) for (int m = gw; m < MTOK; m += NGW) resnorm_row<false, false>(HN + (size_t)m * DM, MIX + (size_t)m * DM, g_mix_post + DM, HN + (size_t)m * DM, RSTD + m, lane);
    SEAM(14);
    if (IN(15)) _Pragma("unroll") for (int rep = 0; rep < REPS(15); ++rep) { pg8::Gemm g{HN, (const bf16_t*)(ws + WS_W_UP1), MTOK, 2 * FFH, 1024, 1024, 0}; pg8::StaticOrder S; S.init(MTOK, 2 * FFH, G, bx);
        pg8::EpiSwiGlu E{HID, RSTD}; pg8::gemm_phase(lds, g, S, E); }
    SEAM(15);
    if (IN(16)) _Pragma("unroll") for (int rep = 0; rep < REPS(16); ++rep) { pg8::Gemm g{HID, (const bf16_t*)(ws + WS_W_DN1), MTOK, 1024, FFH, FFH, 0}; pg8::StaticOrder S; S.init(MTOK, 1024, G, bx);
        pg8::EpiPlain E{MIX, 1024}; pg8::gemm_phase(lds, g, S, E); }
    SEAM(16);
    if (IN(17)) _Pragma("unroll") for (int rep = 0; rep < REPS(17); ++rep) for (int m = gw; m < MTOK; m += NGW) resnorm_row<false, true>(HN + (size_t)m * DM, MIX + (size_t)m * DM, g_ffn_post + DM, X + (size_t)m * DM, nullptr, lane);
#undef IN
#undef SEAM
#undef a
#undef ws
}
constexpr int NPHASES = 18;

extern "C" void kernel_launch(void* const* d_in, const int* in_sizes, int n_in, void* d_out, int out_size, void* d_ws, size_t ws_size, hipStream_t stream) {
    static int grid = 0;
    if (grid == 0) {
        if (n_in != 29 || in_sizes[0] != MTOK * DM || out_size != MTOK * DM || ws_size < WS_END) {
            fprintf(stderr, "kernel_launch: unexpected shapes: n_in %d in0 %d out %d ws %zu (need %zu)\n", n_in, n_in > 0 ? in_sizes[0] : -1, out_size, ws_size, (size_t)WS_END); grid = -1; return; }
        int dev = 0, cus = 0, per_cu = 0;
        hipGetDevice(&dev); hipDeviceGetAttribute(&cus, hipDeviceAttributeMultiprocessorCount, dev);
        if (hipFuncSetAttribute((const void*)mega, hipFuncAttributeMaxDynamicSharedMemorySize, LDS_BYTES) != hipSuccess) { fprintf(stderr, "kernel_launch: hipFuncSetAttribute failed\n"); grid = -1; return; }
        if (hipOccupancyMaxActiveBlocksPerMultiprocessor(&per_cu, (const void*)mega, NTHREADS, LDS_BYTES) != hipSuccess || per_cu < 1) { fprintf(stderr, "kernel_launch: occupancy query says %d\n", per_cu); per_cu = 1; }
        (void)hipGetLastError();
        grid = cus;
    }
    if (grid < 0) return;
    if (hipMemsetAsync((char*)d_ws + WS_CTL, 0, CTL_BYTES, stream) != hipSuccess) { fprintf(stderr, "kernel_launch: memset failed\n"); return; }
    Args a{};
    for (int i = 0; i < 29; ++i) a.in[i] = (const float*)d_in[i];
    a.out = (float*)d_out; a.ws = (unsigned char*)d_ws;
#if N_LAUNCH_MODE == 1
    a.ph_lo = 0; a.ph_hi = NPHASES;
    void* args[] = {&a};
    hipError_t e = hipLaunchCooperativeKernel((const void*)mega, dim3(grid), dim3(NTHREADS), args, LDS_BYTES, stream);
    if (e != hipSuccess) fprintf(stderr, "cooperative launch failed: %s (grid %d)\n", hipGetErrorString(e), grid);
#else
    for (int ph = 0; ph < NPHASES; ++ph) { a.ph_lo = ph; a.ph_hi = ph + 1; hipLaunchKernelGGL(mega, dim3(grid), dim3(NTHREADS), LDS_BYTES, stream, a); }
#endif
}
```

```cpp
#include <hip/hip_runtime.h>
#include <hip/hip_cooperative_groups.h>
#include <cstdio>
#include <cstdint>
namespace cg = cooperative_groups;

#ifndef N_LAUNCH_MODE
#define N_LAUNCH_MODE 1
#endif

#define LAS __attribute__((address_space(3)))
typedef unsigned short bf16_t;
typedef short bf16x8 __attribute__((ext_vector_type(8)));
typedef float f32x4 __attribute__((ext_vector_type(4)));
typedef unsigned u32x4 __attribute__((ext_vector_type(4)));
typedef unsigned u32x2 __attribute__((ext_vector_type(2)));
typedef float f32x2 __attribute__((ext_vector_type(2)));

constexpr int MTOK = 65536, DM = 1024, SEQ = 2048, NBATCH = 32, FFH = 2816;
constexpr float NORM_EPS = 1e-6f;
constexpr float LOG2E = 1.4426950408889634f;
constexpr int NWAVES = 8, NTHREADS = 512;
constexpr int LDS_BYTES = 136 * 1024;

constexpr size_t MiB = 1u << 20;
constexpr size_t WS_CTL = 0;
constexpr size_t WS_W_IN0 = 1 * MiB, WS_W_OUT0 = 5 * MiB, WS_W_GLU = 7 * MiB, WS_W_IN1 = 8 * MiB, WS_W_OUT1 = 12 * MiB, WS_W_GATE = 14 * MiB;
constexpr size_t WS_W_UP0 = 15 * MiB, WS_W_UP1 = 26 * MiB, WS_W_DN0 = 37 * MiB, WS_W_DN1 = 43 * MiB;
constexpr size_t WS_ROPE = 49 * MiB;
constexpr size_t WS_S5TAB = 53 * MiB;
constexpr size_t S5_ABAR = 0, S5_BM = 16384, S5_CM = 16384 + 262144, S5_SP = 16384 + 262144 + 131072;
constexpr size_t WS_HN = 64 * MiB, WS_Z = 192 * MiB, WS_YC = 448 * MiB, WS_MIX = 576 * MiB, WS_PO = 704 * MiB, WS_PM = 896 * MiB, WS_PL = 902 * MiB, WS_Y5 = 908 * MiB;
constexpr size_t WS_HID = 192 * MiB;
constexpr size_t WS_XC = 448 * MiB, WS_BB = 576 * MiB, WS_Y1 = 704 * MiB, WS_LA = 832 * MiB;
constexpr size_t WS_END = 972 * MiB;

struct Args { const float* in[29]; float* out; unsigned char* ws; int ph_lo, ph_hi; };

__device__ __forceinline__ unsigned f2bf(float f) { unsigned u = __builtin_bit_cast(unsigned, f); return (u + 0x7fffu + ((u >> 16) & 1u)) >> 16; }
__device__ __forceinline__ unsigned pk2(float lo, float hi) { unsigned r; asm("v_cvt_pk_bf16_f32 %0, %1, %2" : "=v"(r) : "v"(lo), "v"(hi)); return r; }
__device__ __forceinline__ float bf2f(unsigned short h) { return __builtin_bit_cast(float, (unsigned)h << 16); }
__device__ __forceinline__ float bflo(unsigned w) { return __builtin_bit_cast(float, w << 16); }
__device__ __forceinline__ float bfhi(unsigned w) { return __builtin_bit_cast(float, w & 0xffff0000u); }
__device__ __forceinline__ float fast_exp2(float x) { return __builtin_amdgcn_exp2f(x); }
__device__ __forceinline__ float fast_rcp(float x) { return __builtin_amdgcn_rcpf(x); }
__device__ __forceinline__ float sigmoidf_(float x) { return fast_rcp(1.f + fast_exp2(-x * LOG2E)); }
__device__ __forceinline__ float gelu_tanh(float x) { const float u = 0.7978845608028654f * (x + 0.044715f * x * x * x); return x * sigmoidf_(2.f * u); }
__device__ __forceinline__ float wave_sum(float v) {
#pragma unroll
    for (int o = 1; o < 64; o <<= 1) v += __shfl_xor(v, o);
    return v;
}
#define LDS_WAIT() asm volatile("s_waitcnt lgkmcnt(0)" ::: "memory")

namespace pg8 {
constexpr int BM = 256, BK = 64, HALF = 128, HTB = HALF * BK * 2, STAGE_BYTES = 8 * HTB, NXCD = 8, WGM = 8;
__host__ __device__ __forceinline__ int lds_byte(int r, int c) { const int st = (r >> 4) * 2 + (c >> 5), rr = r & 15, cc = c & 31, ob = rr * 64 + cc * 2; return st * 1024 + (ob ^ (((ob >> 9) & 1) << 5)); }
__host__ __device__ __forceinline__ void stage_rc(int b, int& R, int& C) { const int st = b / 1024, sb = b % 1024, swz = sb ^ (((sb >> 9) & 1) << 5); R = (st >> 1) * 16 + swz / 64; C = (st & 1) * 32 + (swz % 64) / 2; }
__host__ __device__ __forceinline__ int perm32(int rho) { const int n = rho >> 4, i = rho & 15; return 8 * (i >> 2) + 4 * n + (i & 3); }
struct Unit { int pm, pn; };
struct Gemm { const bf16_t* A; const bf16_t* Bt; int M, N, K, lda, grp; };
struct StaticOrder {
    int nM, nN, nwg, G, c;
    __host__ __device__ void init(int M, int N, int G_, int c_) { nM = M / BM; nN = N / BM; nwg = nM * nN; G = G_; c = c_; }
    __host__ __device__ bool next(int i, Unit& u) const {
        const long L = (long)i * G + c; if (L >= nwg) return false;
        int wgid = (int)L; { const int q = nwg / NXCD, r = nwg % NXCD, xcd = wgid % NXCD, off = wgid / NXCD; wgid = (xcd < r ? xcd * (q + 1) : r * (q + 1) + (xcd - r) * q) + off; }
        const int nig = WGM * nN, gid = wgid / nig, fm = gid * WGM, gsz = (nM - fm) < WGM ? (nM - fm) : WGM;
        u.pm = fm + ((wgid % nig) % gsz); u.pn = (wgid % nig) / gsz; return true;
    }
};
template <class Epi>
__device__ __forceinline__ void gemm_phase(LAS unsigned char* lds, const Gemm g, const StaticOrder& S, const Epi& E) {
    int tid_ = threadIdx.x; asm volatile("" : "+v"(tid_));
    const int tid = tid_, wid = __builtin_amdgcn_readfirstlane(tid >> 6), lane = tid & 63, wr = wid >> 2, wc = wid & 3, fr = lane & 15, fq = lane >> 4;
    const int K = g.K, nt = K / BK, lda = g.lda;
    unsigned voffA[2], voffB[2];
#pragma unroll
    for (int i = 0; i < 2; ++i) { int R, C; stage_rc(tid * 16 + i * 8192, R, C); const int Rb = (R & ~31) + perm32(R & 31);
        voffA[i] = (unsigned)(R * lda + C) * 2u; voffB[i] = (unsigned)(Rb * K + C) * 2u; }
    const size_t kstep = (size_t)(BK * 2);
    const size_t hstepA = (size_t)HALF * lda * 2, hstepB = (size_t)HALF * K * 2;
    const size_t tstepA = 2 * hstepA, tstepB = 2 * hstepB;
    const unsigned ldsw = (unsigned)wid * 1024u;
    const int aoff = lds_byte(wr * 64 + fr, fq * 8), boff = lds_byte(wc * 32 + fr, fq * 8);
#define PG8_SA(b, h) (((b) * 2 + (h)) * HTB)
#define PG8_SB(b, h) ((4 + (b) * 2 + (h)) * HTB)
#define PG8_STAGE(bufoff, gbase, voff) do { _Pragma("unroll") for (int _i = 0; _i < 2; ++_i) \
        __builtin_amdgcn_global_load_lds((const unsigned*)((const char*)(gbase) + (voff)[_i]), (LAS unsigned*)(lds + (bufoff) + ldsw + _i * 8192), 16, 0, 0); } while (0)
#define PG8_LDA(dst, b, h) do { _Pragma("unroll") for (int m = 0; m < 4; ++m) _Pragma("unroll") for (int k = 0; k < 2; ++k) dst[m][k] = *(const LAS bf16x8*)(lds + PG8_SA(b, h) + aoff + m * 2048 + k * 1024); } while (0)
#define PG8_LDB(dst, b, h) do { _Pragma("unroll") for (int n = 0; n < 2; ++n) _Pragma("unroll") for (int k = 0; k < 2; ++k) dst[n][k] = *(const LAS bf16x8*)(lds + PG8_SB(b, h) + boff + n * 2048 + k * 1024); } while (0)
#define PG8_MMA(ai, bj, At, Bt) do { __builtin_amdgcn_s_setprio(1); _Pragma("unroll") for (int m = 0; m < 4; ++m) _Pragma("unroll") for (int n = 0; n < 2; ++n) _Pragma("unroll") for (int k = 0; k < 2; ++k) \
        acc[ai][bj][m][n] = __builtin_amdgcn_mfma_f32_16x16x32_bf16(Bt[n][k], At[m][k], acc[ai][bj][m][n], 0, 0, 0); __builtin_amdgcn_s_setprio(0); } while (0)
#define PG8_WAIT_V(n) asm volatile("s_waitcnt vmcnt(" #n ")" ::: "memory")
#define PG8_WAIT_L(n) asm volatile("s_waitcnt lgkmcnt(" #n ")" ::: "memory")
#define PG8_BAR __builtin_amdgcn_s_barrier()
#define PG8_SCHED __builtin_amdgcn_sched_barrier(0)
    Unit cur, nxt; int ui = 0;
    if (!S.next(0, cur)) return;
    f32x4 acc[2][2][4][2];
#pragma unroll
    for (int a = 0; a < 2; ++a)
#pragma unroll
        for (int b = 0; b < 2; ++b)
#pragma unroll
            for (int m = 0; m < 4; ++m)
#pragma unroll
                for (int n = 0; n < 2; ++n) acc[a][b][m][n] = (f32x4){0.f, 0.f, 0.f, 0.f};
    bf16x8 At[4][2], B0[2][2], B1[2][2];
    const char* cA = (const char*)g.A + (size_t)cur.pm * tstepA + (g.grp ? (size_t)(cur.pn >> 1) * K * 2 : 0); const char* cB = (const char*)g.Bt + (size_t)cur.pn * tstepB;
    PG8_STAGE(PG8_SB(0, 0), cB, voffB); PG8_STAGE(PG8_SB(0, 1), cB + hstepB, voffB); PG8_STAGE(PG8_SA(0, 0), cA, voffA); PG8_STAGE(PG8_SA(0, 1), cA + hstepA, voffA);
    if (wr == 1) PG8_BAR;
    PG8_WAIT_V(2); PG8_BAR;
    PG8_STAGE(PG8_SB(1, 0), cB + kstep, voffB); PG8_STAGE(PG8_SA(1, 0), cA + kstep, voffA); PG8_STAGE(PG8_SB(1, 1), cB + hstepB + kstep, voffB);
    PG8_WAIT_V(6); PG8_BAR;
    for (;;) {
        const bool has_next = S.next(ui + 1, nxt);
        const char* nA = has_next ? (const char*)g.A + (size_t)nxt.pm * tstepA + (g.grp ? (size_t)(nxt.pn >> 1) * K * 2 : 0) : cA; const char* nB = has_next ? (const char*)g.Bt + (size_t)nxt.pn * tstepB : cB;
        for (int t = 0; t < nt; t += 2) {
            const bool last = (t == nt - 2);
            const char* a1 = cA + (size_t)(t + 1) * kstep;
            const char* a2 = last ? nA : cA + (size_t)(t + 2) * kstep; const char* b2 = last ? nB : cB + (size_t)(t + 2) * kstep;
            const char* a3 = a2 + kstep; const char* b3 = b2 + kstep;
            PG8_LDB(B0, 0, 0); PG8_LDB(B1, 0, 1); PG8_SCHED; PG8_LDA(At, 0, 0); PG8_STAGE(PG8_SA(1, 1), a1 + hstepA, voffA);
            PG8_WAIT_V(8); PG8_WAIT_L(0); PG8_BAR; PG8_MMA(0, 0, At, B0); PG8_MMA(0, 1, At, B1); PG8_BAR; PG8_SCHED;
            PG8_LDA(At, 0, 1); PG8_STAGE(PG8_SB(0, 0), b2, voffB); PG8_STAGE(PG8_SB(0, 1), b2 + hstepB, voffB); PG8_STAGE(PG8_SA(0, 0), a2, voffA);
            PG8_WAIT_V(8); PG8_WAIT_L(0); PG8_BAR; PG8_MMA(1, 0, At, B0); PG8_MMA(1, 1, At, B1); PG8_BAR; PG8_SCHED;
            PG8_LDB(B0, 1, 0); PG8_LDB(B1, 1, 1); PG8_SCHED; PG8_LDA(At, 1, 0); PG8_STAGE(PG8_SA(0, 1), a2 + hstepA, voffA);
            PG8_WAIT_V(8); PG8_WAIT_L(0); PG8_BAR; PG8_MMA(0, 0, At, B0); PG8_MMA(0, 1, At, B1); PG8_BAR; PG8_SCHED;
            PG8_LDA(At, 1, 1); PG8_STAGE(PG8_SB(1, 0), b3, voffB); PG8_STAGE(PG8_SB(1, 1), b3 + hstepB, voffB); PG8_STAGE(PG8_SA(1, 0), a3, voffA);
            PG8_WAIT_V(8); PG8_WAIT_L(0); PG8_BAR; PG8_MMA(1, 0, At, B0); PG8_MMA(1, 1, At, B1); PG8_BAR; PG8_SCHED;
        }
        if (wr == 0) PG8_BAR;
        E(acc, cur, wr, wc, fr, fq);
        if (!has_next) break;
#pragma unroll
        for (int a = 0; a < 2; ++a)
#pragma unroll
            for (int b = 0; b < 2; ++b)
#pragma unroll
                for (int m = 0; m < 4; ++m)
#pragma unroll
                    for (int n = 0; n < 2; ++n) acc[a][b][m][n] = (f32x4){0.f, 0.f, 0.f, 0.f};
        cur = nxt; cA = nA; cB = nB; ++ui;
        if (wr == 1) PG8_BAR;
    }
    PG8_WAIT_V(0);
    PG8_BAR;
#undef PG8_SA
#undef PG8_SB
#undef PG8_STAGE
#undef PG8_LDA
#undef PG8_LDB
#undef PG8_MMA
#undef PG8_WAIT_V
#undef PG8_WAIT_L
#undef PG8_BAR
#undef PG8_SCHED
}
typedef f32x4 AccT[2][2][4][2];

__device__ __forceinline__ void st8(bf16_t* p, f32x4 v0, f32x4 v1) {
    u32x4 w; w.x = pk2(v0[0], v0[1]); w.y = pk2(v0[2], v0[3]); w.z = pk2(v1[0], v1[1]); w.w = pk2(v1[2], v1[3]); *(u32x4*)p = w;
}
struct EpiPlain {
    bf16_t* O; int ldc;
    __device__ __forceinline__ void operator()(const AccT& acc, const Unit& u, int wr, int wc, int fr, int fq) const {
        const int row0 = u.pm * BM + wr * 64 + fr, col0 = u.pn * BM + wc * 32 + 8 * fq;
#pragma unroll
        for (int ai = 0; ai < 2; ++ai)
#pragma unroll
            for (int m = 0; m < 4; ++m) { bf16_t* rowp = O + (size_t)(row0 + ai * HALF + m * 16) * ldc + col0;
#pragma unroll
                for (int bj = 0; bj < 2; ++bj) st8(rowp + bj * HALF, acc[ai][bj][m][0], acc[ai][bj][m][1]); }
    }
};
struct EpiRope {
    bf16_t* Z; const float* rope; const float* rstd;
    __device__ __forceinline__ void operator()(const AccT& acc, const Unit& u, int wr, int wc, int fr, int fq) const {
        const int row0 = u.pm * BM + wr * 64 + fr, col0 = u.pn * BM + wc * 32 + 8 * fq;
        const bool ropew = (u.pn < 4) && !(wc & 1); const float sc = (u.pn < 2) ? 0.125f * LOG2E : 1.f;
#pragma unroll
        for (int ai = 0; ai < 2; ++ai)
#pragma unroll
            for (int m = 0; m < 4; ++m) { const int row = row0 + ai * HALF + m * 16; bf16_t* rowp = Z + (size_t)row * 2048 + col0;
                f32x4 c0 = {1.f, 1.f, 1.f, 1.f}, c1 = c0, s0 = {0.f, 0.f, 0.f, 0.f}, s1 = s0;
                if (ropew && fq < 2) { const f32x4* rp = (const f32x4*)(rope + (size_t)row * 16); c0 = rp[0]; c1 = rp[1]; s0 = rp[2]; s1 = rp[3]; if (fq == 0) { s0 = -s0; s1 = -s1; } }
                const float rs = rstd[row] * sc;
#pragma unroll
                for (int bj = 0; bj < 2; ++bj) { f32x4 v0 = acc[ai][bj][m][0] * rs, v1 = acc[ai][bj][m][1] * rs;
                    if (ropew) { f32x4 p0, p1;
#pragma unroll
                        for (int i = 0; i < 4; ++i) { p0[i] = __shfl_xor(v0[i], 16); p1[i] = __shfl_xor(v1[i], 16); }
                        v0 = v0 * c0 + p0 * s0; v1 = v1 * c1 + p1 * s1; }
                    st8(rowp + bj * HALF, v0, v1); } }
    }
};
struct EpiGlu {
    const bf16_t* Y; bf16_t* O;
    __device__ __forceinline__ void operator()(const AccT& acc, const Unit& u, int wr, int wc, int fr, int fq) const {
        const int row0 = u.pm * BM + wr * 64 + fr, col0 = u.pn * BM + wc * 32 + 8 * fq;
#pragma unroll
        for (int ai = 0; ai < 2; ++ai)
#pragma unroll
            for (int m = 0; m < 4; ++m) { const int row = row0 + ai * HALF + m * 16;
#pragma unroll
                for (int bj = 0; bj < 2; ++bj) { const int col = col0 + bj * HALF; const u32x4 yw = *(const u32x4*)(Y + (size_t)row * 512 + col);
                    f32x4 a0 = acc[ai][bj][m][0], a1 = acc[ai][bj][m][1], v0, v1;
                    v0[0] = bflo(yw.x) * sigmoidf_(a0[0]); v0[1] = bfhi(yw.x) * sigmoidf_(a0[1]); v0[2] = bflo(yw.y) * sigmoidf_(a0[2]); v0[3] = bfhi(yw.y) * sigmoidf_(a0[3]);
                    v1[0] = bflo(yw.z) * sigmoidf_(a1[0]); v1[1] = bfhi(yw.z) * sigmoidf_(a1[1]); v1[2] = bflo(yw.w) * sigmoidf_(a1[2]); v1[3] = bfhi(yw.w) * sigmoidf_(a1[3]);
                    st8(O + (size_t)row * 1024 + 512 + col, v0, v1); } }
    }
};
struct EpiSwiGlu {
    bf16_t* O; const float* rstd;
    __device__ __forceinline__ void operator()(const AccT& acc, const Unit& u, int wr, int wc, int fr, int fq) const {
        const int row0 = u.pm * BM + wr * 64 + fr, col0 = u.pn * HALF + wc * 32 + 8 * fq;
#pragma unroll
        for (int ai = 0; ai < 2; ++ai)
#pragma unroll
            for (int m = 0; m < 4; ++m) { const int row = row0 + ai * HALF + m * 16; f32x4 v[2]; const float rs = rstd[row];
#pragma unroll
                for (int n = 0; n < 2; ++n)
#pragma unroll
                    for (int i = 0; i < 4; ++i) { const float gt = acc[ai][0][m][n][i] * rs, up = acc[ai][1][m][n][i] * rs; v[n][i] = gt * sigmoidf_(gt) * up; }
                st8(O + (size_t)row * FFH + col0, v[0], v[1]); }
    }
};
struct EpiIn1 {
    bf16_t* Z; const float* rstd;
    __device__ __forceinline__ void operator()(const AccT& acc, const Unit& u, int wr, int wc, int fr, int fq) const {
        const int row0 = u.pm * BM + wr * 64 + fr, col0 = u.pn * BM + wc * 32 + 8 * fq; const bool act = u.pn >= 4;
#pragma unroll
        for (int ai = 0; ai < 2; ++ai)
#pragma unroll
            for (int m = 0; m < 4; ++m) { bf16_t* rowp = Z + (size_t)(row0 + ai * HALF + m * 16) * 2048 + col0; const float rs = rstd[row0 + ai * HALF + m * 16];
#pragma unroll
                for (int bj = 0; bj < 2; ++bj) { f32x4 v0 = acc[ai][bj][m][0] * rs, v1 = acc[ai][bj][m][1] * rs;
                    if (act) {
#pragma unroll
                        for (int i = 0; i < 4; ++i) { v0[i] = gelu_tanh(v0[i]); v1[i] = gelu_tanh(v1[i]); } }
                    st8(rowp + bj * HALF, v0, v1); } }
    }
};
struct EpiGates {
    const bf16_t* XC; bf16_t* LA; bf16_t* BB; const float* b_r; const float* b_i; const float* sp;
    __device__ __forceinline__ void operator()(const AccT& acc, const Unit& u, int wr, int wc, int fr, int fq) const {
        const int row0 = u.pm * BM + wr * 64 + fr, c0 = (u.pn >> 1) * 256 + (u.pn & 1) * 128 + wc * 32 + 8 * fq;
#pragma unroll
        for (int ai = 0; ai < 2; ++ai)
#pragma unroll
            for (int m = 0; m < 4; ++m) { const int row = row0 + ai * HALF + m * 16;
#pragma unroll
                for (int n = 0; n < 2; ++n) { const int c = c0 + 4 * n; const u32x2 xw = *(const u32x2*)(XC + (size_t)row * 1024 + c);
                    const f32x4 br = *(const f32x4*)(b_r + c), bi = *(const f32x4*)(b_i + c), spv = *(const f32x4*)(sp + c);
                    const float xv[4] = {bflo(xw.x), bfhi(xw.x), bflo(xw.y), bfhi(xw.y)}; float la[4], bb[4];
#pragma unroll
                    for (int i = 0; i < 4; ++i) { const float gr = sigmoidf_(acc[ai][0][m][n][i] + br[i]), gi = sigmoidf_(acc[ai][1][m][n][i] + bi[i]);
                        const float l = -8.f * gr * spv[i]; const float a2 = fast_exp2(2.f * l * LOG2E); const float mult = sqrtf(fmaxf(1.f - a2, 0.f));
                        la[i] = l; bb[i] = mult * gi * xv[i]; }
                    u32x2 w0, w1; w0.x = pk2(la[0], la[1]); w0.y = pk2(la[2], la[3]); w1.x = pk2(bb[0], bb[1]); w1.y = pk2(bb[2], bb[3]);
                    *(u32x2*)(LA + (size_t)row * 1024 + c) = w0; *(u32x2*)(BB + (size_t)row * 1024 + c) = w1; __builtin_amdgcn_sched_barrier(0); } }
    }
};
}

__device__ __forceinline__ void transpose_item(const float* W, int ld, int K, bf16_t* dst, int k0, LAS float* scr, int lane, const float* gk = nullptr) {
#pragma unroll 8
    for (int i = 0; i < 32; ++i) { const int kk = 2 * i + (lane >> 5); const float gs = gk ? gk[k0 + kk] : 1.f; scr[kk * 33 + (lane & 31)] = W[(size_t)(k0 + kk) * ld + (lane & 31)] * gs; }
    LDS_WAIT();
    const int c = lane & 7;
#pragma unroll
    for (int j = 0; j < 4; ++j) { const int n = (lane >> 3) + 8 * j; const LAS float* s = scr + (8 * c) * 33 + n;
        u32x4 o; o.x = pk2(s[0 * 33], s[1 * 33]); o.y = pk2(s[2 * 33], s[3 * 33]); o.z = pk2(s[4 * 33], s[5 * 33]); o.w = pk2(s[6 * 33], s[7 * 33]);
        *(u32x4*)(dst + (size_t)n * K + k0 + 8 * c) = o; }
    LDS_WAIT();
}
__device__ __forceinline__ void sincos_rr(float ang, float& s, float& c) {
    const double r = (double)ang * 0.15915494309189535; const double fr = r - __builtin_rint(r); const float f = (float)fr;
    s = __builtin_amdgcn_sinf(f); c = __builtin_amdgcn_cosf(f);
}
template <int R>
__device__ __forceinline__ void rows_to_bf16_rstd(const float* x, bf16_t* o, float* rstd_out, int m0, int stride, int lane) {
    f32x4 v[R][4]; float s[R];
#pragma unroll
    for (int r = 0; r < R; ++r) { const f32x4* xr = (const f32x4*)(x + (size_t)(m0 + r * stride) * DM) + lane;
#pragma unroll
        for (int j = 0; j < 4; ++j) v[r][j] = xr[64 * j]; }
#pragma unroll
    for (int r = 0; r < R; ++r) { s[r] = 0.f;
#pragma unroll
        for (int j = 0; j < 4; ++j) s[r] += (v[r][j].x * v[r][j].x + v[r][j].y * v[r][j].y) + (v[r][j].z * v[r][j].z + v[r][j].w * v[r][j].w); }
#pragma unroll
    for (int o_ = 1; o_ < 64; o_ <<= 1) {
#pragma unroll
        for (int r = 0; r < R; ++r) s[r] += __shfl_xor(s[r], o_); }
#pragma unroll
    for (int r = 0; r < R; ++r) { u32x2* o8 = (u32x2*)(o + (size_t)(m0 + r * stride) * DM) + lane;
#pragma unroll
        for (int j = 0; j < 4; ++j) { u32x2 w; w.x = pk2(v[r][j].x, v[r][j].y); w.y = pk2(v[r][j].z, v[r][j].w); o8[64 * j] = w; }
        if (lane == 0) rstd_out[m0 + r * stride] = 1.f / sqrtf(s[r] * (1.f / DM) + NORM_EPS); }
}
struct RnBuf { u32x2 mx[2][4]; f32x4 xf[2][4]; u32x2 xb[2][4]; };
template <bool XIN_F32>
__device__ __forceinline__ void rn_load(RnBuf& B, const void* xin, const bf16_t* mix, int m0, int stride, int lane) {
#pragma unroll
    for (int r = 0; r < 2; ++r) { const size_t ro = (size_t)(m0 + r * stride) * DM; const u32x2* mr = (const u32x2*)(mix + ro) + lane;
#pragma unroll
        for (int j = 0; j < 4; ++j) { B.mx[r][j] = mr[64 * j];
            if (XIN_F32) B.xf[r][j] = ((const f32x4*)((const float*)xin + ro) + lane)[64 * j]; else B.xb[r][j] = ((const u32x2*)((const bf16_t*)xin + ro) + lane)[64 * j]; } }
}
template <bool XIN_F32, bool OUT_F32>
__device__ __forceinline__ void rn_process(const RnBuf& B, const float* gpost, void* xout, float* rstd_out, int m0, int stride, int lane) {
    f32x4 v[2][4]; float s[2], s2[2];
#pragma unroll
    for (int r = 0; r < 2; ++r) { s[r] = 0.f;
#pragma unroll
        for (int j = 0; j < 4; ++j) { const u32x2 w = B.mx[r][j]; v[r][j] = (f32x4){bflo(w.x), bfhi(w.x), bflo(w.y), bfhi(w.y)};
            s[r] += (v[r][j].x * v[r][j].x + v[r][j].y * v[r][j].y) + (v[r][j].z * v[r][j].z + v[r][j].w * v[r][j].w); } }
#pragma unroll
    for (int o_ = 1; o_ < 64; o_ <<= 1) {
#pragma unroll
        for (int r = 0; r < 2; ++r) s[r] += __shfl_xor(s[r], o_); }
#pragma unroll
    for (int r = 0; r < 2; ++r) { const float rstd = 1.f / sqrtf(s[r] * (1.f / DM) + NORM_EPS); const size_t ro = (size_t)(m0 + r * stride) * DM; s2[r] = 0.f;
#pragma unroll
        for (int j = 0; j < 4; ++j) { const f32x4 gg = ((const f32x4*)gpost + lane)[64 * j]; f32x4 xo;
            if (XIN_F32) xo = B.xf[r][j]; else { const u32x2 w2 = B.xb[r][j]; xo = (f32x4){bflo(w2.x), bfhi(w2.x), bflo(w2.y), bfhi(w2.y)}; }
            v[r][j] = xo + v[r][j] * rstd * gg;
            s2[r] += (v[r][j].x * v[r][j].x + v[r][j].y * v[r][j].y) + (v[r][j].z * v[r][j].z + v[r][j].w * v[r][j].w);
            if (OUT_F32) ((f32x4*)((float*)xout + ro) + lane)[64 * j] = v[r][j]; else { u32x2 w; w.x = pk2(v[r][j].x, v[r][j].y); w.y = pk2(v[r][j].z, v[r][j].w); ((u32x2*)((bf16_t*)xout + ro) + lane)[64 * j] = w; } } }
    if (!OUT_F32) {
#pragma unroll
        for (int o_ = 1; o_ < 64; o_ <<= 1) {
#pragma unroll
            for (int r = 0; r < 2; ++r) s2[r] += __shfl_xor(s2[r], o_); }
#pragma unroll
        for (int r = 0; r < 2; ++r) if (lane == 0) rstd_out[m0 + r * stride] = 1.f / sqrtf(s2[r] * (1.f / DM) + NORM_EPS); }
}
template <bool XIN_F32, bool OUT_F32>
__device__ __forceinline__ void resnorm_phase(const void* xin, const bf16_t* mix, const float* gpost, void* xout, float* rstd_out, int gw, int NGW, int lane) {
    RnBuf A, B; int m = gw;
    if (m + NGW >= MTOK) return;
    rn_load<XIN_F32>(A, xin, mix, m, NGW, lane);
    for (;;) {
        const int m2 = m + 2 * NGW; const bool has2 = m2 + NGW < MTOK;
        if (has2) rn_load<XIN_F32>(B, xin, mix, m2, NGW, lane);
        rn_process<XIN_F32, OUT_F32>(A, gpost, xout, rstd_out, m, NGW, lane);
        if (!has2) break;
        const int m3 = m2 + 2 * NGW; const bool has3 = m3 + NGW < MTOK;
        if (has3) rn_load<XIN_F32>(A, xin, mix, m3, NGW, lane);
        rn_process<XIN_F32, OUT_F32>(B, gpost, xout, rstd_out, m2, NGW, lane);
        if (!has3) break;
        m = m3;
    }
}

constexpr int AT_KPITCH = 144, AT_VPITCH = 160, AT_VOFF = 256 * AT_KPITCH;
constexpr int AT_UNITS = 12288, AT_HEAD = 28;
typedef short s16x4 __attribute__((ext_vector_type(4)));
__device__ __forceinline__ int attn_seq(int bx, int G, int i) {
    if (G != 256) { const int u = bx + i * G; return u < AT_UNITS ? u : -1; }
    const int x = bx & 7, wl = bx >> 3; int L;
    if (wl >= 16) { if (i < AT_HEAD) L = (wl - 16) + 16 * i; else L = 16 * AT_HEAD + (i - AT_HEAD) * 32 + wl; }
    else L = 16 * AT_HEAD + i * 32 + wl;
    if (L >= AT_UNITS / 8) return -1;
    return (x + 8 * (L / 48)) * 48 + (L % 48);
}
#define AT_DECODE(u) const int sub = (u) & 15, br = ((u) >> 4) % 3, bh = (u) / 48, h = bh & 7, b = bh >> 3; \
    const int dil = br == 0 ? 1 : (br == 1 ? 4 : 16), nb = 16 / dil, rho = sub / nb, n = sub % nb; const bf16_t* Zb = Zp + (size_t)b * SEQ * 2048;
__device__ __forceinline__ void attn_issue(const bf16_t* Zp, int u, int tid, int wave, int lane, u32x4 (&rk)[4], u32x4 (&rv)[4], bf16x8& q0, bf16x8& q1) {
    AT_DECODE(u)
#pragma unroll
    for (int it = 0; it < 4; ++it) { if (n == 0 && it < 2) continue; const int idx = tid + it * NTHREADS, kb = idx >> 3, ch = idx & 7;
        const int tok = (n * 128 - 128 + kb) * dil + rho;
        const bf16_t* rowp = Zb + (size_t)tok * 2048 + h * 64 + ch * 8;
        rk[it] = *(const u32x4*)(rowp + 512); rv[it] = *(const u32x4*)(rowp + 1024); }
    const int kq = lane >> 4, qi = 16 * wave + (lane & 15); const int tokq = (n * 128 + qi) * dil + rho;
    const bf16_t* qrow = Zb + (size_t)tokq * 2048 + h * 64;
    q0 = *(const bf16x8*)(qrow + 8 * kq); q1 = *(const bf16x8*)(qrow + 32 + 8 * kq);
}
__device__ __forceinline__ void attn_phase(const bf16_t* Zp, bf16_t* POp, float* PMp, float* PLp, LAS unsigned char* lds, int bx, int G, int tid, int wave, int lane) {
    int ui = 0; int u = attn_seq(bx, G, 0); if (u < 0) return;
    u32x4 rk[4], rv[4]; bf16x8 q0n, q1n;
    attn_issue(Zp, u, tid, wave, lane, rk, rv, q0n, q1n);
    const int q = lane & 15, kq = lane >> 4, qi = 16 * wave + q;
    for (;;) {
        AT_DECODE(u)
        (void)Zb;
        const int kmin_ = (n == 0) ? 128 : 0; const int mlo = qi > kmin_ ? qi : kmin_; const unsigned mrange = (unsigned)(qi + 128 - mlo);
        __syncthreads();
#pragma unroll
        for (int it = 0; it < 4; ++it) { if (n == 0 && it < 2) continue; const int idx = tid + it * NTHREADS, kb = idx >> 3, ch = idx & 7;
            *(LAS u32x4*)(lds + kb * AT_KPITCH + ch * 16) = rk[it]; *(LAS u32x4*)(lds + AT_VOFF + kb * AT_VPITCH + ch * 16) = rv[it]; }
        if (n == 0 && tid < 128) *(LAS u32x4*)(lds + AT_VOFF + (112 + (tid >> 3)) * AT_VPITCH + (tid & 7) * 16) = (u32x4){0u, 0u, 0u, 0u};
        const bf16x8 qf0 = q0n, qf1 = q1n;
        __syncthreads();
        const int un = attn_seq(bx, G, ui + 1);
        if (un >= 0) attn_issue(Zp, un, tid, wave, lane, rk, rv, q0n, q1n);
        const int kstart = (16 * wave < 96) ? 16 * wave : 96;
        f32x4 st[10];
#pragma unroll
        for (int p = 0; p < 5; ++p) {
            const int ks = kstart + 32 * p;
            const bool live = !(n == 0 && ks + 32 <= 128) && !(ks + 31 < 16 * wave);
            st[2 * p] = (f32x4){-1e30f, -1e30f, -1e30f, -1e30f}; st[2 * p + 1] = st[2 * p];
            if (live) {
                const LAS unsigned char* kp = lds + (ks + q) * AT_KPITCH + kq * 16;
                const bf16x8 k00 = *(const LAS bf16x8*)(kp), k01 = *(const LAS bf16x8*)(kp + 64);
                const bf16x8 k10 = *(const LAS bf16x8*)(kp + 16 * AT_KPITCH), k11 = *(const LAS bf16x8*)(kp + 16 * AT_KPITCH + 64);
                f32x4 s0 = {0.f, 0.f, 0.f, 0.f}, s1 = {0.f, 0.f, 0.f, 0.f};
                s0 = __builtin_amdgcn_mfma_f32_16x16x32_bf16(k00, qf0, s0, 0, 0, 0); s0 = __builtin_amdgcn_mfma_f32_16x16x32_bf16(k01, qf1, s0, 0, 0, 0);
                s1 = __builtin_amdgcn_mfma_f32_16x16x32_bf16(k10, qf0, s1, 0, 0, 0); s1 = __builtin_amdgcn_mfma_f32_16x16x32_bf16(k11, qf1, s1, 0, 0, 0);
                const bool need_mask = !(ks >= 16 * wave + 15 && ks + 31 <= 16 * wave + 128) || (n == 0 && ks < 128);
                if (need_mask) {
                    const int tb = ks + 4 * kq - mlo;
#pragma unroll
                    for (int i = 0; i < 4; ++i) { s0[i] = ((unsigned)(tb + i) <= mrange) ? s0[i] : -1e30f; s1[i] = ((unsigned)(tb + 16 + i) <= mrange) ? s1[i] : -1e30f; }
                }
                st[2 * p] = s0; st[2 * p + 1] = s1;
            }
        }
        float mrun = -1e30f;
#pragma unroll
        for (int j = 0; j < 10; ++j) mrun = fmaxf(mrun, fmaxf(fmaxf(st[j][0], st[j][1]), fmaxf(st[j][2], st[j][3])));
        mrun = fmaxf(mrun, __shfl_xor(mrun, 16)); mrun = fmaxf(mrun, __shfl_xor(mrun, 32));
        float lrun = 0.f;
#pragma unroll
        for (int j = 0; j < 10; ++j)
#pragma unroll
            for (int i = 0; i < 4; ++i) { st[j][i] = fast_exp2(st[j][i] - mrun); lrun += st[j][i]; }
        f32x4 o[4];
#pragma unroll
        for (int mm = 0; mm < 4; ++mm) o[mm] = (f32x4){0.f, 0.f, 0.f, 0.f};
#pragma unroll
        for (int p = 0; p < 5; ++p) {
            const int ks = kstart + 32 * p;
            const bool live = !(n == 0 && ks + 32 <= 128) && !(ks + 31 < 16 * wave);
            if (live) {
                const LAS unsigned char* vp = lds + AT_VOFF + (ks + 4 * kq + (q >> 2)) * AT_VPITCH + (q & 3) * 8;
                u32x4 pw; pw.x = pk2(st[2 * p][0], st[2 * p][1]); pw.y = pk2(st[2 * p][2], st[2 * p][3]); pw.z = pk2(st[2 * p + 1][0], st[2 * p + 1][1]); pw.w = pk2(st[2 * p + 1][2], st[2 * p + 1][3]);
                const bf16x8 pf = __builtin_bit_cast(bf16x8, pw);
#pragma unroll
                for (int mm = 0; mm < 4; ++mm) {
                    const s16x4 vlo = __builtin_bit_cast(s16x4, __builtin_amdgcn_ds_read_tr16_b64_v4i16((LAS s16x4*)(vp + 32 * mm)));
                    const s16x4 vhi = __builtin_bit_cast(s16x4, __builtin_amdgcn_ds_read_tr16_b64_v4i16((LAS s16x4*)(vp + 16 * AT_VPITCH + 32 * mm)));
                    bf16x8 vf; vf[0] = vlo[0]; vf[1] = vlo[1]; vf[2] = vlo[2]; vf[3] = vlo[3]; vf[4] = vhi[0]; vf[5] = vhi[1]; vf[6] = vhi[2]; vf[7] = vhi[3];
                    o[mm] = __builtin_amdgcn_mfma_f32_16x16x32_bf16(vf, pf, o[mm], 0, 0, 0); }
            }
        }
        lrun += __shfl_xor(lrun, 16); lrun += __shfl_xor(lrun, 32);
        const float inv = 1.f / lrun; const int tokq = (n * 128 + qi) * dil + rho; const size_t row = (size_t)b * SEQ + tokq;
        bf16_t* orow = POp + ((size_t)br * MTOK + row) * 512 + h * 64 + 4 * kq;
#pragma unroll
        for (int mm = 0; mm < 4; ++mm) { u32x2 w; w.x = pk2(o[mm][0] * inv, o[mm][1] * inv); w.y = pk2(o[mm][2] * inv, o[mm][3] * inv); *(u32x2*)(orow + 16 * mm) = w; }
        if (kq == 0) { PMp[((size_t)br * MTOK + row) * 8 + h] = mrun; PLp[((size_t)br * MTOK + row) * 8 + h] = lrun; }
        if (un < 0) break;
        u = un; ++ui;
    }
}

constexpr int S5_BUSP = 132, S5_HSP = 136;
constexpr int S5_WAVE_BYTES = 16 * S5_BUSP * 4 + 16 * S5_HSP * 2;
__device__ __forceinline__ void s5_unit(const bf16_t* Zp, const unsigned char* tab, const float* dskip, bf16_t* Y5p, LAS unsigned char* lds, int unit, int wave, int lane) {
    const int b = unit >> 2, g = (unit & 3) * 8 + wave;
    LAS float* bus = (LAS float*)(lds + wave * S5_WAVE_BYTES);
    LAS bf16_t* hs = (LAS bf16_t*)(lds + wave * S5_WAVE_BYTES + 16 * S5_BUSP * 4);
    const int n = lane & 15, kg = lane >> 4;
    const bf16_t* BMt = (const bf16_t*)(tab + S5_BM); const bf16_t* CMt = (const bf16_t*)(tab + S5_CM); const float* AB = (const float*)(tab + S5_ABAR);
    bf16x8 bm[8], cm[4];
#pragma unroll
    for (int nt = 0; nt < 8; ++nt) bm[nt] = *(const bf16x8*)(BMt + ((size_t)(g * 128 + 16 * nt + n)) * 32 + 8 * kg);
#pragma unroll
    for (int kk = 0; kk < 4; ++kk) cm[kk] = *(const bf16x8*)(CMt + ((size_t)(g * 16 + n)) * 128 + 32 * kk + 8 * kg);
    const float dsk = dskip[g * 16 + n];
    const float ar = AB[(g * 64 + lane) * 2], ai = AB[(g * 64 + lane) * 2 + 1];
    f32x2 hv = {0.f, 0.f}; const f32x2 a_rr = {ar, ar}, a_ii = {-ai, ai};
    const bf16_t* ub = Zp + (size_t)b * SEQ * 2048 + 1536 + g * 16;
    bf16_t* yb = Y5p + (size_t)b * SEQ * 512 + g * 16 + n;
    LAS bf16_t* uls = (LAS bf16_t*)(lds + 8 * S5_WAVE_BYTES + wave * 1024);
    bf16x8 q1[4], q2[4];
#pragma unroll
    for (int j = 0; j < 4; ++j) { q1[j] = (bf16x8){0, 0, 0, 0, 0, 0, 0, 0}; q2[j] = q1[j];
        if (kg < 2) { q1[j] = *(const bf16x8*)(ub + (size_t)(16 * j + n) * 2048 + 8 * kg); q2[j] = *(const bf16x8*)(ub + (size_t)(64 + 16 * j + n) * 2048 + 8 * kg); } }
    {
        const bf16x8 uf = q1[0];
        if (kg < 2) *(LAS bf16x8*)(uls + n * 32 + 8 * kg) = uf;
#pragma unroll
        for (int nt = 0; nt < 8; ++nt) { f32x4 d = {0.f, 0.f, 0.f, 0.f}; d = __builtin_amdgcn_mfma_f32_16x16x32_bf16(bm[nt], uf, d, 0, 0, 0);
            *(LAS f32x4*)(bus + n * S5_BUSP + 16 * nt + 4 * kg) = d; }
    }
    unsigned short usp[4] = {0, 0, 0, 0};
    for (int sb = 0; sb < SEQ / 64; ++sb) {
        bf16x8 ufc[4];
#pragma unroll
        for (int j = 0; j < 4; ++j) { ufc[j] = q1[j]; q1[j] = q2[j]; if (kg < 2 && sb + 2 < SEQ / 64) q2[j] = *(const bf16x8*)(ub + (size_t)((sb + 2) * 64 + 16 * j + n) * 2048 + 8 * kg); }
#pragma unroll
        for (int j = 0; j < 4; ++j) {
            asm volatile("" ::: "memory");
            const int k = 4 * sb + j;
            bf16x8 hf[4];
#pragma unroll
            for (int kk = 0; kk < 4; ++kk) hf[kk] = *(const LAS bf16x8*)(hs + n * S5_HSP + 32 * kk + 8 * kg);
            f32x2 bv[16];
#pragma unroll
            for (int t = 0; t < 16; ++t) bv[t] = *(const LAS f32x2*)(bus + t * S5_BUSP + 2 * lane);
            unsigned short usc[4];
#pragma unroll
            for (int i = 0; i < 4; ++i) usc[i] = uls[(4 * kg + i) * 32 + n];
            const bf16x8 ufn = (j < 3) ? ufc[(j + 1) & 3] : q1[0];
            f32x4 d[8];
#pragma unroll
            for (int nt = 0; nt < 8; ++nt) { d[nt] = (f32x4){0.f, 0.f, 0.f, 0.f}; d[nt] = __builtin_amdgcn_mfma_f32_16x16x32_bf16(bm[nt], ufn, d[nt], 0, 0, 0); }
            f32x4 y = {0.f, 0.f, 0.f, 0.f};
#pragma unroll
            for (int kk = 0; kk < 4; ++kk) y = __builtin_amdgcn_mfma_f32_16x16x32_bf16(hf[kk], cm[kk], y, 0, 0, 0);
#pragma unroll
            for (int t = 0; t < 16; ++t) { const f32x2 hsw = __builtin_shufflevector(hv, hv, 1, 0);
                hv = a_rr * hv + bv[t]; hv = a_ii * hsw + hv;
                *(LAS unsigned*)(hs + t * S5_HSP + 2 * lane) = pk2(hv.x, hv.y); }
#pragma unroll
            for (int nt = 0; nt < 8; ++nt) *(LAS f32x4*)(bus + n * S5_BUSP + 16 * nt + 4 * kg) = d[nt];
            if (kg < 2) *(LAS bf16x8*)(uls + n * 32 + 8 * kg) = ufn;
            if (k >= 1) {
#pragma unroll
                for (int i = 0; i < 4; ++i) { const int t = 16 * (k - 1) + 4 * kg + i; const float v = gelu_tanh(y[i] + dsk * bf2f(usp[i])); yb[(size_t)t * 512] = (bf16_t)f2bf(v); } }
#pragma unroll
            for (int i = 0; i < 4; ++i) usp[i] = usc[i];
        }
    }
    {
        asm volatile("" ::: "memory");
        f32x4 y = {0.f, 0.f, 0.f, 0.f};
#pragma unroll
        for (int kk = 0; kk < 4; ++kk) { const bf16x8 hf = *(const LAS bf16x8*)(hs + n * S5_HSP + 32 * kk + 8 * kg); y = __builtin_amdgcn_mfma_f32_16x16x32_bf16(hf, cm[kk], y, 0, 0, 0); }
#pragma unroll
        for (int i = 0; i < 4; ++i) { const int t = SEQ - 16 + 4 * kg + i; const float v = gelu_tanh(y[i] + dsk * bf2f(usp[i])); yb[(size_t)t * 512] = (bf16_t)f2bf(v); }
    }
    LDS_WAIT();
}

#define XB_TMO      128
#define XB_XCNT(j)  (256  + 64 * (j))
#define XB_XSUB(j)  (1280 + 64 * (j))
#define XB_XGEN(j)  (2304 + 64 * (j))
#define XB_TOP      3328
#define XB_TOPGEN   3392
#define XCD_BAR_WORDS 3456
#define XB_SPIN_CAP (1u << 22)
__device__ __forceinline__ unsigned xb_ld(unsigned* p)              { return __hip_atomic_load(p, __ATOMIC_RELAXED, __HIP_MEMORY_SCOPE_AGENT); }
__device__ __forceinline__ unsigned xb_add(unsigned* p, unsigned v) { return __hip_atomic_fetch_add(p, v, __ATOMIC_RELAXED, __HIP_MEMORY_SCOPE_AGENT); }
__device__ __forceinline__ unsigned xb_xcc_id() { return (unsigned)__builtin_amdgcn_s_getreg((3 << 11) | 20) & 0xFu; }
#define XB_SPIN(cond, bar) do { unsigned _sp = 0; while (cond) { __builtin_amdgcn_s_sleep(1); \
    if ((++_sp & 255u) == 0u) { if (xb_ld(&(bar)[XB_TMO])) break; if (_sp > XB_SPIN_CAP) { atomicAdd(&(bar)[XB_TMO], 1u); break; } } } } while (0)
__device__ __forceinline__ void xcd_barrier_complete(unsigned* bar, unsigned x, unsigned& nloc, unsigned& nx) {
    const unsigned G = gridDim.x * gridDim.y * gridDim.z;
    unsigned sum, cnt, mine, sp = 0u;
    for (;;) {
        sum = 0u; cnt = 0u; mine = 0u;
#pragma unroll
        for (unsigned j = 0; j < 16; ++j) { const unsigned c = xb_ld(&bar[XB_XCNT(j)]); sum += c; cnt += (c > 0u) ? 1u : 0u; mine = (j == x) ? c : mine; }
        if (sum == G) break;
        __builtin_amdgcn_s_sleep(1);
        if ((++sp & 255u) == 0u) { if (xb_ld(&bar[XB_TMO])) break; if (sp > XB_SPIN_CAP) { atomicAdd(&bar[XB_TMO], 1u); break; } }
    }
    nloc = mine > 0u ? mine : 1u; nx = cnt > 0u ? cnt : 1u;
}
__device__ __forceinline__ void xcd_barrier(unsigned* bar, volatile LAS unsigned* st) {
    asm volatile("s_waitcnt vmcnt(0)" ::: "memory");
    __syncthreads();
    if (threadIdx.x == 0) {
        const unsigned x = xb_xcc_id();
        __builtin_amdgcn_s_waitcnt(0);
        unsigned nloc = st[0], nx = st[1];
        if (nloc == 0u) { xcd_barrier_complete(bar, x, nloc, nx); st[0] = nloc; st[1] = nx; }
        const unsigned old = xb_add(&bar[XB_XSUB(x)], 1u);
        const unsigned gen = old / nloc;
        if (old + 1u == (gen + 1u) * nloc) {
            __builtin_amdgcn_fence(__ATOMIC_RELEASE, "agent");
            asm volatile("s_waitcnt vmcnt(0)" ::: "memory");
            const unsigned og = xb_add(&bar[XB_TOP], 1u);
            const unsigned tg = og / nx;
            if (og + 1u == (tg + 1u) * nx) xb_add(&bar[XB_TOPGEN], 1u);
            else XB_SPIN(xb_ld(&bar[XB_TOPGEN]) == tg, bar);
            __builtin_amdgcn_fence(__ATOMIC_ACQUIRE, "agent");
            xb_add(&bar[XB_XGEN(x)], 1u);
            asm volatile("s_waitcnt vmcnt(0)" ::: "memory");
        } else {
            XB_SPIN(xb_ld(&bar[XB_XGEN(x)]) == gen, bar);
            __builtin_amdgcn_fence(__ATOMIC_ACQUIRE, "agent");
            asm volatile("s_waitcnt vmcnt(0)" ::: "memory");
        }
    }
    __syncthreads();
}
constexpr int LDS_MISC = 135 * 1024;
constexpr size_t CTL_BYTES = 16384;

typedef const __attribute__((address_space(4))) Args* ArgsP;
__global__ void __launch_bounds__(NTHREADS, 2) mega(Args a_kern) {
    extern __shared__ __attribute__((aligned(16))) unsigned char lds_raw[];
    LAS unsigned char* lds = (LAS unsigned char*)lds_raw;
    cg::grid_group grid = cg::this_grid();
    ArgsP ap = (ArgsP)__builtin_amdgcn_kernarg_segment_ptr();
#define a (*ap)
#define ws (a.ws)
    int tid, lane, wave, gw, gt;
    const int G = gridDim.x, bx = blockIdx.x;
    const int NGW = G * NWAVES, NGT = G * NTHREADS;
#define RELOAD() do { asm volatile("" : "+s"(ap)); tid = threadIdx.x; asm volatile("" : "+v"(tid)); lane = tid & 63; wave = __builtin_amdgcn_readfirstlane(tid >> 6); gw = bx * NWAVES + wave; gt = bx * NTHREADS + tid; } while (0)
    RELOAD();
    if (a.ph_lo < 0) grid.sync();
    volatile LAS unsigned* bst = (volatile LAS unsigned*)(lds + LDS_MISC);
    if (tid == 0) { bst[0] = 0u; bst[1] = 0u; (void)xb_add((unsigned*)(ws + WS_CTL) + XB_XCNT(xb_xcc_id()), 1u); }
    __syncthreads();
#define x_in (a.in[0])
#define positions ((const int*)a.in[1])
#define g_mix_pre (a.in[2])
#define g_mix_post (a.in[3])
#define g_ffn_pre (a.in[4])
#define g_ffn_post (a.in[5])
#define HN ((bf16_t*)(ws + WS_HN))
#define RSTD ((float*)(ws + WS_CTL + 512 * 1024))
#define Z ((bf16_t*)(ws + WS_Z))
#define YC ((bf16_t*)(ws + WS_YC))
#define MIX ((bf16_t*)(ws + WS_MIX))
#define PO ((bf16_t*)(ws + WS_PO))
#define PM ((float*)(ws + WS_PM))
#define PL ((float*)(ws + WS_PL))
#define Y5 ((bf16_t*)(ws + WS_Y5))
#define HID ((bf16_t*)(ws + WS_HID))
#define XC ((bf16_t*)(ws + WS_XC))
#define BB ((bf16_t*)(ws + WS_BB))
#define Y1 ((bf16_t*)(ws + WS_Y1))
#define LA ((bf16_t*)(ws + WS_LA))
#define ROPE ((float*)(ws + WS_ROPE))
#define S5T (ws + WS_S5TAB)
#define SP ((float*)(ws + WS_S5TAB + S5_SP))
#define X (a.out)
#ifndef PHMASK
#define PHMASK 0xFFFFFFFFu
#endif
#define IN(k) (((PHMASK >> (k)) & 1u) && a.ph_lo <= (k) && (k) < a.ph_hi)
#ifndef REPMASK
#define REPMASK 0x0u
#endif
#define REPS(k) (1 + (int)((REPMASK >> (k)) & 1u))
#define REPSYNC do { if (rep) grid.sync(); } while (0)
#define SEAM(k) do { if (IN(k) && IN((k) + 1)) { xcd_barrier((unsigned*)(ws + WS_CTL), bst); } RELOAD(); } while (0)

    if (IN(0)) _Pragma("unroll") for (int rep = 0; rep < REPS(0); ++rep) {
        LAS float* scr = (LAS float*)(lds + wave * 8448);
        constexpr int I_IN = 16 * 64, I_OUT = 16 * 32, I_GLU = 8 * 16, I_GATE = 4 * 64, I_UP = 16 * 176, I_DN = 44 * 32;
        constexpr int NITEMS = 2 * I_IN + 2 * I_OUT + I_GLU + I_GATE + 2 * I_UP + 2 * I_DN;
        for (int it = gw; it < NITEMS; it += NGW) {
            int r = it;
            if (r < I_IN) { const int kb = r / 64, nb = r % 64; transpose_item(a.in[6] + nb * 32, 2048, 1024, (bf16_t*)(ws + WS_W_IN0) + (size_t)nb * 32 * 1024, kb * 64, scr, lane, g_mix_pre); continue; } r -= I_IN;
            if (r < I_IN) { const int kb = r / 64, nb = r % 64; transpose_item(a.in[17] + nb * 32, 2048, 1024, (bf16_t*)(ws + WS_W_IN1) + (size_t)nb * 32 * 1024, kb * 64, scr, lane, g_mix_pre + DM); continue; } r -= I_IN;
            if (r < I_OUT) { const int kb = r / 32, nb = r % 32; transpose_item(a.in[7] + nb * 32, 1024, 1024, (bf16_t*)(ws + WS_W_OUT0) + (size_t)nb * 32 * 1024, kb * 64, scr, lane); continue; } r -= I_OUT;
            if (r < I_OUT) { const int kb = r / 32, nb = r % 32; transpose_item(a.in[18] + nb * 32, 1024, 1024, (bf16_t*)(ws + WS_W_OUT1) + (size_t)nb * 32 * 1024, kb * 64, scr, lane); continue; } r -= I_OUT;
            if (r < I_GLU) { const int kb = r / 16, nb = r % 16; transpose_item(a.in[16] + nb * 32, 512, 512, (bf16_t*)(ws + WS_W_GLU) + (size_t)nb * 32 * 512, kb * 64, scr, lane); continue; } r -= I_GLU;
            if (r < I_GATE) { const int kb = r / 64, nb = r % 64; const int n0 = nb * 32, pn = n0 >> 8, half = (n0 >> 7) & 1, j = n0 & 127, hh = pn >> 1, colg = (pn & 1) * 128 + j;
                const float* src = (half ? a.in[23] : a.in[21]) + (size_t)hh * 256 * 256 + colg;
                transpose_item(src, 256, 256, (bf16_t*)(ws + WS_W_GATE) + (size_t)n0 * 256, kb * 64, scr, lane); continue; } r -= I_GATE;
            if (r < 2 * I_UP) { const int layer = r / I_UP; r -= layer * I_UP; const int kb = r / 176, nb = r % 176; const int n0 = nb * 32, t = n0 >> 8, half = (n0 >> 7) & 1, j = n0 & 127;
                const float* src = (half ? a.in[27] : a.in[26]) + (size_t)layer * 1024 * FFH + t * 128 + j;
                transpose_item(src, FFH, 1024, (bf16_t*)(ws + (layer ? WS_W_UP1 : WS_W_UP0)) + (size_t)n0 * 1024, kb * 64, scr, lane, g_ffn_pre + layer * DM); continue; } r -= 2 * I_UP;
            { const int layer = r / I_DN; r -= layer * I_DN; const int kb = r / 32, nb = r % 32;
                transpose_item(a.in[28] + (size_t)layer * FFH * 1024 + nb * 32, 1024, FFH, (bf16_t*)(ws + (layer ? WS_W_DN1 : WS_W_DN0)) + (size_t)nb * 32 * FFH, kb * 64, scr, lane); }
        }
        for (int idx = gt; idx < MTOK * 8; idx += NGT) { const int tok = idx >> 3, j = idx & 7; const float inv_freq = powf(500000.0f, -(float)j * 0.125f);
            const float ang = (float)positions[tok] * inv_freq; float s, c; sincos_rr(ang, s, c); ROPE[(size_t)tok * 16 + j] = c; ROPE[(size_t)tok * 16 + 8 + j] = s; }
        for (int idx = gt; idx < 32 * 64; idx += NGT) { const int g = idx >> 6, p = idx & 63;
            const float are = a.in[8][idx], aim = a.in[9][idx], dt = expf(a.in[10][g]);
            const float xr = are * dt, yi = aim * dt; const float ex = expf(xr); float sn, cs; sincos_rr(yi, sn, cs);
            const float abr = ex * cs, abi = ex * sn;
            float sh, ch; sincos_rr(0.5f * yi, sh, ch); (void)ch;
            const float nre = expm1f(xr) * cs - 2.f * sh * sh, nim = abi;
            const float den = 1.f / (are * are + aim * aim);
            const float cre = (nre * are + nim * aim) * den, cim = (nim * are - nre * aim) * den;
            float* AB = (float*)(S5T + S5_ABAR); AB[idx * 2] = abr; AB[idx * 2 + 1] = abi;
            bf16_t* BMt = (bf16_t*)(S5T + S5_BM); bf16_t* CMt = (bf16_t*)(S5T + S5_CM);
            for (int c = 0; c < 16; ++c) { const float bre = a.in[11][(size_t)idx * 16 + c], bim = a.in[12][(size_t)idx * 16 + c];
                BMt[((size_t)g * 128 + 2 * p) * 32 + c] = (bf16_t)f2bf(cre * bre - cim * bim); BMt[((size_t)g * 128 + 2 * p + 1) * 32 + c] = (bf16_t)f2bf(cre * bim + cim * bre);
                BMt[((size_t)g * 128 + 2 * p) * 32 + 16 + c] = 0; BMt[((size_t)g * 128 + 2 * p + 1) * 32 + 16 + c] = 0;
                CMt[((size_t)g * 16 + c) * 128 + 2 * p] = (bf16_t)f2bf(a.in[13][((size_t)g * 16 + c) * 64 + p]); CMt[((size_t)g * 16 + c) * 128 + 2 * p + 1] = (bf16_t)f2bf(-a.in[14][((size_t)g * 16 + c) * 64 + p]); } }
        for (int idx = gt; idx < 1024; idx += NGT) SP[idx] = log1pf(expf(-a.in[25][idx]));
        for (int m = gw; m + NGW < MTOK; m += 2 * NGW) rows_to_bf16_rstd<2>(x_in, HN, RSTD, m, NGW, lane);
    }
    SEAM(0);
    if (IN(1)) _Pragma("unroll") for (int rep = 0; rep < REPS(1); ++rep) { pg8::Gemm g{HN, (const bf16_t*)(ws + WS_W_IN0), MTOK, 2048, 1024, 1024, 0}; pg8::StaticOrder S; S.init(MTOK, 2048, G, bx);
        pg8::EpiRope E{Z, ROPE, RSTD}; pg8::gemm_phase(lds, g, S, E); }
    SEAM(1);
    if (IN(2)) _Pragma("unroll") for (int rep = 0; rep < REPS(2); ++rep) {
        if (bx < 128) s5_unit(Z, S5T, a.in[15], Y5, lds, bx, wave, lane);
        attn_phase(Z, PO, PM, PL, lds, bx, G, tid, wave, lane);
    }
    SEAM(2);
    if (IN(3)) _Pragma("unroll") for (int rep = 0; rep < REPS(3); ++rep) {
        for (int idx0 = gt; idx0 < MTOK * 64; idx0 += 4 * NGT) {
            float mv[4][3], lv[4][3]; u32x4 ow[4][3];
#pragma unroll
            for (int r = 0; r < 4; ++r) { const int idx = idx0 + r * NGT, row = idx >> 6, c8 = idx & 63, h = c8 >> 3;
#pragma unroll
                for (int i = 0; i < 3; ++i) { mv[r][i] = PM[((size_t)i * MTOK + row) * 8 + h]; lv[r][i] = PL[((size_t)i * MTOK + row) * 8 + h]; ow[r][i] = *(const u32x4*)(PO + ((size_t)i * MTOK + row) * 512 + c8 * 8); } }
#pragma unroll
            for (int r = 0; r < 4; ++r) { const int idx = idx0 + r * NGT, row = idx >> 6, c8 = idx & 63;
                const float mx = fmaxf(mv[r][0], fmaxf(mv[r][1], mv[r][2]));
                float w[3]; float den = 0.f;
#pragma unroll
                for (int i = 0; i < 3; ++i) { w[i] = fast_exp2(mv[r][i] - mx) * lv[r][i]; den += w[i]; }
                const float inv = 1.f / den; f32x4 v0 = {0.f, 0.f, 0.f, 0.f}, v1 = v0;
#pragma unroll
                for (int i = 0; i < 3; ++i) { const float ww = w[i] * inv;
                    v0[0] += ww * bflo(ow[r][i].x); v0[1] += ww * bfhi(ow[r][i].x); v0[2] += ww * bflo(ow[r][i].y); v0[3] += ww * bfhi(ow[r][i].y);
                    v1[0] += ww * bflo(ow[r][i].z); v1[1] += ww * bfhi(ow[r][i].z); v1[2] += ww * bflo(ow[r][i].w); v1[3] += ww * bfhi(ow[r][i].w); }
                pg8::st8(YC + (size_t)row * 1024 + c8 * 8, v0, v1); } }
        __syncthreads();
        pg8::Gemm g{Y5, (const bf16_t*)(ws + WS_W_GLU), MTOK, 512, 512, 512, 0}; pg8::StaticOrder S; S.init(MTOK, 512, G, bx);
        pg8::EpiGlu E{Y5, YC}; pg8::gemm_phase(lds, g, S, E);
    }
    SEAM(3);
    if (IN(4)) _Pragma("unroll") for (int rep = 0; rep < REPS(4); ++rep) { pg8::Gemm g{YC, (const bf16_t*)(ws + WS_W_OUT0), MTOK, 1024, 1024, 1024, 0}; pg8::StaticOrder S; S.init(MTOK, 1024, G, bx);
        pg8::EpiPlain E{MIX, 1024}; pg8::gemm_phase(lds, g, S, E); }
    SEAM(4);
    if (IN(5)) _Pragma("unroll") for (int rep = 0; rep < REPS(5); ++rep) resnorm_phase<true, false>(x_in, MIX, g_mix_post, HN, RSTD, gw, NGW, lane);
    SEAM(5);
    if (IN(6)) _Pragma("unroll") for (int rep = 0; rep < REPS(6); ++rep) { pg8::Gemm g{HN, (const bf16_t*)(ws + WS_W_UP0), MTOK, 2 * FFH, 1024, 1024, 0}; pg8::StaticOrder S; S.init(MTOK, 2 * FFH, G, bx);
        pg8::EpiSwiGlu E{HID, RSTD}; pg8::gemm_phase(lds, g, S, E); }
    SEAM(6);
    if (IN(7)) _Pragma("unroll") for (int rep = 0; rep < REPS(7); ++rep) { pg8::Gemm g{HID, (const bf16_t*)(ws + WS_W_DN0), MTOK, 1024, FFH, FFH, 0}; pg8::StaticOrder S; S.init(MTOK, 1024, G, bx);
        pg8::EpiPlain E{MIX, 1024}; pg8::gemm_phase(lds, g, S, E); }
    SEAM(7);
    if (IN(8)) _Pragma("unroll") for (int rep = 0; rep < REPS(8); ++rep) resnorm_phase<false, false>(HN, MIX, g_ffn_post, HN, RSTD, gw, NGW, lane);
    SEAM(8);
    if (IN(9)) _Pragma("unroll") for (int rep = 0; rep < REPS(9); ++rep) { pg8::Gemm g{HN, (const bf16_t*)(ws + WS_W_IN1), MTOK, 2048, 1024, 1024, 0}; pg8::StaticOrder S; S.init(MTOK, 2048, G, bx);
        pg8::EpiIn1 E{Z, RSTD}; pg8::gemm_phase(lds, g, S, E); }
    SEAM(9);
    if (IN(10)) _Pragma("unroll") for (int rep = 0; rep < REPS(10); ++rep) {
        const float* cw = a.in[19]; const float* cb = a.in[20];
        for (int idx = gt; idx < (MTOK / 8) * 128; idx += NGT) { const int c8 = idx & 127, tb = idx >> 7, row0 = tb * 8, c0 = c8 * 8; const int t0 = row0 & (SEQ - 1);
            float w[4][8], bias[8];
#pragma unroll
            for (int k = 0; k < 4; ++k) { const f32x4 wa = *(const f32x4*)(cw + k * 1024 + c0), wb = *(const f32x4*)(cw + k * 1024 + c0 + 4);
                w[k][0] = wa.x; w[k][1] = wa.y; w[k][2] = wa.z; w[k][3] = wa.w; w[k][4] = wb.x; w[k][5] = wb.y; w[k][6] = wb.z; w[k][7] = wb.w; }
            { const f32x4 ba = *(const f32x4*)(cb + c0), bb = *(const f32x4*)(cb + c0 + 4); bias[0] = ba.x; bias[1] = ba.y; bias[2] = ba.z; bias[3] = ba.w; bias[4] = bb.x; bias[5] = bb.y; bias[6] = bb.z; bias[7] = bb.w; }
            float xm[3][8];
#pragma unroll
            for (int k = 0; k < 3; ++k) { u32x4 v = {0u, 0u, 0u, 0u}; if (t0 - 3 + k >= 0) v = *(const u32x4*)(Z + (size_t)(row0 - 3 + k) * 2048 + c0);
                xm[k][0] = bflo(v.x); xm[k][1] = bfhi(v.x); xm[k][2] = bflo(v.y); xm[k][3] = bfhi(v.y); xm[k][4] = bflo(v.z); xm[k][5] = bfhi(v.z); xm[k][6] = bflo(v.w); xm[k][7] = bfhi(v.w); }
#pragma unroll
            for (int r = 0; r < 8; ++r) { const u32x4 v = *(const u32x4*)(Z + (size_t)(row0 + r) * 2048 + c0);
                const float xc[8] = {bflo(v.x), bfhi(v.x), bflo(v.y), bfhi(v.y), bflo(v.z), bfhi(v.z), bflo(v.w), bfhi(v.w)};
                f32x4 o0, o1;
#pragma unroll
                for (int i = 0; i < 8; ++i) { const float o = bias[i] + w[0][i] * xm[0][i] + w[1][i] * xm[1][i] + w[2][i] * xm[2][i] + w[3][i] * xc[i];
                    if (i < 4) o0[i] = o; else o1[i - 4] = o; xm[0][i] = xm[1][i]; xm[1][i] = xm[2][i]; xm[2][i] = xc[i]; }
                pg8::st8(XC + (size_t)(row0 + r) * 1024 + c0, o0, o1); } }
    }
    SEAM(10);
    if (IN(11)) _Pragma("unroll") for (int rep = 0; rep < REPS(11); ++rep) { pg8::Gemm g{XC, (const bf16_t*)(ws + WS_W_GATE), MTOK, 2048, 256, 1024, 1}; pg8::StaticOrder S; S.init(MTOK, 2048, G, bx);
        pg8::EpiGates E{XC, LA, BB, a.in[22], a.in[24], SP}; pg8::gemm_phase(lds, g, S, E); }
    SEAM(11);
    if (IN(12)) _Pragma("unroll") for (int rep = 0; rep < REPS(12); ++rep) {
        LAS float* car = (LAS float*)lds;
        for (int u = bx; u < 256; u += G) { const int b = u >> 3, c0 = (u & 7) * 128 + 2 * lane;
            float cin0 = 0.f, cin1 = 0.f;
            for (int r = 0; r < 8; ++r) { const size_t rbase = (size_t)b * SEQ + r * 256 + wave * 32;
                const bf16_t* la = LA + rbase * 1024 + c0; const bf16_t* bb = BB + rbase * 1024 + c0; const bf16_t* gb = Z + rbase * 2048 + 1024 + c0; bf16_t* yo = Y1 + rbase * 1024 + c0;
                unsigned lq[32], bq[32], gq[32];
#pragma unroll
                for (int i = 0; i < 32; ++i) { lq[i] = *(const unsigned*)(la + (size_t)i * 1024); bq[i] = *(const unsigned*)(bb + (size_t)i * 1024); }
#pragma unroll
                for (int i = 0; i < 32; ++i) gq[i] = *(const unsigned*)(gb + (size_t)i * 2048);
                float h0 = 0.f, h1 = 0.f, s0 = 0.f, s1 = 0.f;
#pragma unroll
                for (int i = 0; i < 32; ++i) { const float l0 = bflo(lq[i]), l1 = bfhi(lq[i]); s0 += l0; s1 += l1;
                    h0 = fast_exp2(l0 * LOG2E) * h0 + bflo(bq[i]); h1 = fast_exp2(l1 * LOG2E) * h1 + bfhi(bq[i]); }
                __syncthreads();
                *(LAS f32x4*)(car + (wave * 64 + lane) * 4) = (f32x4){fast_exp2(s0 * LOG2E), fast_exp2(s1 * LOG2E), h0, h1};
                __syncthreads();
                h0 = cin0; h1 = cin1; float e0 = cin0, e1 = cin1;
#pragma unroll
                for (int j = 0; j < 8; ++j) { const f32x4 cv = *(const LAS f32x4*)(car + (j * 64 + lane) * 4);
                    if (j < wave) { h0 = cv.x * h0 + cv.z; h1 = cv.y * h1 + cv.w; }
                    e0 = cv.x * e0 + cv.z; e1 = cv.y * e1 + cv.w; }
                cin0 = e0; cin1 = e1;
#pragma unroll
                for (int i = 0; i < 32; ++i) { h0 = fast_exp2(bflo(lq[i]) * LOG2E) * h0 + bflo(bq[i]); h1 = fast_exp2(bfhi(lq[i]) * LOG2E) * h1 + bfhi(bq[i]);
                    *(unsigned*)(yo + (size_t)i * 1024) = pk2(h0 * bflo(gq[i]), h1 * bfhi(gq[i])); }
            }
        }
    }
    SEAM(12);
    if (IN(13)) _Pragma("unroll") for (int rep = 0; rep < REPS(13); ++rep) { pg8::Gemm g{Y1, (const bf16_t*)(ws + WS_W_OUT1), MTOK, 1024, 1024, 1024, 0}; pg8::StaticOrder S; S.init(MTOK, 1024, G, bx);
        pg8::EpiPlain E{MIX, 1024}; pg8::gemm_phase(lds, g, S, E); }
    SEAM(13);
    if (IN(14)) _Pragma("unroll") for (int rep = 0; rep < REPS(14); ++rep) resnorm_phase<false, false>(HN, MIX, g_mix_post + DM, HN, RSTD, gw, NGW, lane);
    SEAM(14);
    if (IN(15)) _Pragma("unroll") for (int rep = 0; rep < REPS(15); ++rep) { pg8::Gemm g{HN, (const bf16_t*)(ws + WS_W_UP1), MTOK, 2 * FFH, 1024, 1024, 0}; pg8::StaticOrder S; S.init(MTOK, 2 * FFH, G, bx);
        pg8::EpiSwiGlu E{HID, RSTD}; pg8::gemm_phase(lds, g, S, E); }
    SEAM(15);
    if (IN(16)) _Pragma("unroll") for (int rep = 0; rep < REPS(16); ++rep) { pg8::Gemm g{HID, (const bf16_t*)(ws + WS_W_DN1), MTOK, 1024, FFH, FFH, 0}; pg8::StaticOrder S; S.init(MTOK, 1024, G, bx);
        pg8::EpiPlain E{MIX, 1024}; pg8::gemm_phase(lds, g, S, E); }
    SEAM(16);
    if (IN(17)) _Pragma("unroll") for (int rep = 0; rep < REPS(17); ++rep) resnorm_phase<false, true>(HN, MIX, g_ffn_post + DM, X, nullptr, gw, NGW, lane);
#undef IN
#undef SEAM
#undef a
#undef ws
}
constexpr int NPHASES = 18;

extern "C" void kernel_launch(void* const* d_in, const int* in_sizes, int n_in, void* d_out, int out_size, void* d_ws, size_t ws_size, hipStream_t stream) {
    static int grid = 0;
    if (grid == 0) {
        if (n_in != 29 || in_sizes[0] != MTOK * DM || out_size != MTOK * DM || ws_size < WS_END) {
            fprintf(stderr, "kernel_launch: unexpected shapes: n_in %d in0 %d out %d ws %zu (need %zu)\n", n_in, n_in > 0 ? in_sizes[0] : -1, out_size, ws_size, (size_t)WS_END); grid = -1; return; }
        int dev = 0, cus = 0, per_cu = 0;
        hipGetDevice(&dev); hipDeviceGetAttribute(&cus, hipDeviceAttributeMultiprocessorCount, dev);
        if (hipFuncSetAttribute((const void*)mega, hipFuncAttributeMaxDynamicSharedMemorySize, LDS_BYTES) != hipSuccess) { fprintf(stderr, "kernel_launch: hipFuncSetAttribute failed\n"); grid = -1; return; }
        if (hipOccupancyMaxActiveBlocksPerMultiprocessor(&per_cu, (const void*)mega, NTHREADS, LDS_BYTES) != hipSuccess || per_cu < 1) { fprintf(stderr, "kernel_launch: occupancy query says %d\n", per_cu); per_cu = 1; }
        (void)hipGetLastError();
        grid = cus;
    }
    if (grid < 0) return;
    if (hipMemsetAsync((char*)d_ws + WS_CTL, 0, CTL_BYTES, stream) != hipSuccess) { fprintf(stderr, "kernel_launch: memset failed\n"); return; }
    Args a{};
    for (int i = 0; i < 29; ++i) a.in[i] = (const float*)d_in[i];
    a.out = (float*)d_out; a.ws = (unsigned char*)d_ws;
#if N_LAUNCH_MODE == 1
    a.ph_lo = 0; a.ph_hi = NPHASES;
    void* args[] = {&a};
    hipError_t e = hipLaunchCooperativeKernel((const void*)mega, dim3(grid), dim3(NTHREADS), args, LDS_BYTES, stream);
    if (e != hipSuccess) fprintf(stderr, "cooperative launch failed: %s (grid %d)\n", hipGetErrorString(e), grid);
#else
    for (int ph = 0; ph < NPHASES; ++ph) { a.ph_lo = ph; a.ph_hi = ph + 1; hipLaunchKernelGGL(mega, dim3(grid), dim3(NTHREADS), LDS_BYTES, stream, a); }
#endif
}
```

```cpp
#include <hip/hip_runtime.h>
#include <hip/hip_cooperative_groups.h>
#include <cstdio>
#include <cstdint>
namespace cg = cooperative_groups;

#ifndef N_LAUNCH_MODE
#define N_LAUNCH_MODE 1
#endif

#define LAS __attribute__((address_space(3)))
typedef unsigned short bf16_t;
typedef short bf16x8 __attribute__((ext_vector_type(8)));
typedef float f32x4 __attribute__((ext_vector_type(4)));
typedef unsigned u32x4 __attribute__((ext_vector_type(4)));
typedef unsigned u32x2 __attribute__((ext_vector_type(2)));
typedef float f32x2 __attribute__((ext_vector_type(2)));

constexpr int MTOK = 65536, DM = 1024, SEQ = 2048, NBATCH = 32, FFH = 2816;
constexpr float NORM_EPS = 1e-6f;
constexpr float LOG2E = 1.4426950408889634f;
constexpr int NWAVES = 8, NTHREADS = 512;
constexpr int LDS_BYTES = 136 * 1024;

constexpr size_t MiB = 1u << 20;
constexpr size_t WS_CTL = 0;
constexpr size_t WS_W_IN0 = 1 * MiB, WS_W_OUT0 = 5 * MiB, WS_W_GLU = 7 * MiB, WS_W_IN1 = 8 * MiB, WS_W_OUT1 = 12 * MiB, WS_W_GATE = 14 * MiB;
constexpr size_t WS_W_UP0 = 15 * MiB, WS_W_UP1 = 26 * MiB, WS_W_DN0 = 37 * MiB, WS_W_DN1 = 43 * MiB;
constexpr size_t WS_ROPE = 49 * MiB;
constexpr size_t WS_S5TAB = 53 * MiB;
constexpr size_t S5_ABAR = 0, S5_BM = 16384, S5_CM = 16384 + 262144, S5_SP = 16384 + 262144 + 131072;
constexpr size_t WS_HN = 64 * MiB, WS_Z = 192 * MiB, WS_YC = 448 * MiB, WS_MIX = 576 * MiB, WS_PO = 704 * MiB, WS_PM = 896 * MiB, WS_PL = 902 * MiB, WS_Y5 = 908 * MiB;
constexpr size_t WS_HID = 192 * MiB;
constexpr size_t WS_XC = 448 * MiB, WS_BB = 576 * MiB, WS_Y1 = 704 * MiB, WS_LA = 832 * MiB;
constexpr size_t WS_END = 972 * MiB;

struct Args { const float* in[29]; float* out; unsigned char* ws; int ph_lo, ph_hi; };

__device__ __forceinline__ unsigned f2bf(float f) { unsigned u = __builtin_bit_cast(unsigned, f); return (u + 0x7fffu + ((u >> 16) & 1u)) >> 16; }
__device__ __forceinline__ unsigned pk2(float lo, float hi) { unsigned r; asm("v_cvt_pk_bf16_f32 %0, %1, %2" : "=v"(r) : "v"(lo), "v"(hi)); return r; }
__device__ __forceinline__ float bf2f(unsigned short h) { return __builtin_bit_cast(float, (unsigned)h << 16); }
__device__ __forceinline__ float bflo(unsigned w) { return __builtin_bit_cast(float, w << 16); }
__device__ __forceinline__ float bfhi(unsigned w) { return __builtin_bit_cast(float, w & 0xffff0000u); }
__device__ __forceinline__ float fast_exp2(float x) { return __builtin_amdgcn_exp2f(x); }
__device__ __forceinline__ float fast_rcp(float x) { return __builtin_amdgcn_rcpf(x); }
__device__ __forceinline__ float sigmoidf_(float x) { return fast_rcp(1.f + fast_exp2(-x * LOG2E)); }
__device__ __forceinline__ float gelu_tanh(float x) { const float u = 0.7978845608028654f * (x + 0.044715f * x * x * x); return x * sigmoidf_(2.f * u); }
__device__ __forceinline__ float wave_sum(float v) {
#pragma unroll
    for (int o = 1; o < 64; o <<= 1) v += __shfl_xor(v, o);
    return v;
}
#define LDS_WAIT() asm volatile("s_waitcnt lgkmcnt(0)" ::: "memory")

namespace pg8 {
constexpr int BM = 256, BK = 64, HALF = 128, HTB = HALF * BK * 2, STAGE_BYTES = 8 * HTB, NXCD = 8, WGM = 8;
__host__ __device__ __forceinline__ int lds_byte(int r, int c) { const int st = (r >> 4) * 2 + (c >> 5), rr = r & 15, cc = c & 31, ob = rr * 64 + cc * 2; return st * 1024 + (ob ^ (((ob >> 9) & 1) << 5)); }
__host__ __device__ __forceinline__ void stage_rc(int b, int& R, int& C) { const int st = b / 1024, sb = b % 1024, swz = sb ^ (((sb >> 9) & 1) << 5); R = (st >> 1) * 16 + swz / 64; C = (st & 1) * 32 + (swz % 64) / 2; }
__host__ __device__ __forceinline__ int perm32(int rho) { const int n = rho >> 4, i = rho & 15; return 8 * (i >> 2) + 4 * n + (i & 3); }
struct Unit { int pm, pn; };
struct Gemm { const bf16_t* A; const bf16_t* Bt; int M, N, K, lda, grp; };
struct StaticOrder {
    int nM, nN, nwg, G, c;
    __host__ __device__ void init(int M, int N, int G_, int c_) { nM = M / BM; nN = N / BM; nwg = nM * nN; G = G_; c = c_; }
    __host__ __device__ bool next(int i, Unit& u) const {
        const long L = (long)i * G + c; if (L >= nwg) return false;
        int wgid = (int)L; { const int q = nwg / NXCD, r = nwg % NXCD, xcd = wgid % NXCD, off = wgid / NXCD; wgid = (xcd < r ? xcd * (q + 1) : r * (q + 1) + (xcd - r) * q) + off; }
        const int nig = WGM * nN, gid = wgid / nig, fm = gid * WGM, gsz = (nM - fm) < WGM ? (nM - fm) : WGM;
        u.pm = fm + ((wgid % nig) % gsz); u.pn = (wgid % nig) / gsz; return true;
    }
};
template <class Epi>
__device__ __forceinline__ void gemm_phase(LAS unsigned char* lds, const Gemm g, const StaticOrder& S, const Epi& E) {
    int tid_ = threadIdx.x; asm volatile("" : "+v"(tid_));
    const int tid = tid_, wid = __builtin_amdgcn_readfirstlane(tid >> 6), lane = tid & 63, wr = wid >> 2, wc = wid & 3, fr = lane & 15, fq = lane >> 4;
    const int K = g.K, nt = K / BK, lda = g.lda;
    unsigned voffA[2], voffB[2];
#pragma unroll
    for (int i = 0; i < 2; ++i) { int R, C; stage_rc(tid * 16 + i * 8192, R, C); const int Rb = (R & ~31) + perm32(R & 31);
        voffA[i] = (unsigned)(R * lda + C) * 2u; voffB[i] = (unsigned)(Rb * K + C) * 2u; }
    const size_t kstep = (size_t)(BK * 2);
    const size_t hstepA = (size_t)HALF * lda * 2, hstepB = (size_t)HALF * K * 2;
    const size_t tstepA = 2 * hstepA, tstepB = 2 * hstepB;
    const unsigned ldsw = (unsigned)wid * 1024u;
    const int aoff = lds_byte(wr * 64 + fr, fq * 8), boff = lds_byte(wc * 32 + fr, fq * 8);
#define PG8_SA(b, h) (((b) * 2 + (h)) * HTB)
#define PG8_SB(b, h) ((4 + (b) * 2 + (h)) * HTB)
#define PG8_STAGE(bufoff, gbase, voff) do { _Pragma("unroll") for (int _i = 0; _i < 2; ++_i) \
        __builtin_amdgcn_global_load_lds((const unsigned*)((const char*)(gbase) + (voff)[_i]), (LAS unsigned*)(lds + (bufoff) + ldsw + _i * 8192), 16, 0, 0); } while (0)
#define PG8_LDA(dst, b, h) do { _Pragma("unroll") for (int m = 0; m < 4; ++m) _Pragma("unroll") for (int k = 0; k < 2; ++k) dst[m][k] = *(const LAS bf16x8*)(lds + PG8_SA(b, h) + aoff + m * 2048 + k * 1024); } while (0)
#define PG8_LDB(dst, b, h) do { _Pragma("unroll") for (int n = 0; n < 2; ++n) _Pragma("unroll") for (int k = 0; k < 2; ++k) dst[n][k] = *(const LAS bf16x8*)(lds + PG8_SB(b, h) + boff + n * 2048 + k * 1024); } while (0)
#define PG8_MMA(ai, bj, At, Bt) do { __builtin_amdgcn_s_setprio(1); _Pragma("unroll") for (int m = 0; m < 4; ++m) _Pragma("unroll") for (int n = 0; n < 2; ++n) _Pragma("unroll") for (int k = 0; k < 2; ++k) \
        acc[ai][bj][m][n] = __builtin_amdgcn_mfma_f32_16x16x32_bf16(Bt[n][k], At[m][k], acc[ai][bj][m][n], 0, 0, 0); __builtin_amdgcn_s_setprio(0); } while (0)
#define PG8_WAIT_V(n) asm volatile("s_waitcnt vmcnt(" #n ")" ::: "memory")
#define PG8_WAIT_L(n) asm volatile("s_waitcnt lgkmcnt(" #n ")" ::: "memory")
#define PG8_BAR __builtin_amdgcn_s_barrier()
#define PG8_SCHED __builtin_amdgcn_sched_barrier(0)
    Unit cur, nxt; int ui = 0;
    if (!S.next(0, cur)) return;
    f32x4 acc[2][2][4][2];
#pragma unroll
    for (int a = 0; a < 2; ++a)
#pragma unroll
        for (int b = 0; b < 2; ++b)
#pragma unroll
            for (int m = 0; m < 4; ++m)
#pragma unroll
                for (int n = 0; n < 2; ++n) acc[a][b][m][n] = (f32x4){0.f, 0.f, 0.f, 0.f};
    bf16x8 At[4][2], B0[2][2], B1[2][2];
    const char* cA = (const char*)g.A + (size_t)cur.pm * tstepA + (g.grp ? (size_t)(cur.pn >> 1) * K * 2 : 0); const char* cB = (const char*)g.Bt + (size_t)cur.pn * tstepB;
    PG8_STAGE(PG8_SB(0, 0), cB, voffB); PG8_STAGE(PG8_SB(0, 1), cB + hstepB, voffB); PG8_STAGE(PG8_SA(0, 0), cA, voffA); PG8_STAGE(PG8_SA(0, 1), cA + hstepA, voffA);
    if (wr == 1) PG8_BAR;
    PG8_WAIT_V(2); PG8_BAR;
    PG8_STAGE(PG8_SB(1, 0), cB + kstep, voffB); PG8_STAGE(PG8_SA(1, 0), cA + kstep, voffA); PG8_STAGE(PG8_SB(1, 1), cB + hstepB + kstep, voffB);
    PG8_WAIT_V(6); PG8_BAR;
    for (;;) {
        const bool has_next = S.next(ui + 1, nxt);
        const char* nA = has_next ? (const char*)g.A + (size_t)nxt.pm * tstepA + (g.grp ? (size_t)(nxt.pn >> 1) * K * 2 : 0) : cA; const char* nB = has_next ? (const char*)g.Bt + (size_t)nxt.pn * tstepB : cB;
        for (int t = 0; t < nt; t += 2) {
            const bool last = (t == nt - 2);
            const char* a1 = cA + (size_t)(t + 1) * kstep;
            const char* a2 = last ? nA : cA + (size_t)(t + 2) * kstep; const char* b2 = last ? nB : cB + (size_t)(t + 2) * kstep;
            const char* a3 = a2 + kstep; const char* b3 = b2 + kstep;
            PG8_LDB(B0, 0, 0); PG8_LDB(B1, 0, 1); PG8_SCHED; PG8_LDA(At, 0, 0); PG8_STAGE(PG8_SA(1, 1), a1 + hstepA, voffA);
            PG8_WAIT_V(8); PG8_WAIT_L(0); PG8_BAR; PG8_MMA(0, 0, At, B0); PG8_MMA(0, 1, At, B1); PG8_BAR; PG8_SCHED;
            PG8_LDA(At, 0, 1); PG8_STAGE(PG8_SB(0, 0), b2, voffB); PG8_STAGE(PG8_SB(0, 1), b2 + hstepB, voffB); PG8_STAGE(PG8_SA(0, 0), a2, voffA);
            PG8_WAIT_V(8); PG8_WAIT_L(0); PG8_BAR; PG8_MMA(1, 0, At, B0); PG8_MMA(1, 1, At, B1); PG8_BAR; PG8_SCHED;
            PG8_LDB(B0, 1, 0); PG8_LDB(B1, 1, 1); PG8_SCHED; PG8_LDA(At, 1, 0); PG8_STAGE(PG8_SA(0, 1), a2 + hstepA, voffA);
            PG8_WAIT_V(8); PG8_WAIT_L(0); PG8_BAR; PG8_MMA(0, 0, At, B0); PG8_MMA(0, 1, At, B1); PG8_BAR; PG8_SCHED;
            PG8_LDA(At, 1, 1); PG8_STAGE(PG8_SB(1, 0), b3, voffB); PG8_STAGE(PG8_SB(1, 1), b3 + hstepB, voffB); PG8_STAGE(PG8_SA(1, 0), a3, voffA);
            PG8_WAIT_V(8); PG8_WAIT_L(0); PG8_BAR; PG8_MMA(1, 0, At, B0); PG8_MMA(1, 1, At, B1); PG8_BAR; PG8_SCHED;
        }
        if (wr == 0) PG8_BAR;
        E(acc, cur, wr, wc, fr, fq);
        if (!has_next) break;
#pragma unroll
        for (int a = 0; a < 2; ++a)
#pragma unroll
            for (int b = 0; b < 2; ++b)
#pragma unroll
                for (int m = 0; m < 4; ++m)
#pragma unroll
                    for (int n = 0; n < 2; ++n) acc[a][b][m][n] = (f32x4){0.f, 0.f, 0.f, 0.f};
        cur = nxt; cA = nA; cB = nB; ++ui;
        if (wr == 1) PG8_BAR;
    }
    PG8_WAIT_V(0);
    PG8_BAR;
#undef PG8_SA
#undef PG8_SB
#undef PG8_STAGE
#undef PG8_LDA
#undef PG8_LDB
#undef PG8_MMA
#undef PG8_WAIT_V
#undef PG8_WAIT_L
#undef PG8_BAR
#undef PG8_SCHED
}
typedef f32x4 AccT[2][2][4][2];

__device__ __forceinline__ void st8(bf16_t* p, f32x4 v0, f32x4 v1) {
    u32x4 w; w.x = pk2(v0[0], v0[1]); w.y = pk2(v0[2], v0[3]); w.z = pk2(v1[0], v1[1]); w.w = pk2(v1[2], v1[3]); *(u32x4*)p = w;
}
struct EpiPlain {
    bf16_t* O; int ldc;
    __device__ __forceinline__ void operator()(const AccT& acc, const Unit& u, int wr, int wc, int fr, int fq) const {
        const int row0 = u.pm * BM + wr * 64 + fr, col0 = u.pn * BM + wc * 32 + 8 * fq;
#pragma unroll
        for (int ai = 0; ai < 2; ++ai)
#pragma unroll
            for (int m = 0; m < 4; ++m) { bf16_t* rowp = O + (size_t)(row0 + ai * HALF + m * 16) * ldc + col0;
#pragma unroll
                for (int bj = 0; bj < 2; ++bj) st8(rowp + bj * HALF, acc[ai][bj][m][0], acc[ai][bj][m][1]); }
    }
};
struct EpiRope {
    bf16_t* Z; const float* rope; const float* rstd;
    __device__ __forceinline__ void operator()(const AccT& acc, const Unit& u, int wr, int wc, int fr, int fq) const {
        const int row0 = u.pm * BM + wr * 64 + fr, col0 = u.pn * BM + wc * 32 + 8 * fq;
        const bool ropew = (u.pn < 4) && !(wc & 1); const float sc = (u.pn < 2) ? 0.125f * LOG2E : 1.f;
#pragma unroll
        for (int ai = 0; ai < 2; ++ai)
#pragma unroll
            for (int m = 0; m < 4; ++m) { const int row = row0 + ai * HALF + m * 16; bf16_t* rowp = Z + (size_t)row * 2048 + col0;
                f32x4 c0 = {1.f, 1.f, 1.f, 1.f}, c1 = c0, s0 = {0.f, 0.f, 0.f, 0.f}, s1 = s0;
                if (ropew && fq < 2) { const f32x4* rp = (const f32x4*)(rope + (size_t)row * 16); c0 = rp[0]; c1 = rp[1]; s0 = rp[2]; s1 = rp[3]; if (fq == 0) { s0 = -s0; s1 = -s1; } }
                const float rs = rstd[row] * sc;
#pragma unroll
                for (int bj = 0; bj < 2; ++bj) { f32x4 v0 = acc[ai][bj][m][0] * rs, v1 = acc[ai][bj][m][1] * rs;
                    if (ropew) { f32x4 p0, p1;
#pragma unroll
                        for (int i = 0; i < 4; ++i) { p0[i] = __shfl_xor(v0[i], 16); p1[i] = __shfl_xor(v1[i], 16); }
                        v0 = v0 * c0 + p0 * s0; v1 = v1 * c1 + p1 * s1; }
                    st8(rowp + bj * HALF, v0, v1); } }
    }
};
struct EpiGlu {
    const bf16_t* Y; bf16_t* O;
    __device__ __forceinline__ void operator()(const AccT& acc, const Unit& u, int wr, int wc, int fr, int fq) const {
        const int row0 = u.pm * BM + wr * 64 + fr, col0 = u.pn * BM + wc * 32 + 8 * fq;
#pragma unroll
        for (int ai = 0; ai < 2; ++ai)
#pragma unroll
            for (int m = 0; m < 4; ++m) { const int row = row0 + ai * HALF + m * 16;
#pragma unroll
                for (int bj = 0; bj < 2; ++bj) { const int col = col0 + bj * HALF; const u32x4 yw = *(const u32x4*)(Y + (size_t)row * 512 + col);
                    f32x4 a0 = acc[ai][bj][m][0], a1 = acc[ai][bj][m][1], v0, v1;
                    v0[0] = bflo(yw.x) * sigmoidf_(a0[0]); v0[1] = bfhi(yw.x) * sigmoidf_(a0[1]); v0[2] = bflo(yw.y) * sigmoidf_(a0[2]); v0[3] = bfhi(yw.y) * sigmoidf_(a0[3]);
                    v1[0] = bflo(yw.z) * sigmoidf_(a1[0]); v1[1] = bfhi(yw.z) * sigmoidf_(a1[1]); v1[2] = bflo(yw.w) * sigmoidf_(a1[2]); v1[3] = bfhi(yw.w) * sigmoidf_(a1[3]);
                    st8(O + (size_t)row * 1024 + 512 + col, v0, v1); } }
    }
};
struct EpiSwiGlu {
    bf16_t* O; const float* rstd;
    __device__ __forceinline__ void operator()(const AccT& acc, const Unit& u, int wr, int wc, int fr, int fq) const {
        const int row0 = u.pm * BM + wr * 64 + fr, col0 = u.pn * HALF + wc * 32 + 8 * fq;
#pragma unroll
        for (int ai = 0; ai < 2; ++ai)
#pragma unroll
            for (int m = 0; m < 4; ++m) { const int row = row0 + ai * HALF + m * 16; f32x4 v[2]; const float rs = rstd[row], rs2 = rs * rs, rsl = -rs * LOG2E;
#pragma unroll
                for (int n = 0; n < 2; ++n)
#pragma unroll
                    for (int i = 0; i < 4; ++i) { const float g0 = acc[ai][0][m][n][i], u0 = acc[ai][1][m][n][i];
                        v[n][i] = (g0 * u0) * (rs2 * fast_rcp(1.f + fast_exp2(g0 * rsl))); }
                st8(O + (size_t)row * FFH + col0, v[0], v[1]); }
    }
};
struct EpiIn1 {
    bf16_t* Z; const float* rstd;
    __device__ __forceinline__ void operator()(const AccT& acc, const Unit& u, int wr, int wc, int fr, int fq) const {
        const int row0 = u.pm * BM + wr * 64 + fr, col0 = u.pn * BM + wc * 32 + 8 * fq; const bool act = u.pn >= 4;
#pragma unroll
        for (int ai = 0; ai < 2; ++ai)
#pragma unroll
            for (int m = 0; m < 4; ++m) { bf16_t* rowp = Z + (size_t)(row0 + ai * HALF + m * 16) * 2048 + col0; const float rs = rstd[row0 + ai * HALF + m * 16];
#pragma unroll
                for (int bj = 0; bj < 2; ++bj) { f32x4 v0 = acc[ai][bj][m][0] * rs, v1 = acc[ai][bj][m][1] * rs;
                    if (act) {
#pragma unroll
                        for (int i = 0; i < 4; ++i) { v0[i] = gelu_tanh(v0[i]); v1[i] = gelu_tanh(v1[i]); } }
                    st8(rowp + bj * HALF, v0, v1); } }
    }
};
struct EpiGates {
    const bf16_t* XC; bf16_t* LA; bf16_t* BB; const float* b_r; const float* b_i; const float* sp;
    __device__ __forceinline__ void operator()(const AccT& acc, const Unit& u, int wr, int wc, int fr, int fq) const {
        const int row0 = u.pm * BM + wr * 64 + fr, c0 = (u.pn >> 1) * 256 + (u.pn & 1) * 128 + wc * 32 + 8 * fq;
        f32x4 br[2], bi[2], spv[2];
#pragma unroll
        for (int n = 0; n < 2; ++n) { br[n] = *(const f32x4*)(b_r + c0 + 4 * n) * (-LOG2E); bi[n] = *(const f32x4*)(b_i + c0 + 4 * n) * (-LOG2E); spv[n] = *(const f32x4*)(sp + c0 + 4 * n) * (-8.f); }
#pragma unroll
        for (int ai = 0; ai < 2; ++ai)
#pragma unroll
            for (int m = 0; m < 4; ++m) { const int row = row0 + ai * HALF + m * 16; const u32x4 xw = *(const u32x4*)(XC + (size_t)row * 1024 + c0);
                const float xv[8] = {bflo(xw.x), bfhi(xw.x), bflo(xw.y), bfhi(xw.y), bflo(xw.z), bfhi(xw.z), bflo(xw.w), bfhi(xw.w)};
                f32x4 la[2], bb[2];
#pragma unroll
                for (int n = 0; n < 2; ++n)
#pragma unroll
                    for (int i = 0; i < 4; ++i) { const float er = fast_exp2(acc[ai][0][m][n][i] * (-LOG2E) + br[n][i]), ei = fast_exp2(acc[ai][1][m][n][i] * (-LOG2E) + bi[n][i]);
                        la[n][i] = spv[n][i] * fast_rcp(1.f + er); bb[n][i] = xv[4 * n + i] * fast_rcp(1.f + ei); }
                st8(LA + (size_t)row * 1024 + c0, la[0], la[1]); st8(BB + (size_t)row * 1024 + c0, bb[0], bb[1]); __builtin_amdgcn_sched_barrier(0); }
    }
};
}

__device__ __forceinline__ void transpose_item(const float* W, int ld, int K, bf16_t* dst, int k0, LAS float* scr, int lane, const float* gk = nullptr) {
    float tv[32];
#pragma unroll
    for (int i = 0; i < 32; ++i) { const int kk = 2 * i + (lane >> 5); tv[i] = W[(size_t)(k0 + kk) * ld + (lane & 31)]; }
#pragma unroll
    for (int i = 0; i < 32; ++i) { const int kk = 2 * i + (lane >> 5); const float gs = gk ? gk[k0 + kk] : 1.f; scr[kk * 33 + (lane & 31)] = tv[i] * gs; }
    LDS_WAIT();
    const int c = lane & 7;
#pragma unroll
    for (int j = 0; j < 4; ++j) { const int n = (lane >> 3) + 8 * j; const LAS float* s = scr + (8 * c) * 33 + n;
        u32x4 o; o.x = pk2(s[0 * 33], s[1 * 33]); o.y = pk2(s[2 * 33], s[3 * 33]); o.z = pk2(s[4 * 33], s[5 * 33]); o.w = pk2(s[6 * 33], s[7 * 33]);
        *(u32x4*)(dst + (size_t)n * K + k0 + 8 * c) = o; }
    LDS_WAIT();
}
__device__ __forceinline__ void sincos_rr(float ang, float& s, float& c) {
    const double r = (double)ang * 0.15915494309189535; const double fr = r - __builtin_rint(r); const float f = (float)fr;
    s = __builtin_amdgcn_sinf(f); c = __builtin_amdgcn_cosf(f);
}
struct RowBuf { f32x4 v[2][4]; };
__device__ __forceinline__ void rows_load(RowBuf& B, const float* x, int m0, int stride, int lane) {
#pragma unroll
    for (int r = 0; r < 2; ++r) { const f32x4* xr = (const f32x4*)(x + (size_t)(m0 + r * stride) * DM) + lane;
#pragma unroll
        for (int j = 0; j < 4; ++j) B.v[r][j] = xr[64 * j]; }
}
__device__ __forceinline__ void rows_store(const RowBuf& B, bf16_t* o, float* rstd_out, int m0, int stride, int lane) {
    float s[2];
#pragma unroll
    for (int r = 0; r < 2; ++r) { s[r] = 0.f;
#pragma unroll
        for (int j = 0; j < 4; ++j) s[r] += (B.v[r][j].x * B.v[r][j].x + B.v[r][j].y * B.v[r][j].y) + (B.v[r][j].z * B.v[r][j].z + B.v[r][j].w * B.v[r][j].w); }
#pragma unroll
    for (int o_ = 1; o_ < 64; o_ <<= 1) {
#pragma unroll
        for (int r = 0; r < 2; ++r) s[r] += __shfl_xor(s[r], o_); }
#pragma unroll
    for (int r = 0; r < 2; ++r) { u32x2* o8 = (u32x2*)(o + (size_t)(m0 + r * stride) * DM) + lane;
#pragma unroll
        for (int j = 0; j < 4; ++j) { u32x2 w; w.x = pk2(B.v[r][j].x, B.v[r][j].y); w.y = pk2(B.v[r][j].z, B.v[r][j].w); o8[64 * j] = w; }
        if (lane == 0) rstd_out[m0 + r * stride] = 1.f / sqrtf(s[r] * (1.f / DM) + NORM_EPS); }
}
__device__ __forceinline__ void rows_phase(const float* x, bf16_t* o, float* rstd_out, int gw, int NGW, int lane) {
    RowBuf A, B; int m = gw;
    if (m + NGW >= MTOK) return;
    rows_load(A, x, m, NGW, lane);
    for (;;) {
        const int m2 = m + 2 * NGW; const bool has2 = m2 + NGW < MTOK;
        if (has2) rows_load(B, x, m2, NGW, lane);
        rows_store(A, o, rstd_out, m, NGW, lane);
        if (!has2) break;
        const int m3 = m2 + 2 * NGW; const bool has3 = m3 + NGW < MTOK;
        if (has3) rows_load(A, x, m3, NGW, lane);
        rows_store(B, o, rstd_out, m2, NGW, lane);
        if (!has3) break;
        m = m3;
    }
}
struct RnBuf { u32x2 mx[2][4]; f32x4 xf[2][4]; u32x2 xb[2][4]; };
template <bool XIN_F32>
__device__ __forceinline__ void rn_load(RnBuf& B, const void* xin, const bf16_t* mix, int m0, int stride, int lane) {
#pragma unroll
    for (int r = 0; r < 2; ++r) { const size_t ro = (size_t)(m0 + r * stride) * DM; const u32x2* mr = (const u32x2*)(mix + ro) + lane;
#pragma unroll
        for (int j = 0; j < 4; ++j) { B.mx[r][j] = mr[64 * j];
            if (XIN_F32) B.xf[r][j] = ((const f32x4*)((const float*)xin + ro) + lane)[64 * j]; else B.xb[r][j] = ((const u32x2*)((const bf16_t*)xin + ro) + lane)[64 * j]; } }
}
template <bool XIN_F32, bool OUT_F32>
__device__ __forceinline__ void rn_process(const RnBuf& B, const float* gpost, void* xout, float* rstd_out, int m0, int stride, int lane) {
    f32x4 v[2][4]; float s[2], s2[2];
#pragma unroll
    for (int r = 0; r < 2; ++r) { s[r] = 0.f;
#pragma unroll
        for (int j = 0; j < 4; ++j) { const u32x2 w = B.mx[r][j]; v[r][j] = (f32x4){bflo(w.x), bfhi(w.x), bflo(w.y), bfhi(w.y)};
            s[r] += (v[r][j].x * v[r][j].x + v[r][j].y * v[r][j].y) + (v[r][j].z * v[r][j].z + v[r][j].w * v[r][j].w); } }
#pragma unroll
    for (int o_ = 1; o_ < 64; o_ <<= 1) {
#pragma unroll
        for (int r = 0; r < 2; ++r) s[r] += __shfl_xor(s[r], o_); }
#pragma unroll
    for (int r = 0; r < 2; ++r) { const float rstd = 1.f / sqrtf(s[r] * (1.f / DM) + NORM_EPS); const size_t ro = (size_t)(m0 + r * stride) * DM; s2[r] = 0.f;
#pragma unroll
        for (int j = 0; j < 4; ++j) { const f32x4 gg = ((const f32x4*)gpost + lane)[64 * j]; f32x4 xo;
            if (XIN_F32) xo = B.xf[r][j]; else { const u32x2 w2 = B.xb[r][j]; xo = (f32x4){bflo(w2.x), bfhi(w2.x), bflo(w2.y), bfhi(w2.y)}; }
            v[r][j] = xo + v[r][j] * rstd * gg;
            s2[r] += (v[r][j].x * v[r][j].x + v[r][j].y * v[r][j].y) + (v[r][j].z * v[r][j].z + v[r][j].w * v[r][j].w);
            if (OUT_F32) ((f32x4*)((float*)xout + ro) + lane)[64 * j] = v[r][j]; else { u32x2 w; w.x = pk2(v[r][j].x, v[r][j].y); w.y = pk2(v[r][j].z, v[r][j].w); ((u32x2*)((bf16_t*)xout + ro) + lane)[64 * j] = w; } } }
    if (!OUT_F32) {
#pragma unroll
        for (int o_ = 1; o_ < 64; o_ <<= 1) {
#pragma unroll
            for (int r = 0; r < 2; ++r) s2[r] += __shfl_xor(s2[r], o_); }
#pragma unroll
        for (int r = 0; r < 2; ++r) if (lane == 0) rstd_out[m0 + r * stride] = 1.f / sqrtf(s2[r] * (1.f / DM) + NORM_EPS); }
}
template <bool XIN_F32, bool OUT_F32>
__device__ __forceinline__ void resnorm_phase(const void* xin, const bf16_t* mix, const float* gpost, void* xout, float* rstd_out, int gw, int NGW, int lane) {
    RnBuf A, B; int m = gw;
    if (m + NGW >= MTOK) return;
    rn_load<XIN_F32>(A, xin, mix, m, NGW, lane);
    for (;;) {
        const int m2 = m + 2 * NGW; const bool has2 = m2 + NGW < MTOK;
        if (has2) rn_load<XIN_F32>(B, xin, mix, m2, NGW, lane);
        rn_process<XIN_F32, OUT_F32>(A, gpost, xout, rstd_out, m, NGW, lane);
        if (!has2) break;
        const int m3 = m2 + 2 * NGW; const bool has3 = m3 + NGW < MTOK;
        if (has3) rn_load<XIN_F32>(A, xin, mix, m3, NGW, lane);
        rn_process<XIN_F32, OUT_F32>(B, gpost, xout, rstd_out, m2, NGW, lane);
        if (!has3) break;
        m = m3;
    }
}

constexpr int AT_KPITCH = 144, AT_VPITCH = 160, AT_VOFF = 256 * AT_KPITCH;
constexpr int AT_UNITS = 12288, AT_HEAD = 0;
typedef short s16x4 __attribute__((ext_vector_type(4)));
__device__ __forceinline__ int attn_seq(int bx, int G, int i) {
    if (G != 256) { const int u = bx + i * G; return u < AT_UNITS ? u : -1; }
    const int x = bx & 7, wl = bx >> 3; int L;
    if (wl >= 16) { if (i < AT_HEAD) L = (wl - 16) + 16 * i; else L = 16 * AT_HEAD + (i - AT_HEAD) * 32 + wl; }
    else L = 16 * AT_HEAD + i * 32 + wl;
    if (L >= AT_UNITS / 8) return -1;
    return (x + 8 * (L / 48)) * 48 + (L % 48);
}
#define AT_DECODE(u) const int sub = (u) & 15, br = ((u) >> 4) % 3, bh = (u) / 48, h = bh & 7, b = bh >> 3; \
    const int dil = br == 0 ? 1 : (br == 1 ? 4 : 16), nb = 16 / dil, rho = sub / nb, n = sub % nb; const bf16_t* Zb = Zp + (size_t)b * SEQ * 2048;
__device__ __forceinline__ void attn_issue(const bf16_t* Zp, int u, int tid, int wave, int lane, u32x4 (&rk)[4], u32x4 (&rv)[4], bf16x8& q0, bf16x8& q1) {
    AT_DECODE(u)
#pragma unroll
    for (int it = 0; it < 4; ++it) { if (n == 0 && it < 2) continue; const int idx = tid + it * NTHREADS, kb = idx >> 3, ch = idx & 7;
        const int tok = (n * 128 - 128 + kb) * dil + rho;
        const bf16_t* rowp = Zb + (size_t)tok * 2048 + h * 64 + ch * 8;
        rk[it] = *(const u32x4*)(rowp + 512); rv[it] = *(const u32x4*)(rowp + 1024); }
    const int kq = lane >> 4, qi = 16 * wave + (lane & 15); const int tokq = (n * 128 + qi) * dil + rho;
    const bf16_t* qrow = Zb + (size_t)tokq * 2048 + h * 64;
    q0 = *(const bf16x8*)(qrow + 8 * kq); q1 = *(const bf16x8*)(qrow + 32 + 8 * kq);
}
__device__ __forceinline__ void attn_phase(const bf16_t* Zp, bf16_t* POp, float* PMp, float* PLp, LAS unsigned char* lds, int bx, int G, int tid, int wave, int lane) {
    int ui = 0; int u = attn_seq(bx, G, 0); if (u < 0) return;
    u32x4 rk[4], rv[4]; bf16x8 q0n, q1n;
    attn_issue(Zp, u, tid, wave, lane, rk, rv, q0n, q1n);
    const int q = lane & 15, kq = lane >> 4, qi = 16 * wave + q;
    for (;;) {
        AT_DECODE(u)
        (void)Zb;
        const int kmin_ = (n == 0) ? 128 : 0; const int mlo = qi > kmin_ ? qi : kmin_; const unsigned mrange = (unsigned)(qi + 128 - mlo);
        __syncthreads();
#pragma unroll
        for (int it = 0; it < 4; ++it) { if (n == 0 && it < 2) continue; const int idx = tid + it * NTHREADS, kb = idx >> 3, ch = idx & 7;
            *(LAS u32x4*)(lds + kb * AT_KPITCH + ch * 16) = rk[it]; *(LAS u32x4*)(lds + AT_VOFF + kb * AT_VPITCH + ch * 16) = rv[it]; }
        if (n == 0 && tid < 128) *(LAS u32x4*)(lds + AT_VOFF + (112 + (tid >> 3)) * AT_VPITCH + (tid & 7) * 16) = (u32x4){0u, 0u, 0u, 0u};
        const bf16x8 qf0 = q0n, qf1 = q1n;
        __syncthreads();
        const int un = attn_seq(bx, G, ui + 1);
        if (un >= 0) attn_issue(Zp, un, tid, wave, lane, rk, rv, q0n, q1n);
        const int kstart = (16 * wave < 96) ? 16 * wave : 96;
        f32x4 st[10];
#pragma unroll
        for (int p = 0; p < 5; ++p) {
            const int ks = kstart + 32 * p;
            const bool live = !(n == 0 && ks + 32 <= 128) && !(ks + 31 < 16 * wave);
            st[2 * p] = (f32x4){-1e30f, -1e30f, -1e30f, -1e30f}; st[2 * p + 1] = st[2 * p];
            if (live) {
                const LAS unsigned char* kp = lds + (ks + q) * AT_KPITCH + kq * 16;
                const bf16x8 k00 = *(const LAS bf16x8*)(kp), k01 = *(const LAS bf16x8*)(kp + 64);
                const bf16x8 k10 = *(const LAS bf16x8*)(kp + 16 * AT_KPITCH), k11 = *(const LAS bf16x8*)(kp + 16 * AT_KPITCH + 64);
                f32x4 s0 = {0.f, 0.f, 0.f, 0.f}, s1 = {0.f, 0.f, 0.f, 0.f};
                s0 = __builtin_amdgcn_mfma_f32_16x16x32_bf16(k00, qf0, s0, 0, 0, 0); s0 = __builtin_amdgcn_mfma_f32_16x16x32_bf16(k01, qf1, s0, 0, 0, 0);
                s1 = __builtin_amdgcn_mfma_f32_16x16x32_bf16(k10, qf0, s1, 0, 0, 0); s1 = __builtin_amdgcn_mfma_f32_16x16x32_bf16(k11, qf1, s1, 0, 0, 0);
                const bool need_mask = !(ks >= 16 * wave + 15 && ks + 31 <= 16 * wave + 128) || (n == 0 && ks < 128);
                if (need_mask) {
                    const int tb = ks + 4 * kq - mlo;
#pragma unroll
                    for (int i = 0; i < 4; ++i) { s0[i] = ((unsigned)(tb + i) <= mrange) ? s0[i] : -1e30f; s1[i] = ((unsigned)(tb + 16 + i) <= mrange) ? s1[i] : -1e30f; }
                }
                st[2 * p] = s0; st[2 * p + 1] = s1;
            }
        }
        float mrun = -1e30f;
#pragma unroll
        for (int j = 0; j < 10; ++j) mrun = fmaxf(mrun, fmaxf(fmaxf(st[j][0], st[j][1]), fmaxf(st[j][2], st[j][3])));
        mrun = fmaxf(mrun, __shfl_xor(mrun, 16)); mrun = fmaxf(mrun, __shfl_xor(mrun, 32));
        float lrun = 0.f;
#pragma unroll
        for (int j = 0; j < 10; ++j)
#pragma unroll
            for (int i = 0; i < 4; ++i) { st[j][i] = fast_exp2(st[j][i] - mrun); lrun += st[j][i]; }
        f32x4 o[4];
#pragma unroll
        for (int mm = 0; mm < 4; ++mm) o[mm] = (f32x4){0.f, 0.f, 0.f, 0.f};
#pragma unroll
        for (int p = 0; p < 5; ++p) {
            const int ks = kstart + 32 * p;
            const bool live = !(n == 0 && ks + 32 <= 128) && !(ks + 31 < 16 * wave);
            if (live) {
                const LAS unsigned char* vp = lds + AT_VOFF + (ks + 4 * kq + (q >> 2)) * AT_VPITCH + (q & 3) * 8;
                u32x4 pw; pw.x = pk2(st[2 * p][0], st[2 * p][1]); pw.y = pk2(st[2 * p][2], st[2 * p][3]); pw.z = pk2(st[2 * p + 1][0], st[2 * p + 1][1]); pw.w = pk2(st[2 * p + 1][2], st[2 * p + 1][3]);
                const bf16x8 pf = __builtin_bit_cast(bf16x8, pw);
#pragma unroll
                for (int mm = 0; mm < 4; ++mm) {
                    const s16x4 vlo = __builtin_bit_cast(s16x4, __builtin_amdgcn_ds_read_tr16_b64_v4i16((LAS s16x4*)(vp + 32 * mm)));
                    const s16x4 vhi = __builtin_bit_cast(s16x4, __builtin_amdgcn_ds_read_tr16_b64_v4i16((LAS s16x4*)(vp + 16 * AT_VPITCH + 32 * mm)));
                    bf16x8 vf; vf[0] = vlo[0]; vf[1] = vlo[1]; vf[2] = vlo[2]; vf[3] = vlo[3]; vf[4] = vhi[0]; vf[5] = vhi[1]; vf[6] = vhi[2]; vf[7] = vhi[3];
                    o[mm] = __builtin_amdgcn_mfma_f32_16x16x32_bf16(vf, pf, o[mm], 0, 0, 0); }
            }
        }
        lrun += __shfl_xor(lrun, 16); lrun += __shfl_xor(lrun, 32);
        const float inv = 1.f / lrun; const int tokq = (n * 128 + qi) * dil + rho; const size_t row = (size_t)b * SEQ + tokq;
        bf16_t* orow = POp + ((size_t)br * MTOK + row) * 512 + h * 64 + 4 * kq;
#pragma unroll
        for (int mm = 0; mm < 4; ++mm) { u32x2 w; w.x = pk2(o[mm][0] * inv, o[mm][1] * inv); w.y = pk2(o[mm][2] * inv, o[mm][3] * inv); *(u32x2*)(orow + 16 * mm) = w; }
        if (kq == 0) { PMp[((size_t)br * MTOK + row) * 8 + h] = mrun; PLp[((size_t)br * MTOK + row) * 8 + h] = lrun; }
        if (un < 0) break;
        u = un; ++ui;
    }
}

constexpr int S5_BUSP = 132, S5_HSP = 136;
constexpr int S5_WAVE_BYTES = 16 * S5_BUSP * 4 + 16 * S5_HSP * 2;
__device__ __forceinline__ void s5_unit(const bf16_t* Zp, const unsigned char* tab, const float* dskip, bf16_t* Y5p, LAS unsigned char* lds, int unit, int wave, int lane) {
    const int b = unit >> 3, g = (unit & 7) * 4 + wave;
    LAS float* bus = (LAS float*)(lds + wave * S5_WAVE_BYTES);
    LAS bf16_t* hs = (LAS bf16_t*)(lds + wave * S5_WAVE_BYTES + 16 * S5_BUSP * 4);
    const int n = lane & 15, kg = lane >> 4;
    const bf16_t* BMt = (const bf16_t*)(tab + S5_BM); const bf16_t* CMt = (const bf16_t*)(tab + S5_CM); const float* AB = (const float*)(tab + S5_ABAR);
    bf16x8 bm[8], cm[4];
#pragma unroll
    for (int nt = 0; nt < 8; ++nt) bm[nt] = *(const bf16x8*)(BMt + ((size_t)(g * 128 + 16 * nt + n)) * 32 + 8 * kg);
#pragma unroll
    for (int kk = 0; kk < 4; ++kk) cm[kk] = *(const bf16x8*)(CMt + ((size_t)(g * 16 + n)) * 128 + 32 * kk + 8 * kg);
    const float dsk = dskip[g * 16 + n];
    const float ar = AB[(g * 64 + lane) * 2], ai = AB[(g * 64 + lane) * 2 + 1];
    f32x2 hv = {0.f, 0.f}; const f32x2 a_rr = {ar, ar}, a_ii = {-ai, ai};
    const float a2r = ar * ar - ai * ai, a2i = 2.f * ar * ai; const f32x2 a2_rr = {a2r, a2r}, a2_ii = {-a2i, a2i};
    const bf16_t* ub = Zp + (size_t)b * SEQ * 2048 + 1536 + g * 16;
    bf16_t* yb = Y5p + (size_t)b * SEQ * 512 + g * 16 + n;
    LAS bf16_t* uls = (LAS bf16_t*)(lds + 8 * S5_WAVE_BYTES + wave * 1024);
    bf16x8 q1[4], q2[4];
#pragma unroll
    for (int j = 0; j < 4; ++j) { q1[j] = (bf16x8){0, 0, 0, 0, 0, 0, 0, 0}; q2[j] = q1[j];
        if (kg < 2) { q1[j] = *(const bf16x8*)(ub + (size_t)(16 * j + n) * 2048 + 8 * kg); q2[j] = *(const bf16x8*)(ub + (size_t)(64 + 16 * j + n) * 2048 + 8 * kg); } }
    {
        const bf16x8 uf = q1[0];
        if (kg < 2) *(LAS bf16x8*)(uls + n * 32 + 8 * kg) = uf;
#pragma unroll
        for (int nt = 0; nt < 8; ++nt) { f32x4 d = {0.f, 0.f, 0.f, 0.f}; d = __builtin_amdgcn_mfma_f32_16x16x32_bf16(bm[nt], uf, d, 0, 0, 0);
            *(LAS f32x4*)(bus + n * S5_BUSP + 16 * nt + 4 * kg) = d; }
    }
    unsigned short usp[4] = {0, 0, 0, 0};
    for (int sb = 0; sb < SEQ / 64; ++sb) {
        bf16x8 ufc[4];
#pragma unroll
        for (int j = 0; j < 4; ++j) { ufc[j] = q1[j]; q1[j] = q2[j]; if (kg < 2 && sb + 2 < SEQ / 64) q2[j] = *(const bf16x8*)(ub + (size_t)((sb + 2) * 64 + 16 * j + n) * 2048 + 8 * kg); }
#pragma unroll
        for (int j = 0; j < 4; ++j) {
            asm volatile("" ::: "memory");
            const int k = 4 * sb + j;
            bf16x8 hf[4];
#pragma unroll
            for (int kk = 0; kk < 4; ++kk) hf[kk] = *(const LAS bf16x8*)(hs + n * S5_HSP + 32 * kk + 8 * kg);
            f32x2 bv[16];
#pragma unroll
            for (int t = 0; t < 16; ++t) bv[t] = *(const LAS f32x2*)(bus + t * S5_BUSP + 2 * lane);
            unsigned short usc[4];
#pragma unroll
            for (int i = 0; i < 4; ++i) usc[i] = uls[(4 * kg + i) * 32 + n];
            const bf16x8 ufn = (j < 3) ? ufc[(j + 1) & 3] : q1[0];
            f32x4 d[8];
#pragma unroll
            for (int nt = 0; nt < 8; ++nt) { d[nt] = (f32x4){0.f, 0.f, 0.f, 0.f}; d[nt] = __builtin_amdgcn_mfma_f32_16x16x32_bf16(bm[nt], ufn, d[nt], 0, 0, 0); }
            f32x4 y = {0.f, 0.f, 0.f, 0.f};
#pragma unroll
            for (int kk = 0; kk < 4; ++kk) y = __builtin_amdgcn_mfma_f32_16x16x32_bf16(hf[kk], cm[kk], y, 0, 0, 0);
#pragma unroll
            for (int t = 0; t < 16; t += 2) {
                const f32x2 bsw = __builtin_shufflevector(bv[t], bv[t], 1, 0), hsw = __builtin_shufflevector(hv, hv, 1, 0);
                f32x2 c = a_rr * bv[t] + bv[t + 1]; c = a_ii * bsw + c;
                f32x2 h1 = a_rr * hv + bv[t]; h1 = a_ii * hsw + h1;
                f32x2 h2 = a2_rr * hv + c; h2 = a2_ii * hsw + h2;
                *(LAS unsigned*)(hs + t * S5_HSP + 2 * lane) = pk2(h1.x, h1.y); *(LAS unsigned*)(hs + (t + 1) * S5_HSP + 2 * lane) = pk2(h2.x, h2.y);
                hv = h2; }
#pragma unroll
            for (int nt = 0; nt < 8; ++nt) *(LAS f32x4*)(bus + n * S5_BUSP + 16 * nt + 4 * kg) = d[nt];
            if (kg < 2) *(LAS bf16x8*)(uls + n * 32 + 8 * kg) = ufn;
            if (k >= 1) {
#pragma unroll
                for (int i = 0; i < 4; ++i) { const int t = 16 * (k - 1) + 4 * kg + i; const float v = gelu_tanh(y[i] + dsk * bf2f(usp[i])); yb[(size_t)t * 512] = (bf16_t)f2bf(v); } }
#pragma unroll
            for (int i = 0; i < 4; ++i) usp[i] = usc[i];
        }
    }
    {
        asm volatile("" ::: "memory");
        f32x4 y = {0.f, 0.f, 0.f, 0.f};
#pragma unroll
        for (int kk = 0; kk < 4; ++kk) { const bf16x8 hf = *(const LAS bf16x8*)(hs + n * S5_HSP + 32 * kk + 8 * kg); y = __builtin_amdgcn_mfma_f32_16x16x32_bf16(hf, cm[kk], y, 0, 0, 0); }
#pragma unroll
        for (int i = 0; i < 4; ++i) { const int t = SEQ - 16 + 4 * kg + i; const float v = gelu_tanh(y[i] + dsk * bf2f(usp[i])); yb[(size_t)t * 512] = (bf16_t)f2bf(v); }
    }
    LDS_WAIT();
}

#define XB_TMO      128
#define XB_XCNT(j)  (256  + 64 * (j))
#define XB_XSUB(j)  (1280 + 64 * (j))
#define XB_XGEN(j)  (2304 + 64 * (j))
#define XB_TOP      3328
#define XB_TOPGEN   3392
#define XCD_BAR_WORDS 3456
#define XB_SPIN_CAP (1u << 22)
__device__ __forceinline__ unsigned xb_ld(unsigned* p)              { return __hip_atomic_load(p, __ATOMIC_RELAXED, __HIP_MEMORY_SCOPE_AGENT); }
__device__ __forceinline__ unsigned xb_add(unsigned* p, unsigned v) { return __hip_atomic_fetch_add(p, v, __ATOMIC_RELAXED, __HIP_MEMORY_SCOPE_AGENT); }
__device__ __forceinline__ unsigned xb_xcc_id() { return (unsigned)__builtin_amdgcn_s_getreg((3 << 11) | 20) & 0xFu; }
#define XB_SPIN(cond, bar) do { unsigned _sp = 0; while (cond) { __builtin_amdgcn_s_sleep(1); \
    if ((++_sp & 255u) == 0u) { if (xb_ld(&(bar)[XB_TMO])) break; if (_sp > XB_SPIN_CAP) { atomicAdd(&(bar)[XB_TMO], 1u); break; } } } } while (0)
__device__ __forceinline__ void xcd_barrier_complete(unsigned* bar, unsigned x, unsigned& nloc, unsigned& nx) {
    const unsigned G = gridDim.x * gridDim.y * gridDim.z;
    unsigned sum, cnt, mine, sp = 0u;
    for (;;) {
        sum = 0u; cnt = 0u; mine = 0u;
#pragma unroll
        for (unsigned j = 0; j < 16; ++j) { const unsigned c = xb_ld(&bar[XB_XCNT(j)]); sum += c; cnt += (c > 0u) ? 1u : 0u; mine = (j == x) ? c : mine; }
        if (sum == G) break;
        __builtin_amdgcn_s_sleep(1);
        if ((++sp & 255u) == 0u) { if (xb_ld(&bar[XB_TMO])) break; if (sp > XB_SPIN_CAP) { atomicAdd(&bar[XB_TMO], 1u); break; } }
    }
    nloc = mine > 0u ? mine : 1u; nx = cnt > 0u ? cnt : 1u;
}
__device__ __forceinline__ void xcd_barrier(unsigned* bar, volatile LAS unsigned* st) {
    asm volatile("s_waitcnt vmcnt(0)" ::: "memory");
    __syncthreads();
    if (threadIdx.x == 0) {
        const unsigned x = xb_xcc_id();
        __builtin_amdgcn_s_waitcnt(0);
        unsigned nloc = st[0], nx = st[1];
        if (nloc == 0u) { xcd_barrier_complete(bar, x, nloc, nx); st[0] = nloc; st[1] = nx; }
        const unsigned old = xb_add(&bar[XB_XSUB(x)], 1u);
        const unsigned gen = old / nloc;
        if (old + 1u == (gen + 1u) * nloc) {
            __builtin_amdgcn_fence(__ATOMIC_RELEASE, "agent");
            asm volatile("s_waitcnt vmcnt(0)" ::: "memory");
            const unsigned og = xb_add(&bar[XB_TOP], 1u);
            const unsigned tg = og / nx;
            if (og + 1u == (tg + 1u) * nx) xb_add(&bar[XB_TOPGEN], 1u);
            else XB_SPIN(xb_ld(&bar[XB_TOPGEN]) == tg, bar);
            __builtin_amdgcn_fence(__ATOMIC_ACQUIRE, "agent");
            xb_add(&bar[XB_XGEN(x)], 1u);
            asm volatile("s_waitcnt vmcnt(0)" ::: "memory");
        } else {
            XB_SPIN(xb_ld(&bar[XB_XGEN(x)]) == gen, bar);
            __builtin_amdgcn_fence(__ATOMIC_ACQUIRE, "agent");
            asm volatile("s_waitcnt vmcnt(0)" ::: "memory");
        }
    }
    __syncthreads();
}
constexpr int LDS_MISC = 135 * 1024;
constexpr size_t CTL_BYTES = 16384;

#ifndef TSEL_LO
#define TSEL_LO -1
#define TSEL_HI -1
#define TSEL_STEP 1
#endif
#define STAMP(k) do { if (TSEL_LO >= 0 && blockIdx.x == 0 && threadIdx.x == 0) ((volatile LAS unsigned long long*)(lds + LDS_MISC + 64))[(k)] = __builtin_amdgcn_s_memrealtime(); } while (0)
typedef const __attribute__((address_space(4))) Args* ArgsP;
__global__ void __launch_bounds__(NTHREADS, 2) mega(Args a_kern) {
    extern __shared__ __attribute__((aligned(16))) unsigned char lds_raw[];
    LAS unsigned char* lds = (LAS unsigned char*)lds_raw;
    cg::grid_group grid = cg::this_grid();
    ArgsP ap = (ArgsP)__builtin_amdgcn_kernarg_segment_ptr();
#define a (*ap)
#define ws (a.ws)
    int tid, lane, wave, gw, gt;
    const int G = gridDim.x, bx = blockIdx.x;
    const int NGW = G * NWAVES, NGT = G * NTHREADS;
#define RELOAD() do { asm volatile("" : "+s"(ap)); tid = threadIdx.x; asm volatile("" : "+v"(tid)); lane = tid & 63; wave = __builtin_amdgcn_readfirstlane(tid >> 6); gw = bx * NWAVES + wave; gt = bx * NTHREADS + tid; } while (0)
    RELOAD();
    if (a.ph_lo < 0) grid.sync();
    volatile LAS unsigned* bst = (volatile LAS unsigned*)(lds + LDS_MISC);
    if (tid == 0) { bst[0] = 0u; bst[1] = 0u; (void)xb_add((unsigned*)(ws + WS_CTL) + XB_XCNT(xb_xcc_id()), 1u); }
    __syncthreads();
    STAMP(0);
#define x_in (a.in[0])
#define positions ((const int*)a.in[1])
#define g_mix_pre (a.in[2])
#define g_mix_post (a.in[3])
#define g_ffn_pre (a.in[4])
#define g_ffn_post (a.in[5])
#define HN ((bf16_t*)(ws + WS_HN))
#define RSTD ((float*)(ws + WS_CTL + 512 * 1024))
#define Z ((bf16_t*)(ws + WS_Z))
#define YC ((bf16_t*)(ws + WS_YC))
#define MIX ((bf16_t*)(ws + WS_MIX))
#define PO ((bf16_t*)(ws + WS_PO))
#define PM ((float*)(ws + WS_PM))
#define PL ((float*)(ws + WS_PL))
#define Y5 ((bf16_t*)(ws + WS_Y5))
#define HID ((bf16_t*)(ws + WS_HID))
#define XC ((bf16_t*)(ws + WS_XC))
#define BB ((bf16_t*)(ws + WS_BB))
#define Y1 ((bf16_t*)(ws + WS_Y1))
#define LA ((bf16_t*)(ws + WS_LA))
#define ROPE ((float*)(ws + WS_ROPE))
#define S5T (ws + WS_S5TAB)
#define SP ((float*)(ws + WS_S5TAB + S5_SP))
#define X (a.out)
#ifndef PHMASK
#define PHMASK 0xFFFFFFFFu
#endif
#define IN(k) (((PHMASK >> (k)) & 1u) && a.ph_lo <= (k) && (k) < a.ph_hi)
#ifndef REPMASK
#define REPMASK 0x0u
#endif
#define REPS(k) (1 + (int)((REPMASK >> (k)) & 1u))
#define REPSYNC do { if (rep) grid.sync(); } while (0)
#define SEAM(k) do { if (IN(k) && IN((k) + 1)) { xcd_barrier((unsigned*)(ws + WS_CTL), bst); } STAMP((k) + 1); RELOAD(); } while (0)

    constexpr int I_IN = 16 * 64, I_OUT = 16 * 32, I_GLU = 8 * 16, I_GATE = 4 * 64, I_UP = 16 * 176, I_DN = 44 * 32;
#define XPOSE_ITEM(ITEM, scr) do { int r = (ITEM); \
            if (r < I_IN) { const int kb = r / 64, nb = r % 64; transpose_item(a.in[6] + nb * 32, 2048, 1024, (bf16_t*)(ws + WS_W_IN0) + (size_t)nb * 32 * 1024, kb * 64, scr, lane, g_mix_pre); break; } r -= I_IN; \
            if (r < I_IN) { const int kb = r / 64, nb = r % 64; transpose_item(a.in[17] + nb * 32, 2048, 1024, (bf16_t*)(ws + WS_W_IN1) + (size_t)nb * 32 * 1024, kb * 64, scr, lane, g_mix_pre + DM); break; } r -= I_IN; \
            if (r < I_OUT) { const int kb = r / 32, nb = r % 32; transpose_item(a.in[7] + nb * 32, 1024, 1024, (bf16_t*)(ws + WS_W_OUT0) + (size_t)nb * 32 * 1024, kb * 64, scr, lane); break; } r -= I_OUT; \
            if (r < I_OUT) { const int kb = r / 32, nb = r % 32; transpose_item(a.in[18] + nb * 32, 1024, 1024, (bf16_t*)(ws + WS_W_OUT1) + (size_t)nb * 32 * 1024, kb * 64, scr, lane); break; } r -= I_OUT; \
            if (r < I_GLU) { const int kb = r / 16, nb = r % 16; transpose_item(a.in[16] + nb * 32, 512, 512, (bf16_t*)(ws + WS_W_GLU) + (size_t)nb * 32 * 512, kb * 64, scr, lane); break; } r -= I_GLU; \
            if (r < I_GATE) { const int kb = r / 64, nb = r % 64; const int n0 = nb * 32, pn = n0 >> 8, half = (n0 >> 7) & 1, j = n0 & 127, hh = pn >> 1, colg = (pn & 1) * 128 + j; \
                const float* src = (half ? a.in[23] : a.in[21]) + (size_t)hh * 256 * 256 + colg; \
                transpose_item(src, 256, 256, (bf16_t*)(ws + WS_W_GATE) + (size_t)n0 * 256, kb * 64, scr, lane); break; } r -= I_GATE; \
            if (r < 2 * I_UP) { const int layer = r / I_UP; r -= layer * I_UP; const int kb = r / 176, nb = r % 176; const int n0 = nb * 32, t = n0 >> 8, half = (n0 >> 7) & 1, j = n0 & 127; \
                const float* src = (half ? a.in[27] : a.in[26]) + (size_t)layer * 1024 * FFH + t * 128 + j; \
                transpose_item(src, FFH, 1024, (bf16_t*)(ws + (layer ? WS_W_UP1 : WS_W_UP0)) + (size_t)n0 * 1024, kb * 64, scr, lane, g_ffn_pre + layer * DM); break; } r -= 2 * I_UP; \
            { const int layer = r / I_DN; r -= layer * I_DN; const int kb = r / 32, nb = r % 32; \
                transpose_item(a.in[28] + (size_t)layer * FFH * 1024 + nb * 32, 1024, FFH, (bf16_t*)(ws + (layer ? WS_W_DN1 : WS_W_DN0)) + (size_t)nb * 32 * FFH, kb * 64, scr, lane); } \
        } while (0)
    if (IN(0)) _Pragma("unroll") for (int rep = 0; rep < REPS(0); ++rep) {
        LAS float* scr = (LAS float*)(lds + wave * 8448);
        for (int j = gw; j < I_IN + I_OUT + I_GLU; j += NGW) { const int it = j < I_IN ? j : (j < I_IN + I_OUT ? 2 * I_IN + (j - I_IN) : 2 * I_IN + 2 * I_OUT + (j - I_IN - I_OUT)); XPOSE_ITEM(it, scr); }
        for (int idx = gt; idx < MTOK * 8; idx += NGT) { const int tok = idx >> 3, j = idx & 7; const float inv_freq = powf(500000.0f, -(float)j * 0.125f);
            const float ang = (float)positions[tok] * inv_freq; float s, c; sincos_rr(ang, s, c); ROPE[(size_t)tok * 16 + j] = c; ROPE[(size_t)tok * 16 + 8 + j] = s; }
        for (int it = gt; it < 32 * 64 * 16; it += NGT) { const int idx = it >> 4, c = it & 15, g = idx >> 6, p = idx & 63;
            const float are = a.in[8][idx], aim = a.in[9][idx], dt = expf(a.in[10][g]);
            const float xr = are * dt, yi = aim * dt; const float ex = expf(xr); float sn, cs; sincos_rr(yi, sn, cs);
            const float abr = ex * cs, abi = ex * sn;
            float sh, ch; sincos_rr(0.5f * yi, sh, ch); (void)ch;
            const float nre = expm1f(xr) * cs - 2.f * sh * sh, nim = abi;
            const float den = 1.f / (are * are + aim * aim);
            const float cre = (nre * are + nim * aim) * den, cim = (nim * are - nre * aim) * den;
            if (c == 0) { float* AB = (float*)(S5T + S5_ABAR); AB[idx * 2] = abr; AB[idx * 2 + 1] = abi; }
            bf16_t* BMt = (bf16_t*)(S5T + S5_BM); bf16_t* CMt = (bf16_t*)(S5T + S5_CM);
            const float bre = a.in[11][(size_t)idx * 16 + c], bim = a.in[12][(size_t)idx * 16 + c];
            BMt[((size_t)g * 128 + 2 * p) * 32 + c] = (bf16_t)f2bf(cre * bre - cim * bim); BMt[((size_t)g * 128 + 2 * p + 1) * 32 + c] = (bf16_t)f2bf(cre * bim + cim * bre);
            BMt[((size_t)g * 128 + 2 * p) * 32 + 16 + c] = 0; BMt[((size_t)g * 128 + 2 * p + 1) * 32 + 16 + c] = 0;
            CMt[((size_t)g * 16 + c) * 128 + 2 * p] = (bf16_t)f2bf(a.in[13][((size_t)g * 16 + c) * 64 + p]); CMt[((size_t)g * 16 + c) * 128 + 2 * p + 1] = (bf16_t)f2bf(-a.in[14][((size_t)g * 16 + c) * 64 + p]); }
        for (int idx = gt; idx < 1024; idx += NGT) SP[idx] = log1pf(expf(-a.in[25][idx]));
        rows_phase(x_in, HN, RSTD, gw, NGW, lane);
    }
    SEAM(0);
    if (IN(1)) _Pragma("unroll") for (int rep = 0; rep < REPS(1); ++rep) { pg8::Gemm g{HN, (const bf16_t*)(ws + WS_W_IN0), MTOK, 2048, 1024, 1024, 0}; pg8::StaticOrder S; S.init(MTOK, 2048, G, bx);
        pg8::EpiRope E{Z, ROPE, RSTD}; pg8::gemm_phase(lds, g, S, E); }
    SEAM(1);
    if (IN(2)) _Pragma("unroll") for (int rep = 0; rep < REPS(2); ++rep) {
        if (wave < 4) { for (int u = bx; u < 256; u += G) s5_unit(Z, S5T, a.in[15], Y5, lds, u, wave, lane); }
        else {
            LAS float* scr2 = (LAS float*)(lds + 56 * 1024 + (wave - 4) * 8448);
            constexpr int NLATE = I_IN + I_OUT + I_GATE + 2 * I_UP + 2 * I_DN;
            for (int k = bx * 4 + (wave - 4); k < NLATE; k += G * 4) { const int it = k < I_IN ? I_IN + k : (k < I_IN + I_OUT ? 2 * I_IN + I_OUT + (k - I_IN) : 2 * I_IN + 2 * I_OUT + I_GLU + (k - I_IN - I_OUT)); XPOSE_ITEM(it, scr2); }
        }
        attn_phase(Z, PO, PM, PL, lds, bx, G, tid, wave, lane);
    }
    SEAM(2);
    if (IN(3)) _Pragma("unroll") for (int rep = 0; rep < REPS(3); ++rep) {
        for (int idx0 = gt; idx0 < MTOK * 64; idx0 += 4 * NGT) {
            float mv[4][3], lv[4][3]; u32x4 ow[4][3];
#pragma unroll
            for (int r = 0; r < 4; ++r) { const int idx = idx0 + r * NGT, row = idx >> 6, c8 = idx & 63, h = c8 >> 3;
#pragma unroll
                for (int i = 0; i < 3; ++i) { mv[r][i] = PM[((size_t)i * MTOK + row) * 8 + h]; lv[r][i] = PL[((size_t)i * MTOK + row) * 8 + h]; ow[r][i] = *(const u32x4*)(PO + ((size_t)i * MTOK + row) * 512 + c8 * 8); } }
#pragma unroll
            for (int r = 0; r < 4; ++r) { const int idx = idx0 + r * NGT, row = idx >> 6, c8 = idx & 63;
                const float mx = fmaxf(mv[r][0], fmaxf(mv[r][1], mv[r][2]));
                float w[3]; float den = 0.f;
#pragma unroll
                for (int i = 0; i < 3; ++i) { w[i] = fast_exp2(mv[r][i] - mx) * lv[r][i]; den += w[i]; }
                const float inv = 1.f / den; f32x4 v0 = {0.f, 0.f, 0.f, 0.f}, v1 = v0;
#pragma unroll
                for (int i = 0; i < 3; ++i) { const float ww = w[i] * inv;
                    v0[0] += ww * bflo(ow[r][i].x); v0[1] += ww * bfhi(ow[r][i].x); v0[2] += ww * bflo(ow[r][i].y); v0[3] += ww * bfhi(ow[r][i].y);
                    v1[0] += ww * bflo(ow[r][i].z); v1[1] += ww * bfhi(ow[r][i].z); v1[2] += ww * bflo(ow[r][i].w); v1[3] += ww * bfhi(ow[r][i].w); }
                pg8::st8(YC + (size_t)row * 1024 + c8 * 8, v0, v1); } }
        __syncthreads();
        pg8::Gemm g{Y5, (const bf16_t*)(ws + WS_W_GLU), MTOK, 512, 512, 512, 0}; pg8::StaticOrder S; S.init(MTOK, 512, G, bx);
        pg8::EpiGlu E{Y5, YC}; pg8::gemm_phase(lds, g, S, E);
    }
    SEAM(3);
    if (IN(4)) _Pragma("unroll") for (int rep = 0; rep < REPS(4); ++rep) { pg8::Gemm g{YC, (const bf16_t*)(ws + WS_W_OUT0), MTOK, 1024, 1024, 1024, 0}; pg8::StaticOrder S; S.init(MTOK, 1024, G, bx);
        pg8::EpiPlain E{MIX, 1024}; pg8::gemm_phase(lds, g, S, E); }
    SEAM(4);
    if (IN(5)) _Pragma("unroll") for (int rep = 0; rep < REPS(5); ++rep) resnorm_phase<false, false>(HN, MIX, g_mix_post, HN, RSTD, gw, NGW, lane);
    SEAM(5);
    if (IN(6)) _Pragma("unroll") for (int rep = 0; rep < REPS(6); ++rep) { pg8::Gemm g{HN, (const bf16_t*)(ws + WS_W_UP0), MTOK, 2 * FFH, 1024, 1024, 0}; pg8::StaticOrder S; S.init(MTOK, 2 * FFH, G, bx);
        pg8::EpiSwiGlu E{HID, RSTD}; pg8::gemm_phase(lds, g, S, E); }
    SEAM(6);
    if (IN(7)) _Pragma("unroll") for (int rep = 0; rep < REPS(7); ++rep) { pg8::Gemm g{HID, (const bf16_t*)(ws + WS_W_DN0), MTOK, 1024, FFH, FFH, 0}; pg8::StaticOrder S; S.init(MTOK, 1024, G, bx);
        pg8::EpiPlain E{MIX, 1024}; pg8::gemm_phase(lds, g, S, E); }
    SEAM(7);
    if (IN(8)) _Pragma("unroll") for (int rep = 0; rep < REPS(8); ++rep) resnorm_phase<false, false>(HN, MIX, g_ffn_post, HN, RSTD, gw, NGW, lane);
    SEAM(8);
    if (IN(9)) _Pragma("unroll") for (int rep = 0; rep < REPS(9); ++rep) { pg8::Gemm g{HN, (const bf16_t*)(ws + WS_W_IN1), MTOK, 2048, 1024, 1024, 0}; pg8::StaticOrder S; S.init(MTOK, 2048, G, bx);
        pg8::EpiIn1 E{Z, RSTD}; pg8::gemm_phase(lds, g, S, E); }
    SEAM(9);
    if (IN(10)) _Pragma("unroll") for (int rep = 0; rep < REPS(10); ++rep) {
        const float* cw = a.in[19]; const float* cb = a.in[20];
        constexpr int RB = 16;
        for (int idx = gt; idx < (MTOK / RB) * 128; idx += NGT) { const int c8 = idx & 127, tb = idx >> 7, row0 = tb * RB, c0 = c8 * 8; const int t0 = row0 & (SEQ - 1);
            u32x4 xr[RB + 3];
#pragma unroll
            for (int k = 0; k < RB + 3; ++k) { xr[k] = (u32x4){0u, 0u, 0u, 0u}; if (k >= 3 || t0 > 0) xr[k] = *(const u32x4*)(Z + (size_t)(row0 - 3 + k) * 2048 + c0); }
            float w[4][8], bias[8];
#pragma unroll
            for (int k = 0; k < 4; ++k) { const f32x4 wa = *(const f32x4*)(cw + k * 1024 + c0), wb = *(const f32x4*)(cw + k * 1024 + c0 + 4);
                w[k][0] = wa.x; w[k][1] = wa.y; w[k][2] = wa.z; w[k][3] = wa.w; w[k][4] = wb.x; w[k][5] = wb.y; w[k][6] = wb.z; w[k][7] = wb.w; }
            { const f32x4 ba = *(const f32x4*)(cb + c0), bb = *(const f32x4*)(cb + c0 + 4); bias[0] = ba.x; bias[1] = ba.y; bias[2] = ba.z; bias[3] = ba.w; bias[4] = bb.x; bias[5] = bb.y; bias[6] = bb.z; bias[7] = bb.w; }
            float xm[3][8];
#pragma unroll
            for (int k = 0; k < 3; ++k) { const u32x4 v = xr[k];
                xm[k][0] = bflo(v.x); xm[k][1] = bfhi(v.x); xm[k][2] = bflo(v.y); xm[k][3] = bfhi(v.y); xm[k][4] = bflo(v.z); xm[k][5] = bfhi(v.z); xm[k][6] = bflo(v.w); xm[k][7] = bfhi(v.w); }
#pragma unroll
            for (int r = 0; r < RB; ++r) { const u32x4 v = xr[r + 3];
                const float xc[8] = {bflo(v.x), bfhi(v.x), bflo(v.y), bfhi(v.y), bflo(v.z), bfhi(v.z), bflo(v.w), bfhi(v.w)};
                f32x4 o0, o1;
#pragma unroll
                for (int i = 0; i < 8; ++i) { const float o = bias[i] + w[0][i] * xm[0][i] + w[1][i] * xm[1][i] + w[2][i] * xm[2][i] + w[3][i] * xc[i];
                    if (i < 4) o0[i] = o; else o1[i - 4] = o; xm[0][i] = xm[1][i]; xm[1][i] = xm[2][i]; xm[2][i] = xc[i]; }
                pg8::st8(XC + (size_t)(row0 + r) * 1024 + c0, o0, o1); } }
    }
    SEAM(10);
    if (IN(11)) _Pragma("unroll") for (int rep = 0; rep < REPS(11); ++rep) { pg8::Gemm g{XC, (const bf16_t*)(ws + WS_W_GATE), MTOK, 2048, 256, 1024, 1}; pg8::StaticOrder S; S.init(MTOK, 2048, G, bx);
        pg8::EpiGates E{XC, LA, BB, a.in[22], a.in[24], SP}; pg8::gemm_phase(lds, g, S, E); }
    SEAM(11);
    if (IN(12)) _Pragma("unroll") for (int rep = 0; rep < REPS(12); ++rep) {
        LAS float* car = (LAS float*)lds;
        for (int u = bx; u < 256; u += G) { const int b = u >> 3, c0 = (u & 7) * 128 + 2 * lane;
            float cin0 = 0.f, cin1 = 0.f;
            for (int r = 0; r < 8; ++r) { const size_t rbase = (size_t)b * SEQ + r * 256 + wave * 32;
                const bf16_t* la = LA + rbase * 1024 + c0; const bf16_t* bb = BB + rbase * 1024 + c0; const bf16_t* gb = Z + rbase * 2048 + 1024 + c0; bf16_t* yo = Y1 + rbase * 1024 + c0;
                unsigned lq[32], bq[32], gq[32];
#pragma unroll
                for (int i = 0; i < 32; ++i) { lq[i] = *(const unsigned*)(la + (size_t)i * 1024); bq[i] = *(const unsigned*)(bb + (size_t)i * 1024); }
#pragma unroll
                for (int i = 0; i < 32; ++i) gq[i] = *(const unsigned*)(gb + (size_t)i * 2048);
                float h0 = 0.f, h1 = 0.f, s0 = 0.f, s1 = 0.f;
#pragma unroll
                for (int i = 0; i < 32; ++i) { const float l0 = bflo(lq[i]), l1 = bfhi(lq[i]); s0 += l0; s1 += l1;
                    const float a0 = fast_exp2(l0 * LOG2E), a1 = fast_exp2(l1 * LOG2E);
                    const float b0 = sqrtf(fmaxf(1.f - a0 * a0, 0.f)) * bflo(bq[i]), b1 = sqrtf(fmaxf(1.f - a1 * a1, 0.f)) * bfhi(bq[i]);
                    bq[i] = pk2(b0, b1);
                    h0 = a0 * h0 + bflo(bq[i]); h1 = a1 * h1 + bfhi(bq[i]); }
                __syncthreads();
                *(LAS f32x4*)(car + (wave * 64 + lane) * 4) = (f32x4){fast_exp2(s0 * LOG2E), fast_exp2(s1 * LOG2E), h0, h1};
                __syncthreads();
                h0 = cin0; h1 = cin1; float e0 = cin0, e1 = cin1;
#pragma unroll
                for (int j = 0; j < 8; ++j) { const f32x4 cv = *(const LAS f32x4*)(car + (j * 64 + lane) * 4);
                    if (j < wave) { h0 = cv.x * h0 + cv.z; h1 = cv.y * h1 + cv.w; }
                    e0 = cv.x * e0 + cv.z; e1 = cv.y * e1 + cv.w; }
                cin0 = e0; cin1 = e1;
#pragma unroll
                for (int i = 0; i < 32; ++i) { h0 = fast_exp2(bflo(lq[i]) * LOG2E) * h0 + bflo(bq[i]); h1 = fast_exp2(bfhi(lq[i]) * LOG2E) * h1 + bfhi(bq[i]);
                    *(unsigned*)(yo + (size_t)i * 1024) = pk2(h0 * bflo(gq[i]), h1 * bfhi(gq[i])); }
            }
        }
    }
    SEAM(12);
    if (IN(13)) _Pragma("unroll") for (int rep = 0; rep < REPS(13); ++rep) { pg8::Gemm g{Y1, (const bf16_t*)(ws + WS_W_OUT1), MTOK, 1024, 1024, 1024, 0}; pg8::StaticOrder S; S.init(MTOK, 1024, G, bx);
        pg8::EpiPlain E{MIX, 1024}; pg8::gemm_phase(lds, g, S, E); }
    SEAM(13);
    if (IN(14)) _Pragma("unroll") for (int rep = 0; rep < REPS(14); ++rep) resnorm_phase<false, false>(HN, MIX, g_mix_post + DM, HN, RSTD, gw, NGW, lane);
    SEAM(14);
    if (IN(15)) _Pragma("unroll") for (int rep = 0; rep < REPS(15); ++rep) { pg8::Gemm g{HN, (const bf16_t*)(ws + WS_W_UP1), MTOK, 2 * FFH, 1024, 1024, 0}; pg8::StaticOrder S; S.init(MTOK, 2 * FFH, G, bx);
        pg8::EpiSwiGlu E{HID, RSTD}; pg8::gemm_phase(lds, g, S, E); }
    SEAM(15);
    if (IN(16)) _Pragma("unroll") for (int rep = 0; rep < REPS(16); ++rep) { pg8::Gemm g{HID, (const bf16_t*)(ws + WS_W_DN1), MTOK, 1024, FFH, FFH, 0}; pg8::StaticOrder S; S.init(MTOK, 1024, G, bx);
        pg8::EpiPlain E{MIX, 1024}; pg8::gemm_phase(lds, g, S, E); }
    SEAM(16);
    if (IN(17)) _Pragma("unroll") for (int rep = 0; rep < REPS(17); ++rep) resnorm_phase<false, true>(HN, MIX, g_ffn_post + DM, X, nullptr, gw, NGW, lane);
    if (TSEL_LO >= 0) { xcd_barrier((unsigned*)(ws + WS_CTL), bst); STAMP(18);
        if (blockIdx.x == 0 && threadIdx.x == 0) { volatile LAS unsigned long long* ts = (volatile LAS unsigned long long*)(lds + LDS_MISC + 64);
            float acc_us = 0.f; for (int k = TSEL_LO; k < TSEL_HI; k += TSEL_STEP) acc_us += (float)(ts[k + 1] - ts[k]) * 0.01f;
            a.out[0] = (float)((int)(acc_us * 0.05f + 0.5f)) * 20.f; } }
#undef IN
#undef SEAM
#undef a
#undef ws
}
constexpr int NPHASES = 18;

extern "C" void kernel_launch(void* const* d_in, const int* in_sizes, int n_in, void* d_out, int out_size, void* d_ws, size_t ws_size, hipStream_t stream) {
    static int grid = 0;
    if (grid == 0) {
        if (n_in != 29 || in_sizes[0] != MTOK * DM || out_size != MTOK * DM || ws_size < WS_END) {
            fprintf(stderr, "kernel_launch: unexpected shapes: n_in %d in0 %d out %d ws %zu (need %zu)\n", n_in, n_in > 0 ? in_sizes[0] : -1, out_size, ws_size, (size_t)WS_END); grid = -1; return; }
        int dev = 0, cus = 0, per_cu = 0;
        hipGetDevice(&dev); hipDeviceGetAttribute(&cus, hipDeviceAttributeMultiprocessorCount, dev);
        if (hipFuncSetAttribute((const void*)mega, hipFuncAttributeMaxDynamicSharedMemorySize, LDS_BYTES) != hipSuccess) { fprintf(stderr, "kernel_launch: hipFuncSetAttribute failed\n"); grid = -1; return; }
        if (hipOccupancyMaxActiveBlocksPerMultiprocessor(&per_cu, (const void*)mega, NTHREADS, LDS_BYTES) != hipSuccess || per_cu < 1) { fprintf(stderr, "kernel_launch: occupancy query says %d\n", per_cu); per_cu = 1; }
        (void)hipGetLastError();
        grid = cus;
    }
    if (grid < 0) return;
    if (hipMemsetAsync((char*)d_ws + WS_CTL, 0, CTL_BYTES, stream) != hipSuccess) { fprintf(stderr, "kernel_launch: memset failed\n"); return; }
    Args a{};
    for (int i = 0; i < 29; ++i) a.in[i] = (const float*)d_in[i];
    a.out = (float*)d_out; a.ws = (unsigned char*)d_ws;
#if N_LAUNCH_MODE == 1
    a.ph_lo = 0; a.ph_hi = NPHASES;
    void* args[] = {&a};
    hipError_t e = hipLaunchCooperativeKernel((const void*)mega, dim3(grid), dim3(NTHREADS), args, LDS_BYTES, stream);
    if (e != hipSuccess) fprintf(stderr, "cooperative launch failed: %s (grid %d)\n", hipGetErrorString(e), grid);
#else
    for (int ph = 0; ph < NPHASES; ++ph) { a.ph_lo = ph; a.ph_hi = ph + 1; hipLaunchKernelGGL(mega, dim3(grid), dim3(NTHREADS), LDS_BYTES, stream, a); }
#endif
}
```

```cpp
#include <hip/hip_runtime.h>
#include <hip/hip_cooperative_groups.h>
#include <cstdio>
#include <cstdint>
namespace cg = cooperative_groups;

#ifndef N_LAUNCH_MODE
#define N_LAUNCH_MODE 1
#endif

#define LAS __attribute__((address_space(3)))
typedef unsigned short bf16_t;
typedef short bf16x8 __attribute__((ext_vector_type(8)));
typedef float f32x4 __attribute__((ext_vector_type(4)));
typedef unsigned u32x4 __attribute__((ext_vector_type(4)));
typedef unsigned u32x2 __attribute__((ext_vector_type(2)));
typedef float f32x2 __attribute__((ext_vector_type(2)));

constexpr int MTOK = 65536, DM = 1024, SEQ = 2048, NBATCH = 32, FFH = 2816;
constexpr float NORM_EPS = 1e-6f;
constexpr float LOG2E = 1.4426950408889634f;
constexpr int NWAVES = 8, NTHREADS = 512;
constexpr int LDS_BYTES = 136 * 1024;

constexpr size_t MiB = 1u << 20;
constexpr size_t WS_CTL = 0;
constexpr size_t WS_W_IN0 = 1 * MiB, WS_W_OUT0 = 5 * MiB, WS_W_GLU = 7 * MiB, WS_W_IN1 = 8 * MiB, WS_W_OUT1 = 12 * MiB, WS_W_GATE = 14 * MiB;
constexpr size_t WS_W_UP0 = 15 * MiB, WS_W_UP1 = 26 * MiB, WS_W_DN0 = 37 * MiB, WS_W_DN1 = 43 * MiB;
constexpr size_t WS_ROPE = 49 * MiB;
constexpr size_t WS_S5TAB = 53 * MiB;
constexpr size_t S5_ABAR = 0, S5_BM = 16384, S5_CM = 16384 + 262144, S5_SP = 16384 + 262144 + 131072;
constexpr size_t WS_HN = 64 * MiB, WS_Z = 192 * MiB, WS_YC = 448 * MiB, WS_MIX = 576 * MiB, WS_PO = 704 * MiB, WS_PM = 896 * MiB, WS_PL = 902 * MiB, WS_Y5 = 908 * MiB;
constexpr size_t WS_HID = 192 * MiB;
constexpr size_t WS_XC = 448 * MiB, WS_BB = 576 * MiB, WS_Y1 = 704 * MiB, WS_LA = 832 * MiB;
constexpr size_t WS_END = 972 * MiB;

struct Args { const float* in[29]; float* out; unsigned char* ws; int ph_lo, ph_hi; };

__device__ __forceinline__ unsigned f2bf(float f) { unsigned u = __builtin_bit_cast(unsigned, f); return (u + 0x7fffu + ((u >> 16) & 1u)) >> 16; }
__device__ __forceinline__ unsigned pk2(float lo, float hi) { unsigned r; asm("v_cvt_pk_bf16_f32 %0, %1, %2" : "=v"(r) : "v"(lo), "v"(hi)); return r; }
__device__ __forceinline__ float bf2f(unsigned short h) { return __builtin_bit_cast(float, (unsigned)h << 16); }
__device__ __forceinline__ float bflo(unsigned w) { return __builtin_bit_cast(float, w << 16); }
__device__ __forceinline__ float bfhi(unsigned w) { return __builtin_bit_cast(float, w & 0xffff0000u); }
__device__ __forceinline__ float fast_exp2(float x) { return __builtin_amdgcn_exp2f(x); }
__device__ __forceinline__ float fast_rcp(float x) { return __builtin_amdgcn_rcpf(x); }
__device__ __forceinline__ float sigmoidf_(float x) { return fast_rcp(1.f + fast_exp2(-x * LOG2E)); }
__device__ __forceinline__ float gelu_tanh(float x) { const float u = 0.7978845608028654f * (x + 0.044715f * x * x * x); return x * sigmoidf_(2.f * u); }
__device__ __forceinline__ float wave_sum(float v) {
#pragma unroll
    for (int o = 1; o < 64; o <<= 1) v += __shfl_xor(v, o);
    return v;
}
#define LDS_WAIT() asm volatile("s_waitcnt lgkmcnt(0)" ::: "memory")

namespace pg8 {
constexpr int BM = 256, BK = 64, HALF = 128, HTB = HALF * BK * 2, STAGE_BYTES = 8 * HTB, NXCD = 8, WGM = 8;
__host__ __device__ __forceinline__ int lds_byte(int r, int c) { const int st = (r >> 4) * 2 + (c >> 5), rr = r & 15, cc = c & 31, ob = rr * 64 + cc * 2; return st * 1024 + (ob ^ (((ob >> 9) & 1) << 5)); }
__host__ __device__ __forceinline__ void stage_rc(int b, int& R, int& C) { const int st = b / 1024, sb = b % 1024, swz = sb ^ (((sb >> 9) & 1) << 5); R = (st >> 1) * 16 + swz / 64; C = (st & 1) * 32 + (swz % 64) / 2; }
__host__ __device__ __forceinline__ int perm32(int rho) { const int n = rho >> 4, i = rho & 15; return 8 * (i >> 2) + 4 * n + (i & 3); }
struct Unit { int pm, pn; };
struct Gemm { const bf16_t* A; const bf16_t* Bt; int M, N, K, lda, grp; };
struct StaticOrder {
    int nM, nN, nwg, G, c;
    __host__ __device__ void init(int M, int N, int G_, int c_) { nM = M / BM; nN = N / BM; nwg = nM * nN; G = G_; c = c_; }
    __host__ __device__ bool next(int i, Unit& u) const {
        const long L = (long)i * G + c; if (L >= nwg) return false;
        int wgid = (int)L; { const int q = nwg / NXCD, r = nwg % NXCD, xcd = wgid % NXCD, off = wgid / NXCD; wgid = (xcd < r ? xcd * (q + 1) : r * (q + 1) + (xcd - r) * q) + off; }
        const int nig = WGM * nN, gid = wgid / nig, fm = gid * WGM, gsz = (nM - fm) < WGM ? (nM - fm) : WGM;
        u.pm = fm + ((wgid % nig) % gsz); u.pn = (wgid % nig) / gsz; return true;
    }
};
template <class Epi>
__device__ __forceinline__ void gemm_phase(LAS unsigned char* lds, const Gemm g, const StaticOrder& S, const Epi& E) {
    int tid_ = threadIdx.x; asm volatile("" : "+v"(tid_));
    const int tid = tid_, wid = __builtin_amdgcn_readfirstlane(tid >> 6), lane = tid & 63, wr = wid >> 2, wc = wid & 3, fr = lane & 15, fq = lane >> 4;
    const int K = g.K, nt = K / BK, lda = g.lda;
    unsigned voffA[2], voffB[2];
#pragma unroll
    for (int i = 0; i < 2; ++i) { int R, C; stage_rc(tid * 16 + i * 8192, R, C); const int Rb = (R & ~31) + perm32(R & 31);
        voffA[i] = (unsigned)(R * lda + C) * 2u; voffB[i] = (unsigned)(Rb * K + C) * 2u; }
    const size_t kstep = (size_t)(BK * 2);
    const size_t hstepA = (size_t)HALF * lda * 2, hstepB = (size_t)HALF * K * 2;
    const size_t tstepA = 2 * hstepA, tstepB = 2 * hstepB;
    const unsigned ldsw = (unsigned)wid * 1024u;
    const int aoff = lds_byte(wr * 64 + fr, fq * 8), boff = lds_byte(wc * 32 + fr, fq * 8);
#define PG8_SA(b, h) (((b) * 2 + (h)) * HTB)
#define PG8_SB(b, h) ((4 + (b) * 2 + (h)) * HTB)
#define PG8_STAGE(bufoff, gbase, voff) do { _Pragma("unroll") for (int _i = 0; _i < 2; ++_i) \
        __builtin_amdgcn_global_load_lds((const unsigned*)((const char*)(gbase) + (voff)[_i]), (LAS unsigned*)(lds + (bufoff) + ldsw + _i * 8192), 16, 0, 0); } while (0)
#define PG8_LDA(dst, b, h) do { _Pragma("unroll") for (int m = 0; m < 4; ++m) _Pragma("unroll") for (int k = 0; k < 2; ++k) dst[m][k] = *(const LAS bf16x8*)(lds + PG8_SA(b, h) + aoff + m * 2048 + k * 1024); } while (0)
#define PG8_LDB(dst, b, h) do { _Pragma("unroll") for (int n = 0; n < 2; ++n) _Pragma("unroll") for (int k = 0; k < 2; ++k) dst[n][k] = *(const LAS bf16x8*)(lds + PG8_SB(b, h) + boff + n * 2048 + k * 1024); } while (0)
#define PG8_MMA(ai, bj, At, Bt) do { __builtin_amdgcn_s_setprio(1); _Pragma("unroll") for (int m = 0; m < 4; ++m) _Pragma("unroll") for (int n = 0; n < 2; ++n) _Pragma("unroll") for (int k = 0; k < 2; ++k) \
        acc[ai][bj][m][n] = __builtin_amdgcn_mfma_f32_16x16x32_bf16(Bt[n][k], At[m][k], acc[ai][bj][m][n], 0, 0, 0); __builtin_amdgcn_s_setprio(0); } while (0)
#define PG8_WAIT_V(n) asm volatile("s_waitcnt vmcnt(" #n ")" ::: "memory")
#define PG8_WAIT_L(n) asm volatile("s_waitcnt lgkmcnt(" #n ")" ::: "memory")
#define PG8_BAR __builtin_amdgcn_s_barrier()
#define PG8_SCHED __builtin_amdgcn_sched_barrier(0)
    Unit cur, nxt; int ui = 0;
    if (!S.next(0, cur)) return;
    f32x4 acc[2][2][4][2];
#pragma unroll
    for (int a = 0; a < 2; ++a)
#pragma unroll
        for (int b = 0; b < 2; ++b)
#pragma unroll
            for (int m = 0; m < 4; ++m)
#pragma unroll
                for (int n = 0; n < 2; ++n) acc[a][b][m][n] = (f32x4){0.f, 0.f, 0.f, 0.f};
    bf16x8 At[4][2], B0[2][2], B1[2][2];
    const char* cA = (const char*)g.A + (size_t)cur.pm * tstepA + (g.grp ? (size_t)(cur.pn >> 1) * K * 2 : 0); const char* cB = (const char*)g.Bt + (size_t)cur.pn * tstepB;
    PG8_STAGE(PG8_SB(0, 0), cB, voffB); PG8_STAGE(PG8_SB(0, 1), cB + hstepB, voffB); PG8_STAGE(PG8_SA(0, 0), cA, voffA); PG8_STAGE(PG8_SA(0, 1), cA + hstepA, voffA);
    if (wr == 1) PG8_BAR;
    PG8_WAIT_V(2); PG8_BAR;
    PG8_STAGE(PG8_SB(1, 0), cB + kstep, voffB); PG8_STAGE(PG8_SA(1, 0), cA + kstep, voffA); PG8_STAGE(PG8_SB(1, 1), cB + hstepB + kstep, voffB);
    PG8_WAIT_V(6); PG8_BAR;
    for (;;) {
        const bool has_next = S.next(ui + 1, nxt);
        const char* nA = has_next ? (const char*)g.A + (size_t)nxt.pm * tstepA + (g.grp ? (size_t)(nxt.pn >> 1) * K * 2 : 0) : cA; const char* nB = has_next ? (const char*)g.Bt + (size_t)nxt.pn * tstepB : cB;
        for (int t = 0; t < nt; t += 2) {
            const bool last = (t == nt - 2);
            const char* a1 = cA + (size_t)(t + 1) * kstep;
            const char* a2 = last ? nA : cA + (size_t)(t + 2) * kstep; const char* b2 = last ? nB : cB + (size_t)(t + 2) * kstep;
            const char* a3 = a2 + kstep; const char* b3 = b2 + kstep;
            PG8_LDB(B0, 0, 0); PG8_LDB(B1, 0, 1); PG8_SCHED; PG8_LDA(At, 0, 0); PG8_STAGE(PG8_SA(1, 1), a1 + hstepA, voffA);
            PG8_WAIT_V(8); PG8_WAIT_L(0); PG8_BAR; PG8_MMA(0, 0, At, B0); PG8_MMA(0, 1, At, B1); PG8_BAR; PG8_SCHED;
            PG8_LDA(At, 0, 1); PG8_STAGE(PG8_SB(0, 0), b2, voffB); PG8_STAGE(PG8_SB(0, 1), b2 + hstepB, voffB); PG8_STAGE(PG8_SA(0, 0), a2, voffA);
            PG8_WAIT_V(8); PG8_WAIT_L(0); PG8_BAR; PG8_MMA(1, 0, At, B0); PG8_MMA(1, 1, At, B1); PG8_BAR; PG8_SCHED;
            PG8_LDB(B0, 1, 0); PG8_LDB(B1, 1, 1); PG8_SCHED; PG8_LDA(At, 1, 0); PG8_STAGE(PG8_SA(0, 1), a2 + hstepA, voffA);
            PG8_WAIT_V(8); PG8_WAIT_L(0); PG8_BAR; PG8_MMA(0, 0, At, B0); PG8_MMA(0, 1, At, B1); PG8_BAR; PG8_SCHED;
            PG8_LDA(At, 1, 1); PG8_STAGE(PG8_SB(1, 0), b3, voffB); PG8_STAGE(PG8_SB(1, 1), b3 + hstepB, voffB); PG8_STAGE(PG8_SA(1, 0), a3, voffA);
            PG8_WAIT_V(8); PG8_WAIT_L(0); PG8_BAR; PG8_MMA(1, 0, At, B0); PG8_MMA(1, 1, At, B1); PG8_BAR; PG8_SCHED;
        }
        if (wr == 0) PG8_BAR;
        E(acc, cur, wr, wc, fr, fq);
        if (!has_next) break;
#pragma unroll
        for (int a = 0; a < 2; ++a)
#pragma unroll
            for (int b = 0; b < 2; ++b)
#pragma unroll
                for (int m = 0; m < 4; ++m)
#pragma unroll
                    for (int n = 0; n < 2; ++n) acc[a][b][m][n] = (f32x4){0.f, 0.f, 0.f, 0.f};
        cur = nxt; cA = nA; cB = nB; ++ui;
        if (wr == 1) PG8_BAR;
    }
    PG8_WAIT_V(0);
    PG8_BAR;
#undef PG8_SA
#undef PG8_SB
#undef PG8_STAGE
#undef PG8_LDA
#undef PG8_LDB
#undef PG8_MMA
#undef PG8_WAIT_V
#undef PG8_WAIT_L
#undef PG8_BAR
#undef PG8_SCHED
}
typedef f32x4 AccT[2][2][4][2];

__device__ __forceinline__ void st8(bf16_t* p, f32x4 v0, f32x4 v1) {
    u32x4 w; w.x = pk2(v0[0], v0[1]); w.y = pk2(v0[2], v0[3]); w.z = pk2(v1[0], v1[1]); w.w = pk2(v1[2], v1[3]); *(u32x4*)p = w;
}
struct EpiPlain {
    bf16_t* O; int ldc;
    __device__ __forceinline__ void operator()(const AccT& acc, const Unit& u, int wr, int wc, int fr, int fq) const {
        const int row0 = u.pm * BM + wr * 64 + fr, col0 = u.pn * BM + wc * 32 + 8 * fq;
#pragma unroll
        for (int ai = 0; ai < 2; ++ai)
#pragma unroll
            for (int m = 0; m < 4; ++m) { bf16_t* rowp = O + (size_t)(row0 + ai * HALF + m * 16) * ldc + col0;
#pragma unroll
                for (int bj = 0; bj < 2; ++bj) st8(rowp + bj * HALF, acc[ai][bj][m][0], acc[ai][bj][m][1]); }
    }
};
struct EpiRope {
    bf16_t* Z; const float* rope; const float* rstd;
    __device__ __forceinline__ void operator()(const AccT& acc, const Unit& u, int wr, int wc, int fr, int fq) const {
        const int row0 = u.pm * BM + wr * 64 + fr, col0 = u.pn * BM + wc * 32 + 8 * fq;
        const bool ropew = (u.pn < 4) && !(wc & 1); const float sc = (u.pn < 2) ? 0.125f * LOG2E : 1.f;
#pragma unroll
        for (int ai = 0; ai < 2; ++ai)
#pragma unroll
            for (int m = 0; m < 4; ++m) { const int row = row0 + ai * HALF + m * 16; bf16_t* rowp = Z + (size_t)row * 2048 + col0;
                f32x4 c0 = {1.f, 1.f, 1.f, 1.f}, c1 = c0, s0 = {0.f, 0.f, 0.f, 0.f}, s1 = s0;
                if (ropew && fq < 2) { const f32x4* rp = (const f32x4*)(rope + (size_t)row * 16); c0 = rp[0]; c1 = rp[1]; s0 = rp[2]; s1 = rp[3]; if (fq == 0) { s0 = -s0; s1 = -s1; } }
                const float rs = rstd[row] * sc;
#pragma unroll
                for (int bj = 0; bj < 2; ++bj) { f32x4 v0 = acc[ai][bj][m][0] * rs, v1 = acc[ai][bj][m][1] * rs;
                    if (ropew) { f32x4 p0, p1;
#pragma unroll
                        for (int i = 0; i < 4; ++i) { p0[i] = __shfl_xor(v0[i], 16); p1[i] = __shfl_xor(v1[i], 16); }
                        v0 = v0 * c0 + p0 * s0; v1 = v1 * c1 + p1 * s1; }
                    st8(rowp + bj * HALF, v0, v1); } }
    }
};
struct EpiGlu {
    const bf16_t* Y; bf16_t* O;
    __device__ __forceinline__ void operator()(const AccT& acc, const Unit& u, int wr, int wc, int fr, int fq) const {
        const int row0 = u.pm * BM + wr * 64 + fr, col0 = u.pn * BM + wc * 32 + 8 * fq;
#pragma unroll
        for (int ai = 0; ai < 2; ++ai)
#pragma unroll
            for (int m = 0; m < 4; ++m) { const int row = row0 + ai * HALF + m * 16;
#pragma unroll
                for (int bj = 0; bj < 2; ++bj) { const int col = col0 + bj * HALF; const u32x4 yw = *(const u32x4*)(Y + (size_t)row * 512 + col);
                    f32x4 a0 = acc[ai][bj][m][0], a1 = acc[ai][bj][m][1], v0, v1;
                    v0[0] = bflo(yw.x) * sigmoidf_(a0[0]); v0[1] = bfhi(yw.x) * sigmoidf_(a0[1]); v0[2] = bflo(yw.y) * sigmoidf_(a0[2]); v0[3] = bfhi(yw.y) * sigmoidf_(a0[3]);
                    v1[0] = bflo(yw.z) * sigmoidf_(a1[0]); v1[1] = bfhi(yw.z) * sigmoidf_(a1[1]); v1[2] = bflo(yw.w) * sigmoidf_(a1[2]); v1[3] = bfhi(yw.w) * sigmoidf_(a1[3]);
                    st8(O + (size_t)row * 1024 + 512 + col, v0, v1); } }
    }
};
struct EpiSwiGlu {
    bf16_t* O; const float* rstd;
    __device__ __forceinline__ void operator()(const AccT& acc, const Unit& u, int wr, int wc, int fr, int fq) const {
        const int row0 = u.pm * BM + wr * 64 + fr, col0 = u.pn * HALF + wc * 32 + 8 * fq;
#pragma unroll
        for (int ai = 0; ai < 2; ++ai)
#pragma unroll
            for (int m = 0; m < 4; ++m) { const int row = row0 + ai * HALF + m * 16; f32x4 v[2]; const float rs = rstd[row], rs2 = rs * rs, rsl = -rs * LOG2E;
#pragma unroll
                for (int n = 0; n < 2; ++n)
#pragma unroll
                    for (int i = 0; i < 4; ++i) { const float g0 = acc[ai][0][m][n][i], u0 = acc[ai][1][m][n][i];
                        v[n][i] = (g0 * u0) * (rs2 * fast_rcp(1.f + fast_exp2(g0 * rsl))); }
                st8(O + (size_t)row * FFH + col0, v[0], v[1]); }
    }
};
struct EpiIn1 {
    bf16_t* Z; const float* rstd;
    __device__ __forceinline__ void operator()(const AccT& acc, const Unit& u, int wr, int wc, int fr, int fq) const {
        const int row0 = u.pm * BM + wr * 64 + fr, col0 = u.pn * BM + wc * 32 + 8 * fq; const bool act = u.pn >= 4;
#pragma unroll
        for (int ai = 0; ai < 2; ++ai)
#pragma unroll
            for (int m = 0; m < 4; ++m) { bf16_t* rowp = Z + (size_t)(row0 + ai * HALF + m * 16) * 2048 + col0; const float rs = rstd[row0 + ai * HALF + m * 16];
#pragma unroll
                for (int bj = 0; bj < 2; ++bj) { f32x4 v0 = acc[ai][bj][m][0] * rs, v1 = acc[ai][bj][m][1] * rs;
                    if (act) {
#pragma unroll
                        for (int i = 0; i < 4; ++i) { v0[i] = gelu_tanh(v0[i]); v1[i] = gelu_tanh(v1[i]); } }
                    st8(rowp + bj * HALF, v0, v1); } }
    }
};
struct EpiGates {
    const bf16_t* XC; bf16_t* LA; bf16_t* BB; const float* b_r; const float* b_i; const float* sp;
    __device__ __forceinline__ void operator()(const AccT& acc, const Unit& u, int wr, int wc, int fr, int fq) const {
        const int row0 = u.pm * BM + wr * 64 + fr, c0 = (u.pn >> 1) * 256 + (u.pn & 1) * 128 + wc * 32 + 8 * fq;
        f32x4 br[2], bi[2], spv[2];
#pragma unroll
        for (int n = 0; n < 2; ++n) { br[n] = *(const f32x4*)(b_r + c0 + 4 * n) * (-LOG2E); bi[n] = *(const f32x4*)(b_i + c0 + 4 * n) * (-LOG2E); spv[n] = *(const f32x4*)(sp + c0 + 4 * n) * (-8.f); }
#pragma unroll
        for (int ai = 0; ai < 2; ++ai)
#pragma unroll
            for (int m = 0; m < 4; ++m) { const int row = row0 + ai * HALF + m * 16; const u32x4 xw = *(const u32x4*)(XC + (size_t)row * 1024 + c0);
                const float xv[8] = {bflo(xw.x), bfhi(xw.x), bflo(xw.y), bfhi(xw.y), bflo(xw.z), bfhi(xw.z), bflo(xw.w), bfhi(xw.w)};
                f32x4 la[2], bb[2];
#pragma unroll
                for (int n = 0; n < 2; ++n)
#pragma unroll
                    for (int i = 0; i < 4; ++i) { const float er = fast_exp2(acc[ai][0][m][n][i] * (-LOG2E) + br[n][i]), ei = fast_exp2(acc[ai][1][m][n][i] * (-LOG2E) + bi[n][i]);
                        la[n][i] = spv[n][i] * fast_rcp(1.f + er); bb[n][i] = xv[4 * n + i] * fast_rcp(1.f + ei); }
                st8(LA + (size_t)row * 1024 + c0, la[0], la[1]); st8(BB + (size_t)row * 1024 + c0, bb[0], bb[1]); __builtin_amdgcn_sched_barrier(0); }
    }
};
}

__device__ __forceinline__ void transpose_item(const float* W, int ld, int K, bf16_t* dst, int k0, LAS float* scr, int lane, const float* gk = nullptr) {
    float tv[32];
#pragma unroll
    for (int i = 0; i < 32; ++i) { const int kk = 2 * i + (lane >> 5); tv[i] = W[(size_t)(k0 + kk) * ld + (lane & 31)]; }
#pragma unroll
    for (int i = 0; i < 32; ++i) { const int kk = 2 * i + (lane >> 5); const float gs = gk ? gk[k0 + kk] : 1.f; scr[kk * 33 + (lane & 31)] = tv[i] * gs; }
    LDS_WAIT();
    const int c = lane & 7;
#pragma unroll
    for (int j = 0; j < 4; ++j) { const int n = (lane >> 3) + 8 * j; const LAS float* s = scr + (8 * c) * 33 + n;
        u32x4 o; o.x = pk2(s[0 * 33], s[1 * 33]); o.y = pk2(s[2 * 33], s[3 * 33]); o.z = pk2(s[4 * 33], s[5 * 33]); o.w = pk2(s[6 * 33], s[7 * 33]);
        *(u32x4*)(dst + (size_t)n * K + k0 + 8 * c) = o; }
    LDS_WAIT();
}
__device__ __forceinline__ void sincos_rr(float ang, float& s, float& c) {
    const double r = (double)ang * 0.15915494309189535; const double fr = r - __builtin_rint(r); const float f = (float)fr;
    s = __builtin_amdgcn_sinf(f); c = __builtin_amdgcn_cosf(f);
}
struct RowBuf { f32x4 v[2][4]; };
__device__ __forceinline__ void rows_load(RowBuf& B, const float* x, int m0, int stride, int lane) {
#pragma unroll
    for (int r = 0; r < 2; ++r) { const f32x4* xr = (const f32x4*)(x + (size_t)(m0 + r * stride) * DM) + lane;
#pragma unroll
        for (int j = 0; j < 4; ++j) B.v[r][j] = xr[64 * j]; }
}
__device__ __forceinline__ void rows_store(const RowBuf& B, bf16_t* o, float* rstd_out, int m0, int stride, int lane) {
    float s[2];
#pragma unroll
    for (int r = 0; r < 2; ++r) { s[r] = 0.f;
#pragma unroll
        for (int j = 0; j < 4; ++j) s[r] += (B.v[r][j].x * B.v[r][j].x + B.v[r][j].y * B.v[r][j].y) + (B.v[r][j].z * B.v[r][j].z + B.v[r][j].w * B.v[r][j].w); }
#pragma unroll
    for (int o_ = 1; o_ < 64; o_ <<= 1) {
#pragma unroll
        for (int r = 0; r < 2; ++r) s[r] += __shfl_xor(s[r], o_); }
#pragma unroll
    for (int r = 0; r < 2; ++r) { u32x2* o8 = (u32x2*)(o + (size_t)(m0 + r * stride) * DM) + lane;
#pragma unroll
        for (int j = 0; j < 4; ++j) { u32x2 w; w.x = pk2(B.v[r][j].x, B.v[r][j].y); w.y = pk2(B.v[r][j].z, B.v[r][j].w); o8[64 * j] = w; }
        if (lane == 0) rstd_out[m0 + r * stride] = 1.f / sqrtf(s[r] * (1.f / DM) + NORM_EPS); }
}
__device__ __forceinline__ void rows_phase(const float* x, bf16_t* o, float* rstd_out, int gw, int NGW, int lane) {
    RowBuf A, B; int m = gw;
    if (m + NGW >= MTOK) return;
    rows_load(A, x, m, NGW, lane);
    for (;;) {
        const int m2 = m + 2 * NGW; const bool has2 = m2 + NGW < MTOK;
        if (has2) rows_load(B, x, m2, NGW, lane);
        rows_store(A, o, rstd_out, m, NGW, lane);
        if (!has2) break;
        const int m3 = m2 + 2 * NGW; const bool has3 = m3 + NGW < MTOK;
        if (has3) rows_load(A, x, m3, NGW, lane);
        rows_store(B, o, rstd_out, m2, NGW, lane);
        if (!has3) break;
        m = m3;
    }
}
struct RnBuf { u32x2 mx[2][4]; f32x4 xf[2][4]; u32x2 xb[2][4]; };
template <bool XIN_F32>
__device__ __forceinline__ void rn_load(RnBuf& B, const void* xin, const bf16_t* mix, int m0, int stride, int lane) {
#pragma unroll
    for (int r = 0; r < 2; ++r) { const size_t ro = (size_t)(m0 + r * stride) * DM; const u32x2* mr = (const u32x2*)(mix + ro) + lane;
#pragma unroll
        for (int j = 0; j < 4; ++j) { B.mx[r][j] = mr[64 * j];
            if (XIN_F32) B.xf[r][j] = ((const f32x4*)((const float*)xin + ro) + lane)[64 * j]; else B.xb[r][j] = ((const u32x2*)((const bf16_t*)xin + ro) + lane)[64 * j]; } }
}
template <bool XIN_F32, bool OUT_F32>
__device__ __forceinline__ void rn_process(const RnBuf& B, const float* gpost, void* xout, float* rstd_out, int m0, int stride, int lane) {
    f32x4 v[2][4]; float s[2], s2[2];
#pragma unroll
    for (int r = 0; r < 2; ++r) { s[r] = 0.f;
#pragma unroll
        for (int j = 0; j < 4; ++j) { const u32x2 w = B.mx[r][j]; v[r][j] = (f32x4){bflo(w.x), bfhi(w.x), bflo(w.y), bfhi(w.y)};
            s[r] += (v[r][j].x * v[r][j].x + v[r][j].y * v[r][j].y) + (v[r][j].z * v[r][j].z + v[r][j].w * v[r][j].w); } }
#pragma unroll
    for (int o_ = 1; o_ < 64; o_ <<= 1) {
#pragma unroll
        for (int r = 0; r < 2; ++r) s[r] += __shfl_xor(s[r], o_); }
#pragma unroll
    for (int r = 0; r < 2; ++r) { const float rstd = 1.f / sqrtf(s[r] * (1.f / DM) + NORM_EPS); const size_t ro = (size_t)(m0 + r * stride) * DM; s2[r] = 0.f;
#pragma unroll
        for (int j = 0; j < 4; ++j) { const f32x4 gg = ((const f32x4*)gpost + lane)[64 * j]; f32x4 xo;
            if (XIN_F32) xo = B.xf[r][j]; else { const u32x2 w2 = B.xb[r][j]; xo = (f32x4){bflo(w2.x), bfhi(w2.x), bflo(w2.y), bfhi(w2.y)}; }
            v[r][j] = xo + v[r][j] * rstd * gg;
            s2[r] += (v[r][j].x * v[r][j].x + v[r][j].y * v[r][j].y) + (v[r][j].z * v[r][j].z + v[r][j].w * v[r][j].w);
            if (OUT_F32) ((f32x4*)((float*)xout + ro) + lane)[64 * j] = v[r][j]; else { u32x2 w; w.x = pk2(v[r][j].x, v[r][j].y); w.y = pk2(v[r][j].z, v[r][j].w); ((u32x2*)((bf16_t*)xout + ro) + lane)[64 * j] = w; } } }
    if (!OUT_F32) {
#pragma unroll
        for (int o_ = 1; o_ < 64; o_ <<= 1) {
#pragma unroll
            for (int r = 0; r < 2; ++r) s2[r] += __shfl_xor(s2[r], o_); }
#pragma unroll
        for (int r = 0; r < 2; ++r) if (lane == 0) rstd_out[m0 + r * stride] = 1.f / sqrtf(s2[r] * (1.f / DM) + NORM_EPS); }
}
template <bool XIN_F32, bool OUT_F32>
__device__ __forceinline__ void resnorm_phase(const void* xin, const bf16_t* mix, const float* gpost, void* xout, float* rstd_out, int gw, int NGW, int lane) {
    RnBuf A, B; int m = gw;
    if (m + NGW >= MTOK) return;
    rn_load<XIN_F32>(A, xin, mix, m, NGW, lane);
    for (;;) {
        const int m2 = m + 2 * NGW; const bool has2 = m2 + NGW < MTOK;
        if (has2) rn_load<XIN_F32>(B, xin, mix, m2, NGW, lane);
        rn_process<XIN_F32, OUT_F32>(A, gpost, xout, rstd_out, m, NGW, lane);
        if (!has2) break;
        const int m3 = m2 + 2 * NGW; const bool has3 = m3 + NGW < MTOK;
        if (has3) rn_load<XIN_F32>(A, xin, mix, m3, NGW, lane);
        rn_process<XIN_F32, OUT_F32>(B, gpost, xout, rstd_out, m2, NGW, lane);
        if (!has3) break;
        m = m3;
    }
}

constexpr int AT_KPITCH = 144, AT_VPITCH = 160, AT_VOFF = 256 * AT_KPITCH;
constexpr int AT_UNITS = 12288, AT_HEAD = 0;
typedef short s16x4 __attribute__((ext_vector_type(4)));
__device__ __forceinline__ int attn_seq(int bx, int G, int i) {
    if (G != 256) { const int u = bx + i * G; return u < AT_UNITS ? u : -1; }
    const int x = bx & 7, wl = bx >> 3; int L;
    if (wl >= 16) { if (i < AT_HEAD) L = (wl - 16) + 16 * i; else L = 16 * AT_HEAD + (i - AT_HEAD) * 32 + wl; }
    else L = 16 * AT_HEAD + i * 32 + wl;
    if (L >= AT_UNITS / 8) return -1;
    return (x + 8 * (L / 48)) * 48 + (L % 48);
}
#define AT_DECODE(u) const int sub = (u) & 15, br = ((u) >> 4) % 3, bh = (u) / 48, h = bh & 7, b = bh >> 3; \
    const int dil = br == 0 ? 1 : (br == 1 ? 4 : 16), nb = 16 / dil, rho = sub / nb, n = sub % nb; const bf16_t* Zb = Zp + (size_t)b * SEQ * 2048;
__device__ __forceinline__ void attn_issue(const bf16_t* Zp, int u, int tid, int wave, int lane, u32x4 (&rk)[4], u32x4 (&rv)[4], bf16x8& q0, bf16x8& q1) {
    AT_DECODE(u)
#pragma unroll
    for (int it = 0; it < 4; ++it) { if (n == 0 && it < 2) continue; const int idx = tid + it * NTHREADS, kb = idx >> 3, ch = idx & 7;
        const int tok = (n * 128 - 128 + kb) * dil + rho;
        const bf16_t* rowp = Zb + (size_t)tok * 2048 + h * 64 + ch * 8;
        rk[it] = *(const u32x4*)(rowp + 512); rv[it] = *(const u32x4*)(rowp + 1024); }
    const int kq = lane >> 4, qi = 16 * wave + (lane & 15); const int tokq = (n * 128 + qi) * dil + rho;
    const bf16_t* qrow = Zb + (size_t)tokq * 2048 + h * 64;
    q0 = *(const bf16x8*)(qrow + 8 * kq); q1 = *(const bf16x8*)(qrow + 32 + 8 * kq);
}
__device__ __forceinline__ void attn_phase(const bf16_t* Zp, bf16_t* POp, float* PMp, float* PLp, LAS unsigned char* lds, int bx, int G, int tid, int wave, int lane) {
    int ui = 0; int u = attn_seq(bx, G, 0); if (u < 0) return;
    u32x4 rk[4], rv[4]; bf16x8 q0n, q1n;
    attn_issue(Zp, u, tid, wave, lane, rk, rv, q0n, q1n);
    const int q = lane & 15, kq = lane >> 4, qi = 16 * wave + q;
    for (;;) {
        AT_DECODE(u)
        (void)Zb;
        const int kmin_ = (n == 0) ? 128 : 0; const int mlo = qi > kmin_ ? qi : kmin_; const unsigned mrange = (unsigned)(qi + 128 - mlo);
        __syncthreads();
#pragma unroll
        for (int it = 0; it < 4; ++it) { if (n == 0 && it < 2) continue; const int idx = tid + it * NTHREADS, kb = idx >> 3, ch = idx & 7;
            *(LAS u32x4*)(lds + kb * AT_KPITCH + ch * 16) = rk[it]; *(LAS u32x4*)(lds + AT_VOFF + kb * AT_VPITCH + ch * 16) = rv[it]; }
        if (n == 0 && tid < 128) *(LAS u32x4*)(lds + AT_VOFF + (112 + (tid >> 3)) * AT_VPITCH + (tid & 7) * 16) = (u32x4){0u, 0u, 0u, 0u};
        const bf16x8 qf0 = q0n, qf1 = q1n;
        __syncthreads();
        const int un = attn_seq(bx, G, ui + 1);
        if (un >= 0) attn_issue(Zp, un, tid, wave, lane, rk, rv, q0n, q1n);
        const int kstart = (16 * wave < 96) ? 16 * wave : 96;
        f32x4 st[10];
#pragma unroll
        for (int p = 0; p < 5; ++p) {
            const int ks = kstart + 32 * p;
            const bool live = !(n == 0 && ks + 32 <= 128) && !(ks + 31 < 16 * wave);
            st[2 * p] = (f32x4){-1e30f, -1e30f, -1e30f, -1e30f}; st[2 * p + 1] = st[2 * p];
            if (live) {
                const LAS unsigned char* kp = lds + (ks + q) * AT_KPITCH + kq * 16;
                const bf16x8 k00 = *(const LAS bf16x8*)(kp), k01 = *(const LAS bf16x8*)(kp + 64);
                const bf16x8 k10 = *(const LAS bf16x8*)(kp + 16 * AT_KPITCH), k11 = *(const LAS bf16x8*)(kp + 16 * AT_KPITCH + 64);
                f32x4 s0 = {0.f, 0.f, 0.f, 0.f}, s1 = {0.f, 0.f, 0.f, 0.f};
                s0 = __builtin_amdgcn_mfma_f32_16x16x32_bf16(k00, qf0, s0, 0, 0, 0); s0 = __builtin_amdgcn_mfma_f32_16x16x32_bf16(k01, qf1, s0, 0, 0, 0);
                s1 = __builtin_amdgcn_mfma_f32_16x16x32_bf16(k10, qf0, s1, 0, 0, 0); s1 = __builtin_amdgcn_mfma_f32_16x16x32_bf16(k11, qf1, s1, 0, 0, 0);
                const bool need_mask = !(ks >= 16 * wave + 15 && ks + 31 <= 16 * wave + 128) || (n == 0 && ks < 128);
                if (need_mask) {
                    const int tb = ks + 4 * kq - mlo;
#pragma unroll
                    for (int i = 0; i < 4; ++i) { s0[i] = ((unsigned)(tb + i) <= mrange) ? s0[i] : -1e30f; s1[i] = ((unsigned)(tb + 16 + i) <= mrange) ? s1[i] : -1e30f; }
                }
                st[2 * p] = s0; st[2 * p + 1] = s1;
            }
        }
        float mrun = -1e30f;
#pragma unroll
        for (int j = 0; j < 10; ++j) mrun = fmaxf(mrun, fmaxf(fmaxf(st[j][0], st[j][1]), fmaxf(st[j][2], st[j][3])));
        mrun = fmaxf(mrun, __shfl_xor(mrun, 16)); mrun = fmaxf(mrun, __shfl_xor(mrun, 32));
        float lrun = 0.f;
#pragma unroll
        for (int j = 0; j < 10; ++j)
#pragma unroll
            for (int i = 0; i < 4; ++i) { st[j][i] = fast_exp2(st[j][i] - mrun); lrun += st[j][i]; }
        f32x4 o[4];
#pragma unroll
        for (int mm = 0; mm < 4; ++mm) o[mm] = (f32x4){0.f, 0.f, 0.f, 0.f};
#pragma unroll
        for (int p = 0; p < 5; ++p) {
            const int ks = kstart + 32 * p;
            const bool live = !(n == 0 && ks + 32 <= 128) && !(ks + 31 < 16 * wave);
            if (live) {
                const LAS unsigned char* vp = lds + AT_VOFF + (ks + 4 * kq + (q >> 2)) * AT_VPITCH + (q & 3) * 8;
                u32x4 pw; pw.x = pk2(st[2 * p][0], st[2 * p][1]); pw.y = pk2(st[2 * p][2], st[2 * p][3]); pw.z = pk2(st[2 * p + 1][0], st[2 * p + 1][1]); pw.w = pk2(st[2 * p + 1][2], st[2 * p + 1][3]);
                const bf16x8 pf = __builtin_bit_cast(bf16x8, pw);
#pragma unroll
                for (int mm = 0; mm < 4; ++mm) {
                    const s16x4 vlo = __builtin_bit_cast(s16x4, __builtin_amdgcn_ds_read_tr16_b64_v4i16((LAS s16x4*)(vp + 32 * mm)));
                    const s16x4 vhi = __builtin_bit_cast(s16x4, __builtin_amdgcn_ds_read_tr16_b64_v4i16((LAS s16x4*)(vp + 16 * AT_VPITCH + 32 * mm)));
                    bf16x8 vf; vf[0] = vlo[0]; vf[1] = vlo[1]; vf[2] = vlo[2]; vf[3] = vlo[3]; vf[4] = vhi[0]; vf[5] = vhi[1]; vf[6] = vhi[2]; vf[7] = vhi[3];
                    o[mm] = __builtin_amdgcn_mfma_f32_16x16x32_bf16(vf, pf, o[mm], 0, 0, 0); }
            }
        }
        lrun += __shfl_xor(lrun, 16); lrun += __shfl_xor(lrun, 32);
        const float inv = 1.f / lrun; const int tokq = (n * 128 + qi) * dil + rho; const size_t row = (size_t)b * SEQ + tokq;
        bf16_t* orow = POp + ((size_t)br * MTOK + row) * 512 + h * 64 + 4 * kq;
#pragma unroll
        for (int mm = 0; mm < 4; ++mm) { u32x2 w; w.x = pk2(o[mm][0] * inv, o[mm][1] * inv); w.y = pk2(o[mm][2] * inv, o[mm][3] * inv); *(u32x2*)(orow + 16 * mm) = w; }
        if (kq == 0) { PMp[((size_t)br * MTOK + row) * 8 + h] = mrun; PLp[((size_t)br * MTOK + row) * 8 + h] = lrun; }
        if (un < 0) break;
        u = un; ++ui;
    }
}

constexpr int S5_BUSP = 132, S5_HSP = 136;
constexpr int S5_WAVE_BYTES = 16 * S5_BUSP * 4 + 16 * S5_HSP * 2;
__device__ __forceinline__ void s5_unit(const bf16_t* Zp, const unsigned char* tab, const float* dskip, bf16_t* Y5p, LAS unsigned char* lds, int unit, int wave, int lane) {
    const int b = unit >> 3, g = (unit & 7) * 4 + wave;
    LAS float* bus = (LAS float*)(lds + wave * S5_WAVE_BYTES);
    LAS bf16_t* hs = (LAS bf16_t*)(lds + wave * S5_WAVE_BYTES + 16 * S5_BUSP * 4);
    const int n = lane & 15, kg = lane >> 4;
    const bf16_t* BMt = (const bf16_t*)(tab + S5_BM); const bf16_t* CMt = (const bf16_t*)(tab + S5_CM); const float* AB = (const float*)(tab + S5_ABAR);
    bf16x8 bm[8], cm[4];
#pragma unroll
    for (int nt = 0; nt < 8; ++nt) bm[nt] = *(const bf16x8*)(BMt + ((size_t)(g * 128 + 16 * nt + n)) * 32 + 8 * kg);
#pragma unroll
    for (int kk = 0; kk < 4; ++kk) cm[kk] = *(const bf16x8*)(CMt + ((size_t)(g * 16 + n)) * 128 + 32 * kk + 8 * kg);
    const f32x4 dsk4 = *(const f32x4*)(dskip + g * 16 + 4 * kg);
    const float ar = AB[(g * 64 + lane) * 2], ai = AB[(g * 64 + lane) * 2 + 1];
    f32x2 hv = {0.f, 0.f}; const f32x2 a_rr = {ar, ar}, a_ii = {-ai, ai};
    const bf16_t* ub = Zp + (size_t)b * SEQ * 2048 + 1536 + g * 16;
    bf16_t* yb = Y5p + (size_t)b * SEQ * 512 + g * 16 + 4 * kg;
    LAS bf16_t* uls = (LAS bf16_t*)(lds + 8 * S5_WAVE_BYTES + wave * 1024);
    bf16x8 q1[4], q2[4];
#pragma unroll
    for (int j = 0; j < 4; ++j) { q1[j] = (bf16x8){0, 0, 0, 0, 0, 0, 0, 0}; q2[j] = q1[j];
        if (kg < 2) { q1[j] = *(const bf16x8*)(ub + (size_t)(16 * j + n) * 2048 + 8 * kg); q2[j] = *(const bf16x8*)(ub + (size_t)(64 + 16 * j + n) * 2048 + 8 * kg); } }
    {
        const bf16x8 uf = q1[0];
        if (kg < 2) *(LAS bf16x8*)(uls + n * 32 + 8 * kg) = uf;
#pragma unroll
        for (int nt = 0; nt < 8; ++nt) { f32x4 d = {0.f, 0.f, 0.f, 0.f}; d = __builtin_amdgcn_mfma_f32_16x16x32_bf16(bm[nt], uf, d, 0, 0, 0);
            *(LAS f32x4*)(bus + n * S5_BUSP + 16 * nt + 4 * kg) = d; }
    }
    u32x2 usp = {0u, 0u};
    for (int sb = 0; sb < SEQ / 64; ++sb) {
        bf16x8 ufc[4];
#pragma unroll
        for (int j = 0; j < 4; ++j) { ufc[j] = q1[j]; q1[j] = q2[j]; if (kg < 2 && sb + 2 < SEQ / 64) q2[j] = *(const bf16x8*)(ub + (size_t)((sb + 2) * 64 + 16 * j + n) * 2048 + 8 * kg); }
#pragma unroll
        for (int j = 0; j < 4; ++j) {
            asm volatile("" ::: "memory");
            const int k = 4 * sb + j;
            bf16x8 hf[4];
#pragma unroll
            for (int kk = 0; kk < 4; ++kk) hf[kk] = *(const LAS bf16x8*)(hs + n * S5_HSP + 32 * kk + 8 * kg);
            f32x2 bv[16];
#pragma unroll
            for (int t = 0; t < 16; ++t) bv[t] = *(const LAS f32x2*)(bus + t * S5_BUSP + 2 * lane);
            const u32x2 usc = *(const LAS u32x2*)(uls + n * 32 + 4 * kg);
            const bf16x8 ufn = (j < 3) ? ufc[(j + 1) & 3] : q1[0];
            f32x4 d[8];
#pragma unroll
            for (int nt = 0; nt < 8; ++nt) { d[nt] = (f32x4){0.f, 0.f, 0.f, 0.f}; d[nt] = __builtin_amdgcn_mfma_f32_16x16x32_bf16(bm[nt], ufn, d[nt], 0, 0, 0); }
            f32x4 y = {0.f, 0.f, 0.f, 0.f};
#pragma unroll
            for (int kk = 0; kk < 4; ++kk) y = __builtin_amdgcn_mfma_f32_16x16x32_bf16(cm[kk], hf[kk], y, 0, 0, 0);
#pragma unroll
            for (int t = 0; t < 16; ++t) { const f32x2 hsw = __builtin_shufflevector(hv, hv, 1, 0);
                hv = a_rr * hv + bv[t]; hv = a_ii * hsw + hv;
                *(LAS unsigned*)(hs + t * S5_HSP + 2 * lane) = pk2(hv.x, hv.y); }
#pragma unroll
            for (int nt = 0; nt < 8; ++nt) *(LAS f32x4*)(bus + n * S5_BUSP + 16 * nt + 4 * kg) = d[nt];
            if (kg < 2) *(LAS bf16x8*)(uls + n * 32 + 8 * kg) = ufn;
            if (k >= 1) {
#pragma unroll
                for (int i = 0; i < 4; ++i) { const unsigned uw = (i < 2) ? usp.x : usp.y; const float uu = (i & 1) ? bfhi(uw) : bflo(uw); y[i] = gelu_tanh(y[i] + dsk4[i] * uu); }
                u32x2 w; w.x = pk2(y[0], y[1]); w.y = pk2(y[2], y[3]); *(u32x2*)(yb + (size_t)(16 * (k - 1) + n) * 512) = w; }
#pragma unroll
            for (int i = 0; i < 1; ++i) usp = usc;
        }
    }
    {
        asm volatile("" ::: "memory");
        f32x4 y = {0.f, 0.f, 0.f, 0.f};
#pragma unroll
        for (int kk = 0; kk < 4; ++kk) { const bf16x8 hf = *(const LAS bf16x8*)(hs + n * S5_HSP + 32 * kk + 8 * kg); y = __builtin_amdgcn_mfma_f32_16x16x32_bf16(cm[kk], hf, y, 0, 0, 0); }
#pragma unroll
        for (int i = 0; i < 4; ++i) { const unsigned uw = (i < 2) ? usp.x : usp.y; const float uu = (i & 1) ? bfhi(uw) : bflo(uw); y[i] = gelu_tanh(y[i] + dsk4[i] * uu); }
        { u32x2 w; w.x = pk2(y[0], y[1]); w.y = pk2(y[2], y[3]); *(u32x2*)(yb + (size_t)(SEQ - 16 + n) * 512) = w; }
    }
    LDS_WAIT();
}

#define XB_TMO      128
#define XB_XCNT(j)  (256  + 64 * (j))
#define XB_XSUB(j)  (1280 + 64 * (j))
#define XB_XGEN(j)  (2304 + 64 * (j))
#define XB_TOP      3328
#define XB_TOPGEN   3392
#define XCD_BAR_WORDS 3456
#define XB_SPIN_CAP (1u << 22)
__device__ __forceinline__ unsigned xb_ld(unsigned* p)              { return __hip_atomic_load(p, __ATOMIC_RELAXED, __HIP_MEMORY_SCOPE_AGENT); }
__device__ __forceinline__ unsigned xb_add(unsigned* p, unsigned v) { return __hip_atomic_fetch_add(p, v, __ATOMIC_RELAXED, __HIP_MEMORY_SCOPE_AGENT); }
__device__ __forceinline__ unsigned xb_xcc_id() { return (unsigned)__builtin_amdgcn_s_getreg((3 << 11) | 20) & 0xFu; }
#define XB_SPIN(cond, bar) do { unsigned _sp = 0; while (cond) { __builtin_amdgcn_s_sleep(1); \
    if ((++_sp & 255u) == 0u) { if (xb_ld(&(bar)[XB_TMO])) break; if (_sp > XB_SPIN_CAP) { atomicAdd(&(bar)[XB_TMO], 1u); break; } } } } while (0)
__device__ __forceinline__ void xcd_barrier_complete(unsigned* bar, unsigned x, unsigned& nloc, unsigned& nx) {
    const unsigned G = gridDim.x * gridDim.y * gridDim.z;
    unsigned sum, cnt, mine, sp = 0u;
    for (;;) {
        sum = 0u; cnt = 0u; mine = 0u;
#pragma unroll
        for (unsigned j = 0; j < 16; ++j) { const unsigned c = xb_ld(&bar[XB_XCNT(j)]); sum += c; cnt += (c > 0u) ? 1u : 0u; mine = (j == x) ? c : mine; }
        if (sum == G) break;
        __builtin_amdgcn_s_sleep(1);
        if ((++sp & 255u) == 0u) { if (xb_ld(&bar[XB_TMO])) break; if (sp > XB_SPIN_CAP) { atomicAdd(&bar[XB_TMO], 1u); break; } }
    }
    nloc = mine > 0u ? mine : 1u; nx = cnt > 0u ? cnt : 1u;
}
__device__ __forceinline__ void xcd_barrier(unsigned* bar, volatile LAS unsigned* st) {
    asm volatile("s_waitcnt vmcnt(0)" ::: "memory");
    __syncthreads();
    if (threadIdx.x == 0) {
        const unsigned x = xb_xcc_id();
        __builtin_amdgcn_s_waitcnt(0);
        unsigned nloc = st[0], nx = st[1];
        if (nloc == 0u) { xcd_barrier_complete(bar, x, nloc, nx); st[0] = nloc; st[1] = nx; }
        const unsigned old = xb_add(&bar[XB_XSUB(x)], 1u);
        const unsigned gen = old / nloc;
        if (old + 1u == (gen + 1u) * nloc) {
            __builtin_amdgcn_fence(__ATOMIC_RELEASE, "agent");
            asm volatile("s_waitcnt vmcnt(0)" ::: "memory");
            const unsigned og = xb_add(&bar[XB_TOP], 1u);
            const unsigned tg = og / nx;
            if (og + 1u == (tg + 1u) * nx) xb_add(&bar[XB_TOPGEN], 1u);
            else XB_SPIN(xb_ld(&bar[XB_TOPGEN]) == tg, bar);
            __builtin_amdgcn_fence(__ATOMIC_ACQUIRE, "agent");
            xb_add(&bar[XB_XGEN(x)], 1u);
            asm volatile("s_waitcnt vmcnt(0)" ::: "memory");
        } else {
            XB_SPIN(xb_ld(&bar[XB_XGEN(x)]) == gen, bar);
            __builtin_amdgcn_fence(__ATOMIC_ACQUIRE, "agent");
            asm volatile("s_waitcnt vmcnt(0)" ::: "memory");
        }
    }
    __syncthreads();
}
constexpr int LDS_MISC = 135 * 1024;
constexpr size_t CTL_BYTES = 16384;

#ifndef TSEL_LO
#define TSEL_LO -1
#define TSEL_HI -1
#define TSEL_STEP 1
#endif
#define STAMP(k) do { if (TSEL_LO >= 0 && blockIdx.x == 0 && threadIdx.x == 0) ((volatile LAS unsigned long long*)(lds + LDS_MISC + 64))[(k)] = __builtin_amdgcn_s_memrealtime(); } while (0)
typedef const __attribute__((address_space(4))) Args* ArgsP;
__global__ void __launch_bounds__(NTHREADS, 2) mega(Args a_kern) {
    extern __shared__ __attribute__((aligned(16))) unsigned char lds_raw[];
    LAS unsigned char* lds = (LAS unsigned char*)lds_raw;
    cg::grid_group grid = cg::this_grid();
    ArgsP ap = (ArgsP)__builtin_amdgcn_kernarg_segment_ptr();
#define a (*ap)
#define ws (a.ws)
    int tid, lane, wave, gw, gt;
    const int G = gridDim.x, bx = blockIdx.x;
    const int NGW = G * NWAVES, NGT = G * NTHREADS;
#define RELOAD() do { asm volatile("" : "+s"(ap)); tid = threadIdx.x; asm volatile("" : "+v"(tid)); lane = tid & 63; wave = __builtin_amdgcn_readfirstlane(tid >> 6); gw = bx * NWAVES + wave; gt = bx * NTHREADS + tid; } while (0)
    RELOAD();
    if (a.ph_lo < 0) grid.sync();
    volatile LAS unsigned* bst = (volatile LAS unsigned*)(lds + LDS_MISC);
    if (tid == 0) { bst[0] = 0u; bst[1] = 0u; (void)xb_add((unsigned*)(ws + WS_CTL) + XB_XCNT(xb_xcc_id()), 1u); }
    __syncthreads();
    STAMP(0);
#define x_in (a.in[0])
#define positions ((const int*)a.in[1])
#define g_mix_pre (a.in[2])
#define g_mix_post (a.in[3])
#define g_ffn_pre (a.in[4])
#define g_ffn_post (a.in[5])
#define HN ((bf16_t*)(ws + WS_HN))
#define RSTD ((float*)(ws + WS_CTL + 512 * 1024))
#define Z ((bf16_t*)(ws + WS_Z))
#define YC ((bf16_t*)(ws + WS_YC))
#define MIX ((bf16_t*)(ws + WS_MIX))
#define PO ((bf16_t*)(ws + WS_PO))
#define PM ((float*)(ws + WS_PM))
#define PL ((float*)(ws + WS_PL))
#define Y5 ((bf16_t*)(ws + WS_Y5))
#define HID ((bf16_t*)(ws + WS_HID))
#define XC ((bf16_t*)(ws + WS_XC))
#define BB ((bf16_t*)(ws + WS_BB))
#define Y1 ((bf16_t*)(ws + WS_Y1))
#define LA ((bf16_t*)(ws + WS_LA))
#define ROPE ((float*)(ws + WS_ROPE))
#define S5T (ws + WS_S5TAB)
#define SP ((float*)(ws + WS_S5TAB + S5_SP))
#define X (a.out)
#ifndef PHMASK
#define PHMASK 0xFFFFFFFFu
#endif
#define IN(k) (((PHMASK >> (k)) & 1u) && a.ph_lo <= (k) && (k) < a.ph_hi)
#ifndef REPMASK
#define REPMASK 0x0u
#endif
#define REPS(k) (1 + (int)((REPMASK >> (k)) & 1u))
#define REPSYNC do { if (rep) grid.sync(); } while (0)
#define SEAM(k) do { if (IN(k) && IN((k) + 1)) { xcd_barrier((unsigned*)(ws + WS_CTL), bst); } STAMP((k) + 1); RELOAD(); } while (0)

    constexpr int I_IN = 16 * 64, I_OUT = 16 * 32, I_GLU = 8 * 16, I_GATE = 4 * 64, I_UP = 16 * 176, I_DN = 44 * 32;
#define XPOSE_ITEM(ITEM, scr) do { int r = (ITEM); \
            if (r < I_IN) { const int kb = r / 64, nb = r % 64; transpose_item(a.in[6] + nb * 32, 2048, 1024, (bf16_t*)(ws + WS_W_IN0) + (size_t)nb * 32 * 1024, kb * 64, scr, lane, g_mix_pre); break; } r -= I_IN; \
            if (r < I_IN) { const int kb = r / 64, nb = r % 64; transpose_item(a.in[17] + nb * 32, 2048, 1024, (bf16_t*)(ws + WS_W_IN1) + (size_t)nb * 32 * 1024, kb * 64, scr, lane, g_mix_pre + DM); break; } r -= I_IN; \
            if (r < I_OUT) { const int kb = r / 32, nb = r % 32; transpose_item(a.in[7] + nb * 32, 1024, 1024, (bf16_t*)(ws + WS_W_OUT0) + (size_t)nb * 32 * 1024, kb * 64, scr, lane); break; } r -= I_OUT; \
            if (r < I_OUT) { const int kb = r / 32, nb = r % 32; transpose_item(a.in[18] + nb * 32, 1024, 1024, (bf16_t*)(ws + WS_W_OUT1) + (size_t)nb * 32 * 1024, kb * 64, scr, lane); break; } r -= I_OUT; \
            if (r < I_GLU) { const int kb = r / 16, nb = r % 16; transpose_item(a.in[16] + nb * 32, 512, 512, (bf16_t*)(ws + WS_W_GLU) + (size_t)nb * 32 * 512, kb * 64, scr, lane); break; } r -= I_GLU; \
            if (r < I_GATE) { const int kb = r / 64, nb = r % 64; const int n0 = nb * 32, pn = n0 >> 8, half = (n0 >> 7) & 1, j = n0 & 127, hh = pn >> 1, colg = (pn & 1) * 128 + j; \
                const float* src = (half ? a.in[23] : a.in[21]) + (size_t)hh * 256 * 256 + colg; \
                transpose_item(src, 256, 256, (bf16_t*)(ws + WS_W_GATE) + (size_t)n0 * 256, kb * 64, scr, lane); break; } r -= I_GATE; \
            if (r < 2 * I_UP) { const int layer = r / I_UP; r -= layer * I_UP; const int kb = r / 176, nb = r % 176; const int n0 = nb * 32, t = n0 >> 8, half = (n0 >> 7) & 1, j = n0 & 127; \
                const float* src = (half ? a.in[27] : a.in[26]) + (size_t)layer * 1024 * FFH + t * 128 + j; \
                transpose_item(src, FFH, 1024, (bf16_t*)(ws + (layer ? WS_W_UP1 : WS_W_UP0)) + (size_t)n0 * 1024, kb * 64, scr, lane, g_ffn_pre + layer * DM); break; } r -= 2 * I_UP; \
            { const int layer = r / I_DN; r -= layer * I_DN; const int kb = r / 32, nb = r % 32; \
                transpose_item(a.in[28] + (size_t)layer * FFH * 1024 + nb * 32, 1024, FFH, (bf16_t*)(ws + (layer ? WS_W_DN1 : WS_W_DN0)) + (size_t)nb * 32 * FFH, kb * 64, scr, lane); } \
        } while (0)
    if (IN(0)) _Pragma("unroll") for (int rep = 0; rep < REPS(0); ++rep) {
        LAS float* scr = (LAS float*)(lds + wave * 8448);
        for (int j = gw; j < I_IN + I_OUT + I_GLU; j += NGW) { const int it = j < I_IN ? j : (j < I_IN + I_OUT ? 2 * I_IN + (j - I_IN) : 2 * I_IN + 2 * I_OUT + (j - I_IN - I_OUT)); XPOSE_ITEM(it, scr); }
        for (int idx = gt; idx < MTOK * 8; idx += NGT) { const int tok = idx >> 3, j = idx & 7; const float inv_freq = powf(500000.0f, -(float)j * 0.125f);
            const float ang = (float)positions[tok] * inv_freq; float s, c; sincos_rr(ang, s, c); ROPE[(size_t)tok * 16 + j] = c; ROPE[(size_t)tok * 16 + 8 + j] = s; }
        for (int it = gt; it < 32 * 64 * 16; it += NGT) { const int idx = it >> 4, c = it & 15, g = idx >> 6, p = idx & 63;
            const float are = a.in[8][idx], aim = a.in[9][idx], dt = expf(a.in[10][g]);
            const float xr = are * dt, yi = aim * dt; const float ex = expf(xr); float sn, cs; sincos_rr(yi, sn, cs);
            const float abr = ex * cs, abi = ex * sn;
            float sh, ch; sincos_rr(0.5f * yi, sh, ch); (void)ch;
            const float nre = expm1f(xr) * cs - 2.f * sh * sh, nim = abi;
            const float den = 1.f / (are * are + aim * aim);
            const float cre = (nre * are + nim * aim) * den, cim = (nim * are - nre * aim) * den;
            if (c == 0) { float* AB = (float*)(S5T + S5_ABAR); AB[idx * 2] = abr; AB[idx * 2 + 1] = abi; }
            bf16_t* BMt = (bf16_t*)(S5T + S5_BM); bf16_t* CMt = (bf16_t*)(S5T + S5_CM);
            const float bre = a.in[11][(size_t)idx * 16 + c], bim = a.in[12][(size_t)idx * 16 + c];
            BMt[((size_t)g * 128 + 2 * p) * 32 + c] = (bf16_t)f2bf(cre * bre - cim * bim); BMt[((size_t)g * 128 + 2 * p + 1) * 32 + c] = (bf16_t)f2bf(cre * bim + cim * bre);
            BMt[((size_t)g * 128 + 2 * p) * 32 + 16 + c] = 0; BMt[((size_t)g * 128 + 2 * p + 1) * 32 + 16 + c] = 0;
            CMt[((size_t)g * 16 + c) * 128 + 2 * p] = (bf16_t)f2bf(a.in[13][((size_t)g * 16 + c) * 64 + p]); CMt[((size_t)g * 16 + c) * 128 + 2 * p + 1] = (bf16_t)f2bf(-a.in[14][((size_t)g * 16 + c) * 64 + p]); }
        for (int idx = gt; idx < 1024; idx += NGT) SP[idx] = log1pf(expf(-a.in[25][idx]));
        rows_phase(x_in, HN, RSTD, gw, NGW, lane);
    }
    SEAM(0);
    if (IN(1)) _Pragma("unroll") for (int rep = 0; rep < REPS(1); ++rep) { pg8::Gemm g{HN, (const bf16_t*)(ws + WS_W_IN0), MTOK, 2048, 1024, 1024, 0}; pg8::StaticOrder S; S.init(MTOK, 2048, G, bx);
        pg8::EpiRope E{Z, ROPE, RSTD}; pg8::gemm_phase(lds, g, S, E); }
    SEAM(1);
    if (IN(2)) _Pragma("unroll") for (int rep = 0; rep < REPS(2); ++rep) {
        if (wave < 4) { for (int u = bx; u < 256; u += G) s5_unit(Z, S5T, a.in[15], Y5, lds, u, wave, lane); }
        else {
            LAS float* scr2 = (LAS float*)(lds + 56 * 1024 + (wave - 4) * 8448);
            constexpr int NLATE = I_IN + I_OUT + I_GATE + 2 * I_UP + 2 * I_DN;
            for (int k = bx * 4 + (wave - 4); k < NLATE; k += G * 4) { const int it = k < I_IN ? I_IN + k : (k < I_IN + I_OUT ? 2 * I_IN + I_OUT + (k - I_IN) : 2 * I_IN + 2 * I_OUT + I_GLU + (k - I_IN - I_OUT)); XPOSE_ITEM(it, scr2); }
        }
        attn_phase(Z, PO, PM, PL, lds, bx, G, tid, wave, lane);
    }
    SEAM(2);
    if (IN(3)) _Pragma("unroll") for (int rep = 0; rep < REPS(3); ++rep) {
        for (int idx0 = gt; idx0 < MTOK * 64; idx0 += 4 * NGT) {
            float mv[4][3], lv[4][3]; u32x4 ow[4][3];
#pragma unroll
            for (int r = 0; r < 4; ++r) { const int idx = idx0 + r * NGT, row = idx >> 6, c8 = idx & 63, h = c8 >> 3;
#pragma unroll
                for (int i = 0; i < 3; ++i) { mv[r][i] = PM[((size_t)i * MTOK + row) * 8 + h]; lv[r][i] = PL[((size_t)i * MTOK + row) * 8 + h]; ow[r][i] = *(const u32x4*)(PO + ((size_t)i * MTOK + row) * 512 + c8 * 8); } }
#pragma unroll
            for (int r = 0; r < 4; ++r) { const int idx = idx0 + r * NGT, row = idx >> 6, c8 = idx & 63;
                const float mx = fmaxf(mv[r][0], fmaxf(mv[r][1], mv[r][2]));
                float w[3]; float den = 0.f;
#pragma unroll
                for (int i = 0; i < 3; ++i) { w[i] = fast_exp2(mv[r][i] - mx) * lv[r][i]; den += w[i]; }
                const float inv = 1.f / den; f32x4 v0 = {0.f, 0.f, 0.f, 0.f}, v1 = v0;
#pragma unroll
                for (int i = 0; i < 3; ++i) { const float ww = w[i] * inv;
                    v0[0] += ww * bflo(ow[r][i].x); v0[1] += ww * bfhi(ow[r][i].x); v0[2] += ww * bflo(ow[r][i].y); v0[3] += ww * bfhi(ow[r][i].y);
                    v1[0] += ww * bflo(ow[r][i].z); v1[1] += ww * bfhi(ow[r][i].z); v1[2] += ww * bflo(ow[r][i].w); v1[3] += ww * bfhi(ow[r][i].w); }
                pg8::st8(YC + (size_t)row * 1024 + c8 * 8, v0, v1); } }
        __syncthreads();
        pg8::Gemm g{Y5, (const bf16_t*)(ws + WS_W_GLU), MTOK, 512, 512, 512, 0}; pg8::StaticOrder S; S.init(MTOK, 512, G, bx);
        pg8::EpiGlu E{Y5, YC}; pg8::gemm_phase(lds, g, S, E);
    }
    SEAM(3);
    if (IN(4)) _Pragma("unroll") for (int rep = 0; rep < REPS(4); ++rep) { pg8::Gemm g{YC, (const bf16_t*)(ws + WS_W_OUT0), MTOK, 1024, 1024, 1024, 0}; pg8::StaticOrder S; S.init(MTOK, 1024, G, bx);
        pg8::EpiPlain E{MIX, 1024}; pg8::gemm_phase(lds, g, S, E); }
    SEAM(4);
    if (IN(5)) _Pragma("unroll") for (int rep = 0; rep < REPS(5); ++rep) resnorm_phase<false, false>(HN, MIX, g_mix_post, HN, RSTD, gw, NGW, lane);
    SEAM(5);
    if (IN(6)) _Pragma("unroll") for (int rep = 0; rep < REPS(6); ++rep) { pg8::Gemm g{HN, (const bf16_t*)(ws + WS_W_UP0), MTOK, 2 * FFH, 1024, 1024, 0}; pg8::StaticOrder S; S.init(MTOK, 2 * FFH, G, bx);
        pg8::EpiSwiGlu E{HID, RSTD}; pg8::gemm_phase(lds, g, S, E); }
    SEAM(6);
    if (IN(7)) _Pragma("unroll") for (int rep = 0; rep < REPS(7); ++rep) { pg8::Gemm g{HID, (const bf16_t*)(ws + WS_W_DN0), MTOK, 1024, FFH, FFH, 0}; pg8::StaticOrder S; S.init(MTOK, 1024, G, bx);
        pg8::EpiPlain E{MIX, 1024}; pg8::gemm_phase(lds, g, S, E); }
    SEAM(7);
    if (IN(8)) _Pragma("unroll") for (int rep = 0; rep < REPS(8); ++rep) resnorm_phase<false, false>(HN, MIX, g_ffn_post, HN, RSTD, gw, NGW, lane);
    SEAM(8);
    if (IN(9)) _Pragma("unroll") for (int rep = 0; rep < REPS(9); ++rep) { pg8::Gemm g{HN, (const bf16_t*)(ws + WS_W_IN1), MTOK, 2048, 1024, 1024, 0}; pg8::StaticOrder S; S.init(MTOK, 2048, G, bx);
        pg8::EpiIn1 E{Z, RSTD}; pg8::gemm_phase(lds, g, S, E); }
    SEAM(9);
    if (IN(10)) _Pragma("unroll") for (int rep = 0; rep < REPS(10); ++rep) {
        const float* cw = a.in[19]; const float* cb = a.in[20];
        constexpr int RB = 16;
        for (int idx = gt; idx < (MTOK / RB) * 128; idx += NGT) { const int c8 = idx & 127, tb = idx >> 7, row0 = tb * RB, c0 = c8 * 8; const int t0 = row0 & (SEQ - 1);
            u32x4 xr[RB + 3];
#pragma unroll
            for (int k = 0; k < RB + 3; ++k) { xr[k] = (u32x4){0u, 0u, 0u, 0u}; if (k >= 3 || t0 > 0) xr[k] = *(const u32x4*)(Z + (size_t)(row0 - 3 + k) * 2048 + c0); }
            float w[4][8], bias[8];
#pragma unroll
            for (int k = 0; k < 4; ++k) { const f32x4 wa = *(const f32x4*)(cw + k * 1024 + c0), wb = *(const f32x4*)(cw + k * 1024 + c0 + 4);
                w[k][0] = wa.x; w[k][1] = wa.y; w[k][2] = wa.z; w[k][3] = wa.w; w[k][4] = wb.x; w[k][5] = wb.y; w[k][6] = wb.z; w[k][7] = wb.w; }
            { const f32x4 ba = *(const f32x4*)(cb + c0), bb = *(const f32x4*)(cb + c0 + 4); bias[0] = ba.x; bias[1] = ba.y; bias[2] = ba.z; bias[3] = ba.w; bias[4] = bb.x; bias[5] = bb.y; bias[6] = bb.z; bias[7] = bb.w; }
            float xm[3][8];
#pragma unroll
            for (int k = 0; k < 3; ++k) { const u32x4 v = xr[k];
                xm[k][0] = bflo(v.x); xm[k][1] = bfhi(v.x); xm[k][2] = bflo(v.y); xm[k][3] = bfhi(v.y); xm[k][4] = bflo(v.z); xm[k][5] = bfhi(v.z); xm[k][6] = bflo(v.w); xm[k][7] = bfhi(v.w); }
#pragma unroll
            for (int r = 0; r < RB; ++r) { const u32x4 v = xr[r + 3];
                const float xc[8] = {bflo(v.x), bfhi(v.x), bflo(v.y), bfhi(v.y), bflo(v.z), bfhi(v.z), bflo(v.w), bfhi(v.w)};
                f32x4 o0, o1;
#pragma unroll
                for (int i = 0; i < 8; ++i) { const float o = bias[i] + w[0][i] * xm[0][i] + w[1][i] * xm[1][i] + w[2][i] * xm[2][i] + w[3][i] * xc[i];
                    if (i < 4) o0[i] = o; else o1[i - 4] = o; xm[0][i] = xm[1][i]; xm[1][i] = xm[2][i]; xm[2][i] = xc[i]; }
                pg8::st8(XC + (size_t)(row0 + r) * 1024 + c0, o0, o1); } }
    }
    SEAM(10);
    if (IN(11)) _Pragma("unroll") for (int rep = 0; rep < REPS(11); ++rep) { pg8::Gemm g{XC, (const bf16_t*)(ws + WS_W_GATE), MTOK, 2048, 256, 1024, 1}; pg8::StaticOrder S; S.init(MTOK, 2048, G, bx);
        pg8::EpiGates E{XC, LA, BB, a.in[22], a.in[24], SP}; pg8::gemm_phase(lds, g, S, E); }
    SEAM(11);
    if (IN(12)) _Pragma("unroll") for (int rep = 0; rep < REPS(12); ++rep) {
        LAS float* car = (LAS float*)lds;
        for (int u = bx; u < 256; u += G) { const int b = u >> 3, c0 = (u & 7) * 128 + 2 * lane;
            float cin0 = 0.f, cin1 = 0.f;
            for (int r = 0; r < 8; ++r) { const size_t rbase = (size_t)b * SEQ + r * 256 + wave * 32;
                const bf16_t* la = LA + rbase * 1024 + c0; const bf16_t* bb = BB + rbase * 1024 + c0; const bf16_t* gb = Z + rbase * 2048 + 1024 + c0; bf16_t* yo = Y1 + rbase * 1024 + c0;
                unsigned lq[32], bq[32], gq[32];
#pragma unroll
                for (int i = 0; i < 32; ++i) { lq[i] = *(const unsigned*)(la + (size_t)i * 1024); bq[i] = *(const unsigned*)(bb + (size_t)i * 1024); }
#pragma unroll
                for (int i = 0; i < 32; ++i) gq[i] = *(const unsigned*)(gb + (size_t)i * 2048);
                float h0 = 0.f, h1 = 0.f, s0 = 0.f, s1 = 0.f;
#pragma unroll
                for (int i = 0; i < 32; ++i) { const float l0 = bflo(lq[i]), l1 = bfhi(lq[i]); s0 += l0; s1 += l1;
                    const float a0 = fast_exp2(l0 * LOG2E), a1 = fast_exp2(l1 * LOG2E);
                    const float b0 = sqrtf(fmaxf(1.f - a0 * a0, 0.f)) * bflo(bq[i]), b1 = sqrtf(fmaxf(1.f - a1 * a1, 0.f)) * bfhi(bq[i]);
                    bq[i] = pk2(b0, b1);
                    h0 = a0 * h0 + bflo(bq[i]); h1 = a1 * h1 + bfhi(bq[i]); }
                __syncthreads();
                *(LAS f32x4*)(car + (wave * 64 + lane) * 4) = (f32x4){fast_exp2(s0 * LOG2E), fast_exp2(s1 * LOG2E), h0, h1};
                __syncthreads();
                h0 = cin0; h1 = cin1; float e0 = cin0, e1 = cin1;
#pragma unroll
                for (int j = 0; j < 8; ++j) { const f32x4 cv = *(const LAS f32x4*)(car + (j * 64 + lane) * 4);
                    if (j < wave) { h0 = cv.x * h0 + cv.z; h1 = cv.y * h1 + cv.w; }
                    e0 = cv.x * e0 + cv.z; e1 = cv.y * e1 + cv.w; }
                cin0 = e0; cin1 = e1;
#pragma unroll
                for (int i = 0; i < 32; ++i) { h0 = fast_exp2(bflo(lq[i]) * LOG2E) * h0 + bflo(bq[i]); h1 = fast_exp2(bfhi(lq[i]) * LOG2E) * h1 + bfhi(bq[i]);
                    *(unsigned*)(yo + (size_t)i * 1024) = pk2(h0 * bflo(gq[i]), h1 * bfhi(gq[i])); }
            }
        }
    }
    SEAM(12);
    if (IN(13)) _Pragma("unroll") for (int rep = 0; rep < REPS(13); ++rep) { pg8::Gemm g{Y1, (const bf16_t*)(ws + WS_W_OUT1), MTOK, 1024, 1024, 1024, 0}; pg8::StaticOrder S; S.init(MTOK, 1024, G, bx);
        pg8::EpiPlain E{MIX, 1024}; pg8::gemm_phase(lds, g, S, E); }
    SEAM(13);
    if (IN(14)) _Pragma("unroll") for (int rep = 0; rep < REPS(14); ++rep) resnorm_phase<false, false>(HN, MIX, g_mix_post + DM, HN, RSTD, gw, NGW, lane);
    SEAM(14);
    if (IN(15)) _Pragma("unroll") for (int rep = 0; rep < REPS(15); ++rep) { pg8::Gemm g{HN, (const bf16_t*)(ws + WS_W_UP1), MTOK, 2 * FFH, 1024, 1024, 0}; pg8::StaticOrder S; S.init(MTOK, 2 * FFH, G, bx);
        pg8::EpiSwiGlu E{HID, RSTD}; pg8::gemm_phase(lds, g, S, E); }
    SEAM(15);
    if (IN(16)) _Pragma("unroll") for (int rep = 0; rep < REPS(16); ++rep) { pg8::Gemm g{HID, (const bf16_t*)(ws + WS_W_DN1), MTOK, 1024, FFH, FFH, 0}; pg8::StaticOrder S; S.init(MTOK, 1024, G, bx);
        pg8::EpiPlain E{MIX, 1024}; pg8::gemm_phase(lds, g, S, E); }
    SEAM(16);
    if (IN(17)) _Pragma("unroll") for (int rep = 0; rep < REPS(17); ++rep) resnorm_phase<false, true>(HN, MIX, g_ffn_post + DM, X, nullptr, gw, NGW, lane);
    if (TSEL_LO >= 0) { xcd_barrier((unsigned*)(ws + WS_CTL), bst); STAMP(18);
        if (blockIdx.x == 0 && threadIdx.x == 0) { volatile LAS unsigned long long* ts = (volatile LAS unsigned long long*)(lds + LDS_MISC + 64);
            float acc_us = 0.f; for (int k = TSEL_LO; k < TSEL_HI; k += TSEL_STEP) acc_us += (float)(ts[k + 1] - ts[k]) * 0.01f;
            a.out[0] = (float)((int)(acc_us * 0.05f + 0.5f)) * 20.f; } }
#undef IN
#undef SEAM
#undef a
#undef ws
}
constexpr int NPHASES = 18;

extern "C" void kernel_launch(void* const* d_in, const int* in_sizes, int n_in, void* d_out, int out_size, void* d_ws, size_t ws_size, hipStream_t stream) {
    static int grid = 0;
    if (grid == 0) {
        if (n_in != 29 || in_sizes[0] != MTOK * DM || out_size != MTOK * DM || ws_size < WS_END) {
            fprintf(stderr, "kernel_launch: unexpected shapes: n_in %d in0 %d out %d ws %zu (need %zu)\n", n_in, n_in > 0 ? in_sizes[0] : -1, out_size, ws_size, (size_t)WS_END); grid = -1; return; }
        int dev = 0, cus = 0, per_cu = 0;
        hipGetDevice(&dev); hipDeviceGetAttribute(&cus, hipDeviceAttributeMultiprocessorCount, dev);
        if (hipFuncSetAttribute((const void*)mega, hipFuncAttributeMaxDynamicSharedMemorySize, LDS_BYTES) != hipSuccess) { fprintf(stderr, "kernel_launch: hipFuncSetAttribute failed\n"); grid = -1; return; }
        if (hipOccupancyMaxActiveBlocksPerMultiprocessor(&per_cu, (const void*)mega, NTHREADS, LDS_BYTES) != hipSuccess || per_cu < 1) { fprintf(stderr, "kernel_launch: occupancy query says %d\n", per_cu); per_cu = 1; }
        (void)hipGetLastError();
        grid = cus;
    }
    if (grid < 0) return;
    if (hipMemsetAsync((char*)d_ws + WS_CTL, 0, CTL_BYTES, stream) != hipSuccess) { fprintf(stderr, "kernel_launch: memset failed\n"); return; }
    Args a{};
    for (int i = 0; i < 29; ++i) a.in[i] = (const float*)d_in[i];
    a.out = (float*)d_out; a.ws = (unsigned char*)d_ws;
#if N_LAUNCH_MODE == 1
    a.ph_lo = 0; a.ph_hi = NPHASES;
    void* args[] = {&a};
    hipError_t e = hipLaunchCooperativeKernel((const void*)mega, dim3(grid), dim3(NTHREADS), args, LDS_BYTES, stream);
    if (e != hipSuccess) fprintf(stderr, "cooperative launch failed: %s (grid %d)\n", hipGetErrorString(e), grid);
#else
    for (int ph = 0; ph < NPHASES; ++ph) { a.ph_lo = ph; a.ph_hi = ph + 1; hipLaunchKernelGGL(mega, dim3(grid), dim3(NTHREADS), LDS_BYTES, stream, a); }
#endif
}
```

```cpp
#include <hip/hip_runtime.h>
#include <hip/hip_cooperative_groups.h>
#include <cstdio>
#include <cstdint>
namespace cg = cooperative_groups;

#ifndef N_LAUNCH_MODE
#define N_LAUNCH_MODE 1
#endif

#define LAS __attribute__((address_space(3)))
typedef unsigned short bf16_t;
typedef short bf16x8 __attribute__((ext_vector_type(8)));
typedef float f32x4 __attribute__((ext_vector_type(4)));
typedef unsigned u32x4 __attribute__((ext_vector_type(4)));
typedef unsigned u32x2 __attribute__((ext_vector_type(2)));
typedef float f32x2 __attribute__((ext_vector_type(2)));

constexpr int MTOK = 65536, DM = 1024, SEQ = 2048, NBATCH = 32, FFH = 2816;
constexpr float NORM_EPS = 1e-6f;
constexpr float LOG2E = 1.4426950408889634f;
constexpr int NWAVES = 8, NTHREADS = 512;
constexpr int LDS_BYTES = 136 * 1024;

constexpr size_t MiB = 1u << 20;
constexpr size_t WS_CTL = 0;
constexpr size_t WS_W_IN0 = 1 * MiB, WS_W_OUT0 = 5 * MiB, WS_W_GLU = 7 * MiB, WS_W_IN1 = 8 * MiB, WS_W_OUT1 = 12 * MiB, WS_W_GATE = 14 * MiB;
constexpr size_t WS_W_UP0 = 15 * MiB, WS_W_UP1 = 26 * MiB, WS_W_DN0 = 37 * MiB, WS_W_DN1 = 43 * MiB;
constexpr size_t WS_ROPE = 49 * MiB;
constexpr size_t WS_S5TAB = 53 * MiB;
constexpr size_t S5_ABAR = 0, S5_BM = 16384, S5_CM = 16384 + 262144, S5_SP = 16384 + 262144 + 131072;
constexpr size_t WS_HN = 64 * MiB, WS_Z = 192 * MiB, WS_YC = 448 * MiB, WS_MIX = 576 * MiB, WS_PO = 704 * MiB, WS_PM = 896 * MiB, WS_PL = 902 * MiB, WS_Y5 = 908 * MiB;
constexpr size_t WS_HID = 192 * MiB;
constexpr size_t WS_XC = 448 * MiB, WS_BB = 576 * MiB, WS_Y1 = 704 * MiB, WS_LA = 832 * MiB;
constexpr size_t WS_END = 972 * MiB;

struct Args { const float* in[29]; float* out; unsigned char* ws; int ph_lo, ph_hi; };

__device__ __forceinline__ unsigned f2bf(float f) { unsigned u = __builtin_bit_cast(unsigned, f); return (u + 0x7fffu + ((u >> 16) & 1u)) >> 16; }
__device__ __forceinline__ unsigned pk2(float lo, float hi) { unsigned r; asm("v_cvt_pk_bf16_f32 %0, %1, %2" : "=v"(r) : "v"(lo), "v"(hi)); return r; }
__device__ __forceinline__ float bf2f(unsigned short h) { return __builtin_bit_cast(float, (unsigned)h << 16); }
__device__ __forceinline__ float bflo(unsigned w) { return __builtin_bit_cast(float, w << 16); }
__device__ __forceinline__ float bfhi(unsigned w) { return __builtin_bit_cast(float, w & 0xffff0000u); }
__device__ __forceinline__ float fast_exp2(float x) { return __builtin_amdgcn_exp2f(x); }
__device__ __forceinline__ float fast_rcp(float x) { return __builtin_amdgcn_rcpf(x); }
__device__ __forceinline__ float sigmoidf_(float x) { return fast_rcp(1.f + fast_exp2(-x * LOG2E)); }
__device__ __forceinline__ float gelu_tanh(float x) { const float u = 0.7978845608028654f * (x + 0.044715f * x * x * x); return x * sigmoidf_(2.f * u); }
__device__ __forceinline__ float wave_sum(float v) {
#pragma unroll
    for (int o = 1; o < 64; o <<= 1) v += __shfl_xor(v, o);
    return v;
}
#define LDS_WAIT() asm volatile("s_waitcnt lgkmcnt(0)" ::: "memory")

namespace pg8 {
constexpr int BM = 256, BK = 64, HALF = 128, HTB = HALF * BK * 2, STAGE_BYTES = 8 * HTB, NXCD = 8, WGM = 8;
__host__ __device__ __forceinline__ int lds_byte(int r, int c) { const int st = (r >> 4) * 2 + (c >> 5), rr = r & 15, cc = c & 31, ob = rr * 64 + cc * 2; return st * 1024 + (ob ^ (((ob >> 9) & 1) << 5)); }
__host__ __device__ __forceinline__ void stage_rc(int b, int& R, int& C) { const int st = b / 1024, sb = b % 1024, swz = sb ^ (((sb >> 9) & 1) << 5); R = (st >> 1) * 16 + swz / 64; C = (st & 1) * 32 + (swz % 64) / 2; }
__host__ __device__ __forceinline__ int perm32(int rho) { const int n = rho >> 4, i = rho & 15; return 8 * (i >> 2) + 4 * n + (i & 3); }
struct Unit { int pm, pn; };
struct Gemm { const bf16_t* A; const bf16_t* Bt; int M, N, K, lda, grp; };
struct StaticOrder {
    int nM, nN, nwg, G, c;
    __host__ __device__ void init(int M, int N, int G_, int c_) { nM = M / BM; nN = N / BM; nwg = nM * nN; G = G_; c = c_; }
    __host__ __device__ bool next(int i, Unit& u) const {
        const long L = (long)i * G + c; if (L >= nwg) return false;
        int wgid = (int)L; { const int q = nwg / NXCD, r = nwg % NXCD, xcd = wgid % NXCD, off = wgid / NXCD; wgid = (xcd < r ? xcd * (q + 1) : r * (q + 1) + (xcd - r) * q) + off; }
        const int nig = WGM * nN, gid = wgid / nig, fm = gid * WGM, gsz = (nM - fm) < WGM ? (nM - fm) : WGM;
        u.pm = fm + ((wgid % nig) % gsz); u.pn = (wgid % nig) / gsz; return true;
    }
};
template <class Epi>
__device__ __forceinline__ void gemm_phase(LAS unsigned char* lds, const Gemm g, const StaticOrder& S, const Epi& E) {
    int tid_ = threadIdx.x; asm volatile("" : "+v"(tid_));
    const int tid = tid_, wid = __builtin_amdgcn_readfirstlane(tid >> 6), lane = tid & 63, wr = wid >> 2, wc = wid & 3, fr = lane & 15, fq = lane >> 4;
    const int K = g.K, nt = K / BK, lda = g.lda;
    unsigned voffA[2], voffB[2];
#pragma unroll
    for (int i = 0; i < 2; ++i) { int R, C; stage_rc(tid * 16 + i * 8192, R, C); const int Rb = (R & ~31) + perm32(R & 31);
        voffA[i] = (unsigned)(R * lda + C) * 2u; voffB[i] = (unsigned)(Rb * K + C) * 2u; }
    const size_t kstep = (size_t)(BK * 2);
    const size_t hstepA = (size_t)HALF * lda * 2, hstepB = (size_t)HALF * K * 2;
    const size_t tstepA = 2 * hstepA, tstepB = 2 * hstepB;
    const unsigned ldsw = (unsigned)wid * 1024u;
    const int aoff = lds_byte(wr * 64 + fr, fq * 8), boff = lds_byte(wc * 32 + fr, fq * 8);
#define PG8_SA(b, h) (((b) * 2 + (h)) * HTB)
#define PG8_SB(b, h) ((4 + (b) * 2 + (h)) * HTB)
#define PG8_STAGE(bufoff, gbase, voff) do { _Pragma("unroll") for (int _i = 0; _i < 2; ++_i) \
        __builtin_amdgcn_global_load_lds((const unsigned*)((const char*)(gbase) + (voff)[_i]), (LAS unsigned*)(lds + (bufoff) + ldsw + _i * 8192), 16, 0, 0); } while (0)
#define PG8_LDA(dst, b, h) do { _Pragma("unroll") for (int m = 0; m < 4; ++m) _Pragma("unroll") for (int k = 0; k < 2; ++k) dst[m][k] = *(const LAS bf16x8*)(lds + PG8_SA(b, h) + aoff + m * 2048 + k * 1024); } while (0)
#define PG8_LDB(dst, b, h) do { _Pragma("unroll") for (int n = 0; n < 2; ++n) _Pragma("unroll") for (int k = 0; k < 2; ++k) dst[n][k] = *(const LAS bf16x8*)(lds + PG8_SB(b, h) + boff + n * 2048 + k * 1024); } while (0)
#define PG8_MMA(ai, bj, At, Bt) do { __builtin_amdgcn_s_setprio(1); _Pragma("unroll") for (int m = 0; m < 4; ++m) _Pragma("unroll") for (int n = 0; n < 2; ++n) _Pragma("unroll") for (int k = 0; k < 2; ++k) \
        acc[ai][bj][m][n] = __builtin_amdgcn_mfma_f32_16x16x32_bf16(Bt[n][k], At[m][k], acc[ai][bj][m][n], 0, 0, 0); __builtin_amdgcn_s_setprio(0); } while (0)
#define PG8_WAIT_V(n) asm volatile("s_waitcnt vmcnt(" #n ")" ::: "memory")
#define PG8_WAIT_L(n) asm volatile("s_waitcnt lgkmcnt(" #n ")" ::: "memory")
#define PG8_BAR __builtin_amdgcn_s_barrier()
#define PG8_SCHED __builtin_amdgcn_sched_barrier(0)
    Unit cur, nxt; int ui = 0;
    if (!S.next(0, cur)) return;
    f32x4 acc[2][2][4][2];
#pragma unroll
    for (int a = 0; a < 2; ++a)
#pragma unroll
        for (int b = 0; b < 2; ++b)
#pragma unroll
            for (int m = 0; m < 4; ++m)
#pragma unroll
                for (int n = 0; n < 2; ++n) acc[a][b][m][n] = (f32x4){0.f, 0.f, 0.f, 0.f};
    bf16x8 At[4][2], B0[2][2], B1[2][2];
    const char* cA = (const char*)g.A + (size_t)cur.pm * tstepA + (g.grp ? (size_t)(cur.pn >> 1) * K * 2 : 0); const char* cB = (const char*)g.Bt + (size_t)cur.pn * tstepB;
    PG8_STAGE(PG8_SB(0, 0), cB, voffB); PG8_STAGE(PG8_SB(0, 1), cB + hstepB, voffB); PG8_STAGE(PG8_SA(0, 0), cA, voffA); PG8_STAGE(PG8_SA(0, 1), cA + hstepA, voffA);
    if (wr == 1) PG8_BAR;
    PG8_WAIT_V(2); PG8_BAR;
    PG8_STAGE(PG8_SB(1, 0), cB + kstep, voffB); PG8_STAGE(PG8_SA(1, 0), cA + kstep, voffA); PG8_STAGE(PG8_SB(1, 1), cB + hstepB + kstep, voffB);
    PG8_WAIT_V(6); PG8_BAR;
    for (;;) {
        const bool has_next = S.next(ui + 1, nxt);
        const char* nA = has_next ? (const char*)g.A + (size_t)nxt.pm * tstepA + (g.grp ? (size_t)(nxt.pn >> 1) * K * 2 : 0) : cA; const char* nB = has_next ? (const char*)g.Bt + (size_t)nxt.pn * tstepB : cB;
        for (int t = 0; t < nt; t += 2) {
            const bool last = (t == nt - 2);
            const char* a1 = cA + (size_t)(t + 1) * kstep;
            const char* a2 = last ? nA : cA + (size_t)(t + 2) * kstep; const char* b2 = last ? nB : cB + (size_t)(t + 2) * kstep;
            const char* a3 = a2 + kstep; const char* b3 = b2 + kstep;
            PG8_LDB(B0, 0, 0); PG8_LDB(B1, 0, 1); PG8_SCHED; PG8_LDA(At, 0, 0); PG8_STAGE(PG8_SA(1, 1), a1 + hstepA, voffA);
            PG8_WAIT_V(8); PG8_WAIT_L(0); PG8_BAR; PG8_MMA(0, 0, At, B0); PG8_MMA(0, 1, At, B1); PG8_BAR; PG8_SCHED;
            PG8_LDA(At, 0, 1); PG8_STAGE(PG8_SB(0, 0), b2, voffB); PG8_STAGE(PG8_SB(0, 1), b2 + hstepB, voffB); PG8_STAGE(PG8_SA(0, 0), a2, voffA);
            PG8_WAIT_V(8); PG8_WAIT_L(0); PG8_BAR; PG8_MMA(1, 0, At, B0); PG8_MMA(1, 1, At, B1); PG8_BAR; PG8_SCHED;
            PG8_LDB(B0, 1, 0); PG8_LDB(B1, 1, 1); PG8_SCHED; PG8_LDA(At, 1, 0); PG8_STAGE(PG8_SA(0, 1), a2 + hstepA, voffA);
            PG8_WAIT_V(8); PG8_WAIT_L(0); PG8_BAR; PG8_MMA(0, 0, At, B0); PG8_MMA(0, 1, At, B1); PG8_BAR; PG8_SCHED;
            PG8_LDA(At, 1, 1); PG8_STAGE(PG8_SB(1, 0), b3, voffB); PG8_STAGE(PG8_SB(1, 1), b3 + hstepB, voffB); PG8_STAGE(PG8_SA(1, 0), a3, voffA);
            PG8_WAIT_V(8); PG8_WAIT_L(0); PG8_BAR; PG8_MMA(1, 0, At, B0); PG8_MMA(1, 1, At, B1); PG8_BAR; PG8_SCHED;
        }
        if (wr == 0) PG8_BAR;
        E(acc, cur, wr, wc, fr, fq);
        if (!has_next) break;
#pragma unroll
        for (int a = 0; a < 2; ++a)
#pragma unroll
            for (int b = 0; b < 2; ++b)
#pragma unroll
                for (int m = 0; m < 4; ++m)
#pragma unroll
                    for (int n = 0; n < 2; ++n) acc[a][b][m][n] = (f32x4){0.f, 0.f, 0.f, 0.f};
        cur = nxt; cA = nA; cB = nB; ++ui;
        if (wr == 1) PG8_BAR;
    }
    PG8_WAIT_V(0);
    PG8_BAR;
#undef PG8_SA
#undef PG8_SB
#undef PG8_STAGE
#undef PG8_LDA
#undef PG8_LDB
#undef PG8_MMA
#undef PG8_WAIT_V
#undef PG8_WAIT_L
#undef PG8_BAR
#undef PG8_SCHED
}
typedef f32x4 AccT[2][2][4][2];

__device__ __forceinline__ void st8(bf16_t* p, f32x4 v0, f32x4 v1) {
    u32x4 w; w.x = pk2(v0[0], v0[1]); w.y = pk2(v0[2], v0[3]); w.z = pk2(v1[0], v1[1]); w.w = pk2(v1[2], v1[3]); *(u32x4*)p = w;
}
struct EpiPlain {
    bf16_t* O; int ldc;
    __device__ __forceinline__ void operator()(const AccT& acc, const Unit& u, int wr, int wc, int fr, int fq) const {
        const int row0 = u.pm * BM + wr * 64 + fr, col0 = u.pn * BM + wc * 32 + 8 * fq;
#pragma unroll
        for (int ai = 0; ai < 2; ++ai)
#pragma unroll
            for (int m = 0; m < 4; ++m) { bf16_t* rowp = O + (size_t)(row0 + ai * HALF + m * 16) * ldc + col0;
#pragma unroll
                for (int bj = 0; bj < 2; ++bj) st8(rowp + bj * HALF, acc[ai][bj][m][0], acc[ai][bj][m][1]); }
    }
};
struct EpiRope {
    bf16_t* Z; const float* rope; const float* rstd;
    __device__ __forceinline__ void operator()(const AccT& acc, const Unit& u, int wr, int wc, int fr, int fq) const {
        const int row0 = u.pm * BM + wr * 64 + fr, col0 = u.pn * BM + wc * 32 + 8 * fq;
        const bool ropew = (u.pn < 4) && !(wc & 1); const float sc = (u.pn < 2) ? 0.125f * LOG2E : 1.f;
#pragma unroll
        for (int ai = 0; ai < 2; ++ai)
#pragma unroll
            for (int m = 0; m < 4; ++m) { const int row = row0 + ai * HALF + m * 16; bf16_t* rowp = Z + (size_t)row * 2048 + col0;
                f32x4 c0 = {1.f, 1.f, 1.f, 1.f}, c1 = c0, s0 = {0.f, 0.f, 0.f, 0.f}, s1 = s0;
                if (ropew && fq < 2) { const f32x4* rp = (const f32x4*)(rope + (size_t)row * 16); c0 = rp[0]; c1 = rp[1]; s0 = rp[2]; s1 = rp[3]; if (fq == 0) { s0 = -s0; s1 = -s1; } }
                const float rs = rstd[row] * sc;
#pragma unroll
                for (int bj = 0; bj < 2; ++bj) { f32x4 v0 = acc[ai][bj][m][0] * rs, v1 = acc[ai][bj][m][1] * rs;
                    if (ropew) { f32x4 p0, p1;
#pragma unroll
                        for (int i = 0; i < 4; ++i) { p0[i] = __shfl_xor(v0[i], 16); p1[i] = __shfl_xor(v1[i], 16); }
                        v0 = v0 * c0 + p0 * s0; v1 = v1 * c1 + p1 * s1; }
                    st8(rowp + bj * HALF, v0, v1); } }
    }
};
struct EpiGlu {
    const bf16_t* Y; bf16_t* O;
    __device__ __forceinline__ void operator()(const AccT& acc, const Unit& u, int wr, int wc, int fr, int fq) const {
        const int row0 = u.pm * BM + wr * 64 + fr, col0 = u.pn * BM + wc * 32 + 8 * fq;
#pragma unroll
        for (int ai = 0; ai < 2; ++ai)
#pragma unroll
            for (int m = 0; m < 4; ++m) { const int row = row0 + ai * HALF + m * 16;
#pragma unroll
                for (int bj = 0; bj < 2; ++bj) { const int col = col0 + bj * HALF; const u32x4 yw = *(const u32x4*)(Y + (size_t)row * 512 + col);
                    f32x4 a0 = acc[ai][bj][m][0], a1 = acc[ai][bj][m][1], v0, v1;
                    v0[0] = bflo(yw.x) * sigmoidf_(a0[0]); v0[1] = bfhi(yw.x) * sigmoidf_(a0[1]); v0[2] = bflo(yw.y) * sigmoidf_(a0[2]); v0[3] = bfhi(yw.y) * sigmoidf_(a0[3]);
                    v1[0] = bflo(yw.z) * sigmoidf_(a1[0]); v1[1] = bfhi(yw.z) * sigmoidf_(a1[1]); v1[2] = bflo(yw.w) * sigmoidf_(a1[2]); v1[3] = bfhi(yw.w) * sigmoidf_(a1[3]);
                    st8(O + (size_t)row * 1024 + 512 + col, v0, v1); } }
    }
};
struct EpiSwiGlu {
    bf16_t* O; const float* rstd;
    __device__ __forceinline__ void operator()(const AccT& acc, const Unit& u, int wr, int wc, int fr, int fq) const {
        const int row0 = u.pm * BM + wr * 64 + fr, col0 = u.pn * HALF + wc * 32 + 8 * fq;
#pragma unroll
        for (int ai = 0; ai < 2; ++ai)
#pragma unroll
            for (int m = 0; m < 4; ++m) { const int row = row0 + ai * HALF + m * 16; f32x4 v[2]; const float rs = rstd[row], rs2 = rs * rs, rsl = -rs * LOG2E;
#pragma unroll
                for (int n = 0; n < 2; ++n)
#pragma unroll
                    for (int i = 0; i < 4; ++i) { const float g0 = acc[ai][0][m][n][i], u0 = acc[ai][1][m][n][i];
                        v[n][i] = (g0 * u0) * (rs2 * fast_rcp(1.f + fast_exp2(g0 * rsl))); }
                st8(O + (size_t)row * FFH + col0, v[0], v[1]); }
    }
};
struct EpiIn1 {
    bf16_t* Z; const float* rstd;
    __device__ __forceinline__ void operator()(const AccT& acc, const Unit& u, int wr, int wc, int fr, int fq) const {
        const int row0 = u.pm * BM + wr * 64 + fr, col0 = u.pn * BM + wc * 32 + 8 * fq; const bool act = u.pn >= 4;
#pragma unroll
        for (int ai = 0; ai < 2; ++ai)
#pragma unroll
            for (int m = 0; m < 4; ++m) { bf16_t* rowp = Z + (size_t)(row0 + ai * HALF + m * 16) * 2048 + col0; const float rs = rstd[row0 + ai * HALF + m * 16];
#pragma unroll
                for (int bj = 0; bj < 2; ++bj) { f32x4 v0 = acc[ai][bj][m][0] * rs, v1 = acc[ai][bj][m][1] * rs;
                    if (act) {
#pragma unroll
                        for (int i = 0; i < 4; ++i) { v0[i] = gelu_tanh(v0[i]); v1[i] = gelu_tanh(v1[i]); } }
                    st8(rowp + bj * HALF, v0, v1); } }
    }
};
struct EpiGates {
    const bf16_t* XC; bf16_t* LA; bf16_t* BB; const float* b_r; const float* b_i; const float* sp;
    __device__ __forceinline__ void operator()(const AccT& acc, const Unit& u, int wr, int wc, int fr, int fq) const {
        const int row0 = u.pm * BM + wr * 64 + fr, c0 = (u.pn >> 1) * 256 + (u.pn & 1) * 128 + wc * 32 + 8 * fq;
        f32x4 br[2], bi[2], spv[2];
#pragma unroll
        for (int n = 0; n < 2; ++n) { br[n] = *(const f32x4*)(b_r + c0 + 4 * n) * (-LOG2E); bi[n] = *(const f32x4*)(b_i + c0 + 4 * n) * (-LOG2E); spv[n] = *(const f32x4*)(sp + c0 + 4 * n) * (-8.f); }
#pragma unroll
        for (int ai = 0; ai < 2; ++ai)
#pragma unroll
            for (int m = 0; m < 4; ++m) { const int row = row0 + ai * HALF + m * 16; const u32x4 xw = *(const u32x4*)(XC + (size_t)row * 1024 + c0);
                const float xv[8] = {bflo(xw.x), bfhi(xw.x), bflo(xw.y), bfhi(xw.y), bflo(xw.z), bfhi(xw.z), bflo(xw.w), bfhi(xw.w)};
                f32x4 la[2], bb[2];
#pragma unroll
                for (int n = 0; n < 2; ++n)
#pragma unroll
                    for (int i = 0; i < 4; ++i) { const float er = fast_exp2(acc[ai][0][m][n][i] * (-LOG2E) + br[n][i]), ei = fast_exp2(acc[ai][1][m][n][i] * (-LOG2E) + bi[n][i]);
                        la[n][i] = spv[n][i] * fast_rcp(1.f + er); bb[n][i] = xv[4 * n + i] * fast_rcp(1.f + ei); }
                st8(LA + (size_t)row * 1024 + c0, la[0], la[1]); st8(BB + (size_t)row * 1024 + c0, bb[0], bb[1]); __builtin_amdgcn_sched_barrier(0); }
    }
};
}

__device__ __forceinline__ void transpose_item(const float* W, int ld, int K, bf16_t* dst, int k0, LAS float* scr, int lane, const float* gk = nullptr) {
    float tv[32];
#pragma unroll
    for (int i = 0; i < 32; ++i) { const int kk = 2 * i + (lane >> 5); tv[i] = W[(size_t)(k0 + kk) * ld + (lane & 31)]; }
#pragma unroll
    for (int i = 0; i < 32; ++i) { const int kk = 2 * i + (lane >> 5); const float gs = gk ? gk[k0 + kk] : 1.f; scr[kk * 33 + (lane & 31)] = tv[i] * gs; }
    LDS_WAIT();
    const int c = lane & 7;
#pragma unroll
    for (int j = 0; j < 4; ++j) { const int n = (lane >> 3) + 8 * j; const LAS float* s = scr + (8 * c) * 33 + n;
        u32x4 o; o.x = pk2(s[0 * 33], s[1 * 33]); o.y = pk2(s[2 * 33], s[3 * 33]); o.z = pk2(s[4 * 33], s[5 * 33]); o.w = pk2(s[6 * 33], s[7 * 33]);
        *(u32x4*)(dst + (size_t)n * K + k0 + 8 * c) = o; }
    LDS_WAIT();
}
__device__ __forceinline__ void sincos_rr(float ang, float& s, float& c) {
    const double r = (double)ang * 0.15915494309189535; const double fr = r - __builtin_rint(r); const float f = (float)fr;
    s = __builtin_amdgcn_sinf(f); c = __builtin_amdgcn_cosf(f);
}
struct RowBuf { f32x4 v[2][4]; };
__device__ __forceinline__ void rows_load(RowBuf& B, const float* x, int m0, int stride, int lane) {
#pragma unroll
    for (int r = 0; r < 2; ++r) { const f32x4* xr = (const f32x4*)(x + (size_t)(m0 + r * stride) * DM) + lane;
#pragma unroll
        for (int j = 0; j < 4; ++j) B.v[r][j] = xr[64 * j]; }
}
__device__ __forceinline__ void rows_store(const RowBuf& B, bf16_t* o, float* rstd_out, int m0, int stride, int lane) {
    float s[2];
#pragma unroll
    for (int r = 0; r < 2; ++r) { s[r] = 0.f;
#pragma unroll
        for (int j = 0; j < 4; ++j) s[r] += (B.v[r][j].x * B.v[r][j].x + B.v[r][j].y * B.v[r][j].y) + (B.v[r][j].z * B.v[r][j].z + B.v[r][j].w * B.v[r][j].w); }
#pragma unroll
    for (int o_ = 1; o_ < 64; o_ <<= 1) {
#pragma unroll
        for (int r = 0; r < 2; ++r) s[r] += __shfl_xor(s[r], o_); }
#pragma unroll
    for (int r = 0; r < 2; ++r) { u32x2* o8 = (u32x2*)(o + (size_t)(m0 + r * stride) * DM) + lane;
#pragma unroll
        for (int j = 0; j < 4; ++j) { u32x2 w; w.x = pk2(B.v[r][j].x, B.v[r][j].y); w.y = pk2(B.v[r][j].z, B.v[r][j].w); o8[64 * j] = w; }
        if (lane == 0) rstd_out[m0 + r * stride] = 1.f / sqrtf(s[r] * (1.f / DM) + NORM_EPS); }
}
__device__ __forceinline__ void rows_phase(const float* x, bf16_t* o, float* rstd_out, int gw, int NGW, int lane) {
    RowBuf A, B; int m = gw;
    if (m + NGW >= MTOK) return;
    rows_load(A, x, m, NGW, lane);
    for (;;) {
        const int m2 = m + 2 * NGW; const bool has2 = m2 + NGW < MTOK;
        if (has2) rows_load(B, x, m2, NGW, lane);
        rows_store(A, o, rstd_out, m, NGW, lane);
        if (!has2) break;
        const int m3 = m2 + 2 * NGW; const bool has3 = m3 + NGW < MTOK;
        if (has3) rows_load(A, x, m3, NGW, lane);
        rows_store(B, o, rstd_out, m2, NGW, lane);
        if (!has3) break;
        m = m3;
    }
}
struct RnBuf { u32x2 mx[2][4]; f32x4 xf[2][4]; u32x2 xb[2][4]; };
template <bool XIN_F32>
__device__ __forceinline__ void rn_load(RnBuf& B, const void* xin, const bf16_t* mix, int m0, int stride, int lane) {
#pragma unroll
    for (int r = 0; r < 2; ++r) { const size_t ro = (size_t)(m0 + r * stride) * DM; const u32x2* mr = (const u32x2*)(mix + ro) + lane;
#pragma unroll
        for (int j = 0; j < 4; ++j) { B.mx[r][j] = mr[64 * j];
            if (XIN_F32) B.xf[r][j] = ((const f32x4*)((const float*)xin + ro) + lane)[64 * j]; else B.xb[r][j] = ((const u32x2*)((const bf16_t*)xin + ro) + lane)[64 * j]; } }
}
template <bool XIN_F32, bool OUT_F32>
__device__ __forceinline__ void rn_process(const RnBuf& B, const float* gpost, void* xout, float* rstd_out, int m0, int stride, int lane) {
    f32x4 v[2][4]; float s[2], s2[2];
#pragma unroll
    for (int r = 0; r < 2; ++r) { s[r] = 0.f;
#pragma unroll
        for (int j = 0; j < 4; ++j) { const u32x2 w = B.mx[r][j]; v[r][j] = (f32x4){bflo(w.x), bfhi(w.x), bflo(w.y), bfhi(w.y)};
            s[r] += (v[r][j].x * v[r][j].x + v[r][j].y * v[r][j].y) + (v[r][j].z * v[r][j].z + v[r][j].w * v[r][j].w); } }
#pragma unroll
    for (int o_ = 1; o_ < 64; o_ <<= 1) {
#pragma unroll
        for (int r = 0; r < 2; ++r) s[r] += __shfl_xor(s[r], o_); }
#pragma unroll
    for (int r = 0; r < 2; ++r) { const float rstd = 1.f / sqrtf(s[r] * (1.f / DM) + NORM_EPS); const size_t ro = (size_t)(m0 + r * stride) * DM; s2[r] = 0.f;
#pragma unroll
        for (int j = 0; j < 4; ++j) { const f32x4 gg = ((const f32x4*)gpost + lane)[64 * j]; f32x4 xo;
            if (XIN_F32) xo = B.xf[r][j]; else { const u32x2 w2 = B.xb[r][j]; xo = (f32x4){bflo(w2.x), bfhi(w2.x), bflo(w2.y), bfhi(w2.y)}; }
            v[r][j] = xo + v[r][j] * rstd * gg;
            s2[r] += (v[r][j].x * v[r][j].x + v[r][j].y * v[r][j].y) + (v[r][j].z * v[r][j].z + v[r][j].w * v[r][j].w);
            if (OUT_F32) ((f32x4*)((float*)xout + ro) + lane)[64 * j] = v[r][j]; else { u32x2 w; w.x = pk2(v[r][j].x, v[r][j].y); w.y = pk2(v[r][j].z, v[r][j].w); ((u32x2*)((bf16_t*)xout + ro) + lane)[64 * j] = w; } } }
    if (!OUT_F32) {
#pragma unroll
        for (int o_ = 1; o_ < 64; o_ <<= 1) {
#pragma unroll
            for (int r = 0; r < 2; ++r) s2[r] += __shfl_xor(s2[r], o_); }
#pragma unroll
        for (int r = 0; r < 2; ++r) if (lane == 0) rstd_out[m0 + r * stride] = 1.f / sqrtf(s2[r] * (1.f / DM) + NORM_EPS); }
}
template <bool XIN_F32, bool OUT_F32>
__device__ __forceinline__ void resnorm_phase(const void* xin, const bf16_t* mix, const float* gpost, void* xout, float* rstd_out, int gw, int NGW, int lane) {
    RnBuf A, B; int m = gw;
    if (m + NGW >= MTOK) return;
    rn_load<XIN_F32>(A, xin, mix, m, NGW, lane);
    for (;;) {
        const int m2 = m + 2 * NGW; const bool has2 = m2 + NGW < MTOK;
        if (has2) rn_load<XIN_F32>(B, xin, mix, m2, NGW, lane);
        rn_process<XIN_F32, OUT_F32>(A, gpost, xout, rstd_out, m, NGW, lane);
        if (!has2) break;
        const int m3 = m2 + 2 * NGW; const bool has3 = m3 + NGW < MTOK;
        if (has3) rn_load<XIN_F32>(A, xin, mix, m3, NGW, lane);
        rn_process<XIN_F32, OUT_F32>(B, gpost, xout, rstd_out, m2, NGW, lane);
        if (!has3) break;
        m = m3;
    }
}

constexpr int AT_KPITCH = 144, AT_VPITCH = 160, AT_VOFF = 256 * AT_KPITCH;
constexpr int AT_UNITS = 12288, AT_HEAD = 0;
typedef short s16x4 __attribute__((ext_vector_type(4)));
__device__ __forceinline__ int attn_seq(int bx, int G, int i) {
    if (G != 256) { const int u = bx + i * G; return u < AT_UNITS ? u : -1; }
    const int x = bx & 7, wl = bx >> 3; int L;
    if (wl >= 16) { if (i < AT_HEAD) L = (wl - 16) + 16 * i; else L = 16 * AT_HEAD + (i - AT_HEAD) * 32 + wl; }
    else L = 16 * AT_HEAD + i * 32 + wl;
    if (L >= AT_UNITS / 8) return -1;
    return (x + 8 * (L / 48)) * 48 + (L % 48);
}
#define AT_DECODE(u) const int sub = (u) & 15, br = ((u) >> 4) % 3, bh = (u) / 48, h = bh & 7, b = bh >> 3; \
    const int dil = br == 0 ? 1 : (br == 1 ? 4 : 16), nb = 16 / dil, rho = sub / nb, n = sub % nb; const bf16_t* Zb = Zp + (size_t)b * SEQ * 2048;
__device__ __forceinline__ void attn_issue(const bf16_t* Zp, int u, int tid, int wave, int lane, u32x4 (&rk)[4], u32x4 (&rv)[4], bf16x8& q0, bf16x8& q1) {
    AT_DECODE(u)
#pragma unroll
    for (int it = 0; it < 4; ++it) { if (n == 0 && it < 2) continue; const int idx = tid + it * NTHREADS, kb = idx >> 3, ch = idx & 7;
        const int tok = (n * 128 - 128 + kb) * dil + rho;
        const bf16_t* rowp = Zb + (size_t)tok * 2048 + h * 64 + ch * 8;
        rk[it] = *(const u32x4*)(rowp + 512); rv[it] = *(const u32x4*)(rowp + 1024); }
    const int kq = lane >> 4, qi = 16 * wave + (lane & 15); const int tokq = (n * 128 + qi) * dil + rho;
    const bf16_t* qrow = Zb + (size_t)tokq * 2048 + h * 64;
    q0 = *(const bf16x8*)(qrow + 8 * kq); q1 = *(const bf16x8*)(qrow + 32 + 8 * kq);
}
__device__ __forceinline__ void attn_phase(const bf16_t* Zp, bf16_t* POp, float* PMp, float* PLp, LAS unsigned char* lds, int bx, int G, int tid, int wave, int lane) {
    int ui = 0; int u = attn_seq(bx, G, 0); if (u < 0) return;
    u32x4 rk[4], rv[4]; bf16x8 q0n, q1n;
    attn_issue(Zp, u, tid, wave, lane, rk, rv, q0n, q1n);
    const int q = lane & 15, kq = lane >> 4, qi = 16 * wave + q;
    for (;;) {
        AT_DECODE(u)
        (void)Zb;
        const int kmin_ = (n == 0) ? 128 : 0; const int mlo = qi > kmin_ ? qi : kmin_; const unsigned mrange = (unsigned)(qi + 128 - mlo);
        __syncthreads();
#pragma unroll
        for (int it = 0; it < 4; ++it) { if (n == 0 && it < 2) continue; const int idx = tid + it * NTHREADS, kb = idx >> 3, ch = idx & 7;
            *(LAS u32x4*)(lds + kb * AT_KPITCH + ch * 16) = rk[it]; *(LAS u32x4*)(lds + AT_VOFF + kb * AT_VPITCH + ch * 16) = rv[it]; }
        if (n == 0 && tid < 128) *(LAS u32x4*)(lds + AT_VOFF + (112 + (tid >> 3)) * AT_VPITCH + (tid & 7) * 16) = (u32x4){0u, 0u, 0u, 0u};
        const bf16x8 qf0 = q0n, qf1 = q1n;
        __syncthreads();
        const int un = attn_seq(bx, G, ui + 1);
        if (un >= 0) attn_issue(Zp, un, tid, wave, lane, rk, rv, q0n, q1n);
        const int kstart = (16 * wave < 96) ? 16 * wave : 96;
        f32x4 st[10];
#pragma unroll
        for (int p = 0; p < 5; ++p) {
            const int ks = kstart + 32 * p;
            const bool live = !(n == 0 && ks + 32 <= 128) && !(ks + 31 < 16 * wave);
            st[2 * p] = (f32x4){-1e30f, -1e30f, -1e30f, -1e30f}; st[2 * p + 1] = st[2 * p];
            if (live) {
                const LAS unsigned char* kp = lds + (ks + q) * AT_KPITCH + kq * 16;
                const bf16x8 k00 = *(const LAS bf16x8*)(kp), k01 = *(const LAS bf16x8*)(kp + 64);
                const bf16x8 k10 = *(const LAS bf16x8*)(kp + 16 * AT_KPITCH), k11 = *(const LAS bf16x8*)(kp + 16 * AT_KPITCH + 64);
                f32x4 s0 = {0.f, 0.f, 0.f, 0.f}, s1 = {0.f, 0.f, 0.f, 0.f};
                s0 = __builtin_amdgcn_mfma_f32_16x16x32_bf16(k00, qf0, s0, 0, 0, 0); s0 = __builtin_amdgcn_mfma_f32_16x16x32_bf16(k01, qf1, s0, 0, 0, 0);
                s1 = __builtin_amdgcn_mfma_f32_16x16x32_bf16(k10, qf0, s1, 0, 0, 0); s1 = __builtin_amdgcn_mfma_f32_16x16x32_bf16(k11, qf1, s1, 0, 0, 0);
                const bool need_mask = !(ks >= 16 * wave + 15 && ks + 31 <= 16 * wave + 128) || (n == 0 && ks < 128);
                if (need_mask) {
                    const int tb = ks + 4 * kq - mlo;
#pragma unroll
                    for (int i = 0; i < 4; ++i) { s0[i] = ((unsigned)(tb + i) <= mrange) ? s0[i] : -1e30f; s1[i] = ((unsigned)(tb + 16 + i) <= mrange) ? s1[i] : -1e30f; }
                }
                st[2 * p] = s0; st[2 * p + 1] = s1;
            }
        }
        float mrun = -1e30f;
#pragma unroll
        for (int j = 0; j < 10; ++j) mrun = fmaxf(mrun, fmaxf(fmaxf(st[j][0], st[j][1]), fmaxf(st[j][2], st[j][3])));
        mrun = fmaxf(mrun, __shfl_xor(mrun, 16)); mrun = fmaxf(mrun, __shfl_xor(mrun, 32));
        float lrun = 0.f;
#pragma unroll
        for (int j = 0; j < 10; ++j)
#pragma unroll
            for (int i = 0; i < 4; ++i) { st[j][i] = fast_exp2(st[j][i] - mrun); lrun += st[j][i]; }
        f32x4 o[4];
#pragma unroll
        for (int mm = 0; mm < 4; ++mm) o[mm] = (f32x4){0.f, 0.f, 0.f, 0.f};
#pragma unroll
        for (int p = 0; p < 5; ++p) {
            const int ks = kstart + 32 * p;
            const bool live = !(n == 0 && ks + 32 <= 128) && !(ks + 31 < 16 * wave);
            if (live) {
                const LAS unsigned char* vp = lds + AT_VOFF + (ks + 4 * kq + (q >> 2)) * AT_VPITCH + (q & 3) * 8;
                u32x4 pw; pw.x = pk2(st[2 * p][0], st[2 * p][1]); pw.y = pk2(st[2 * p][2], st[2 * p][3]); pw.z = pk2(st[2 * p + 1][0], st[2 * p + 1][1]); pw.w = pk2(st[2 * p + 1][2], st[2 * p + 1][3]);
                const bf16x8 pf = __builtin_bit_cast(bf16x8, pw);
#pragma unroll
                for (int mm = 0; mm < 4; ++mm) {
                    const s16x4 vlo = __builtin_bit_cast(s16x4, __builtin_amdgcn_ds_read_tr16_b64_v4i16((LAS s16x4*)(vp + 32 * mm)));
                    const s16x4 vhi = __builtin_bit_cast(s16x4, __builtin_amdgcn_ds_read_tr16_b64_v4i16((LAS s16x4*)(vp + 16 * AT_VPITCH + 32 * mm)));
                    bf16x8 vf; vf[0] = vlo[0]; vf[1] = vlo[1]; vf[2] = vlo[2]; vf[3] = vlo[3]; vf[4] = vhi[0]; vf[5] = vhi[1]; vf[6] = vhi[2]; vf[7] = vhi[3];
                    o[mm] = __builtin_amdgcn_mfma_f32_16x16x32_bf16(vf, pf, o[mm], 0, 0, 0); }
            }
        }
        lrun += __shfl_xor(lrun, 16); lrun += __shfl_xor(lrun, 32);
        const float inv = 1.f / lrun; const int tokq = (n * 128 + qi) * dil + rho; const size_t row = (size_t)b * SEQ + tokq;
        bf16_t* orow = POp + ((size_t)br * MTOK + row) * 512 + h * 64 + 4 * kq;
#pragma unroll
        for (int mm = 0; mm < 4; ++mm) { u32x2 w; w.x = pk2(o[mm][0] * inv, o[mm][1] * inv); w.y = pk2(o[mm][2] * inv, o[mm][3] * inv); *(u32x2*)(orow + 16 * mm) = w; }
        if (kq == 0) { PMp[((size_t)br * MTOK + row) * 8 + h] = mrun; PLp[((size_t)br * MTOK + row) * 8 + h] = lrun; }
        if (un < 0) break;
        u = un; ++ui;
    }
}

constexpr int S5_BUSP = 132, S5_HSP = 136;
constexpr int S5_WAVE_BYTES = 16 * S5_BUSP * 4 + 16 * S5_HSP * 2;
__device__ __forceinline__ void s5_unit(const bf16_t* Zp, const unsigned char* tab, const float* dskip, bf16_t* Y5p, LAS unsigned char* lds, int unit, int wave, int lane) {
    const int b = unit >> 3, g = (unit & 7) * 4 + wave;
    LAS float* bus = (LAS float*)(lds + wave * S5_WAVE_BYTES);
    LAS bf16_t* hs = (LAS bf16_t*)(lds + wave * S5_WAVE_BYTES + 16 * S5_BUSP * 4);
    const int n = lane & 15, kg = lane >> 4;
    const bf16_t* BMt = (const bf16_t*)(tab + S5_BM); const bf16_t* CMt = (const bf16_t*)(tab + S5_CM); const float* AB = (const float*)(tab + S5_ABAR);
    bf16x8 bm[8], cm[4];
#pragma unroll
    for (int nt = 0; nt < 8; ++nt) bm[nt] = *(const bf16x8*)(BMt + ((size_t)(g * 128 + 16 * nt + n)) * 32 + 8 * kg);
#pragma unroll
    for (int kk = 0; kk < 4; ++kk) cm[kk] = *(const bf16x8*)(CMt + ((size_t)(g * 16 + n)) * 128 + 32 * kk + 8 * kg);
    const f32x4 dsk4 = *(const f32x4*)(dskip + g * 16 + 4 * kg);
    const float ar = AB[(g * 64 + lane) * 2], ai = AB[(g * 64 + lane) * 2 + 1];
    f32x2 hv = {0.f, 0.f}; const f32x2 a_rr = {ar, ar}, a_ii = {-ai, ai};
    const bf16_t* ub = Zp + (size_t)b * SEQ * 2048 + 1536 + g * 16;
    bf16_t* yb = Y5p + (size_t)b * SEQ * 512 + g * 16 + 4 * kg;
    LAS bf16_t* uls = (LAS bf16_t*)(lds + 8 * S5_WAVE_BYTES + wave * 1024);
    bf16x8 q1[4], q2[4];
#pragma unroll
    for (int j = 0; j < 4; ++j) { q1[j] = (bf16x8){0, 0, 0, 0, 0, 0, 0, 0}; q2[j] = q1[j];
        if (kg < 2) { q1[j] = *(const bf16x8*)(ub + (size_t)(16 * j + n) * 2048 + 8 * kg); q2[j] = *(const bf16x8*)(ub + (size_t)(64 + 16 * j + n) * 2048 + 8 * kg); } }
    {
        const bf16x8 uf = q1[0];
        if (kg < 2) *(LAS bf16x8*)(uls + n * 32 + 8 * kg) = uf;
#pragma unroll
        for (int nt = 0; nt < 8; ++nt) { f32x4 d = {0.f, 0.f, 0.f, 0.f}; d = __builtin_amdgcn_mfma_f32_16x16x32_bf16(bm[nt], uf, d, 0, 0, 0);
            *(LAS f32x4*)(bus + n * S5_BUSP + 16 * nt + 4 * kg) = d; }
    }
    u32x2 usp = {0u, 0u};
    for (int sb = 0; sb < SEQ / 64; ++sb) {
        bf16x8 ufc[4];
#pragma unroll
        for (int j = 0; j < 4; ++j) { ufc[j] = q1[j]; q1[j] = q2[j]; if (kg < 2 && sb + 2 < SEQ / 64) q2[j] = *(const bf16x8*)(ub + (size_t)((sb + 2) * 64 + 16 * j + n) * 2048 + 8 * kg); }
#pragma unroll
        for (int j = 0; j < 4; ++j) {
            asm volatile("" ::: "memory");
            const int k = 4 * sb + j;
            bf16x8 hf[4];
#pragma unroll
            for (int kk = 0; kk < 4; ++kk) hf[kk] = *(const LAS bf16x8*)(hs + n * S5_HSP + 32 * kk + 8 * kg);
            f32x2 bv[16];
#pragma unroll
            for (int t = 0; t < 16; ++t) bv[t] = *(const LAS f32x2*)(bus + t * S5_BUSP + 2 * lane);
            const u32x2 usc = *(const LAS u32x2*)(uls + n * 32 + 4 * kg);
            const bf16x8 ufn = (j < 3) ? ufc[(j + 1) & 3] : q1[0];
            f32x4 d[8];
#pragma unroll
            for (int nt = 0; nt < 8; ++nt) { d[nt] = (f32x4){0.f, 0.f, 0.f, 0.f}; d[nt] = __builtin_amdgcn_mfma_f32_16x16x32_bf16(bm[nt], ufn, d[nt], 0, 0, 0); }
            f32x4 y = {0.f, 0.f, 0.f, 0.f};
#pragma unroll
            for (int kk = 0; kk < 4; ++kk) y = __builtin_amdgcn_mfma_f32_16x16x32_bf16(cm[kk], hf[kk], y, 0, 0, 0);
#pragma unroll
            for (int t = 0; t < 16; ++t) { const f32x2 hsw = __builtin_shufflevector(hv, hv, 1, 0);
                hv = a_rr * hv + bv[t]; hv = a_ii * hsw + hv;
                *(LAS unsigned*)(hs + t * S5_HSP + 2 * lane) = pk2(hv.x, hv.y); }
#pragma unroll
            for (int nt = 0; nt < 8; ++nt) *(LAS f32x4*)(bus + n * S5_BUSP + 16 * nt + 4 * kg) = d[nt];
            if (kg < 2) *(LAS bf16x8*)(uls + n * 32 + 8 * kg) = ufn;
            if (k >= 1) {
#pragma unroll
                for (int i = 0; i < 4; ++i) { const unsigned uw = (i < 2) ? usp.x : usp.y; const float uu = (i & 1) ? bfhi(uw) : bflo(uw); y[i] = gelu_tanh(y[i] + dsk4[i] * uu); }
                u32x2 w; w.x = pk2(y[0], y[1]); w.y = pk2(y[2], y[3]); *(u32x2*)(yb + (size_t)(16 * (k - 1) + n) * 512) = w; }
#pragma unroll
            for (int i = 0; i < 1; ++i) usp = usc;
        }
    }
    {
        asm volatile("" ::: "memory");
        f32x4 y = {0.f, 0.f, 0.f, 0.f};
#pragma unroll
        for (int kk = 0; kk < 4; ++kk) { const bf16x8 hf = *(const LAS bf16x8*)(hs + n * S5_HSP + 32 * kk + 8 * kg); y = __builtin_amdgcn_mfma_f32_16x16x32_bf16(cm[kk], hf, y, 0, 0, 0); }
#pragma unroll
        for (int i = 0; i < 4; ++i) { const unsigned uw = (i < 2) ? usp.x : usp.y; const float uu = (i & 1) ? bfhi(uw) : bflo(uw); y[i] = gelu_tanh(y[i] + dsk4[i] * uu); }
        { u32x2 w; w.x = pk2(y[0], y[1]); w.y = pk2(y[2], y[3]); *(u32x2*)(yb + (size_t)(SEQ - 16 + n) * 512) = w; }
    }
    LDS_WAIT();
}

#define XB_TMO      128
#define XB_XCNT(j)  (256  + 64 * (j))
#define XB_XSUB(j)  (1280 + 64 * (j))
#define XB_XGEN(j)  (2304 + 64 * (j))
#define XB_TOP      3328
#define XB_TOPGEN   3392
#define XCD_BAR_WORDS 3456
#define XB_SPIN_CAP (1u << 22)
__device__ __forceinline__ unsigned xb_ld(unsigned* p)              { return __hip_atomic_load(p, __ATOMIC_RELAXED, __HIP_MEMORY_SCOPE_AGENT); }
__device__ __forceinline__ unsigned xb_add(unsigned* p, unsigned v) { return __hip_atomic_fetch_add(p, v, __ATOMIC_RELAXED, __HIP_MEMORY_SCOPE_AGENT); }
__device__ __forceinline__ unsigned xb_xcc_id() { return (unsigned)__builtin_amdgcn_s_getreg((3 << 11) | 20) & 0xFu; }
#define XB_SPIN(cond, bar) do { unsigned _sp = 0; while (cond) { __builtin_amdgcn_s_sleep(1); \
    if ((++_sp & 255u) == 0u) { if (xb_ld(&(bar)[XB_TMO])) break; if (_sp > XB_SPIN_CAP) { atomicAdd(&(bar)[XB_TMO], 1u); break; } } } } while (0)
__device__ __forceinline__ void xcd_barrier_complete(unsigned* bar, unsigned x, unsigned& nloc, unsigned& nx) {
    const unsigned G = gridDim.x * gridDim.y * gridDim.z;
    unsigned sum, cnt, mine, sp = 0u;
    for (;;) {
        sum = 0u; cnt = 0u; mine = 0u;
#pragma unroll
        for (unsigned j = 0; j < 16; ++j) { const unsigned c = xb_ld(&bar[XB_XCNT(j)]); sum += c; cnt += (c > 0u) ? 1u : 0u; mine = (j == x) ? c : mine; }
        if (sum == G) break;
        __builtin_amdgcn_s_sleep(1);
        if ((++sp & 255u) == 0u) { if (xb_ld(&bar[XB_TMO])) break; if (sp > XB_SPIN_CAP) { atomicAdd(&bar[XB_TMO], 1u); break; } }
    }
    nloc = mine > 0u ? mine : 1u; nx = cnt > 0u ? cnt : 1u;
}
__device__ __forceinline__ void xcd_barrier(unsigned* bar, volatile LAS unsigned* st) {
    asm volatile("s_waitcnt vmcnt(0)" ::: "memory");
    __syncthreads();
    if (threadIdx.x == 0) {
        const unsigned x = xb_xcc_id();
        __builtin_amdgcn_s_waitcnt(0);
        unsigned nloc = st[0], nx = st[1];
        if (nloc == 0u) { xcd_barrier_complete(bar, x, nloc, nx); st[0] = nloc; st[1] = nx; }
        const unsigned old = xb_add(&bar[XB_XSUB(x)], 1u);
        const unsigned gen = old / nloc;
        if (old + 1u == (gen + 1u) * nloc) {
            __builtin_amdgcn_fence(__ATOMIC_RELEASE, "agent");
            asm volatile("s_waitcnt vmcnt(0)" ::: "memory");
            const unsigned og = xb_add(&bar[XB_TOP], 1u);
            const unsigned tg = og / nx;
            if (og + 1u == (tg + 1u) * nx) xb_add(&bar[XB_TOPGEN], 1u);
            else XB_SPIN(xb_ld(&bar[XB_TOPGEN]) == tg, bar);
            __builtin_amdgcn_fence(__ATOMIC_ACQUIRE, "agent");
            xb_add(&bar[XB_XGEN(x)], 1u);
            asm volatile("s_waitcnt vmcnt(0)" ::: "memory");
        } else {
            XB_SPIN(xb_ld(&bar[XB_XGEN(x)]) == gen, bar);
            __builtin_amdgcn_fence(__ATOMIC_ACQUIRE, "agent");
            asm volatile("s_waitcnt vmcnt(0)" ::: "memory");
        }
    }
    __syncthreads();
}
constexpr int LDS_MISC = 135 * 1024;
constexpr size_t CTL_BYTES = 16384;

#ifndef TSEL_LO
#define TSEL_LO -1
#define TSEL_HI -1
#define TSEL_STEP 1
#endif
#define STAMP(k) do { if (TSEL_LO >= 0 && blockIdx.x == 0 && threadIdx.x == 0) ((volatile LAS unsigned long long*)(lds + LDS_MISC + 64))[(k)] = __builtin_amdgcn_s_memrealtime(); } while (0)
typedef const __attribute__((address_space(4))) Args* ArgsP;
__global__ void __launch_bounds__(NTHREADS, 2) mega(Args a_kern) {
    extern __shared__ __attribute__((aligned(16))) unsigned char lds_raw[];
    LAS unsigned char* lds = (LAS unsigned char*)lds_raw;
    cg::grid_group grid = cg::this_grid();
    ArgsP ap = (ArgsP)__builtin_amdgcn_kernarg_segment_ptr();
#define a (*ap)
#define ws (a.ws)
    int tid, lane, wave, gw, gt;
    const int G = gridDim.x, bx = blockIdx.x;
    const int NGW = G * NWAVES, NGT = G * NTHREADS;
#define RELOAD() do { asm volatile("" : "+s"(ap)); tid = threadIdx.x; asm volatile("" : "+v"(tid)); lane = tid & 63; wave = __builtin_amdgcn_readfirstlane(tid >> 6); gw = bx * NWAVES + wave; gt = bx * NTHREADS + tid; } while (0)
    RELOAD();
    if (a.ph_lo < 0) grid.sync();
    volatile LAS unsigned* bst = (volatile LAS unsigned*)(lds + LDS_MISC);
    if (tid == 0) { bst[0] = 0u; bst[1] = 0u; (void)xb_add((unsigned*)(ws + WS_CTL) + XB_XCNT(xb_xcc_id()), 1u); }
    __syncthreads();
    STAMP(0);
#define x_in (a.in[0])
#define positions ((const int*)a.in[1])
#define g_mix_pre (a.in[2])
#define g_mix_post (a.in[3])
#define g_ffn_pre (a.in[4])
#define g_ffn_post (a.in[5])
#define HN ((bf16_t*)(ws + WS_HN))
#define RSTD ((float*)(ws + WS_CTL + 512 * 1024))
#define Z ((bf16_t*)(ws + WS_Z))
#define YC ((bf16_t*)(ws + WS_YC))
#define MIX ((bf16_t*)(ws + WS_MIX))
#define PO ((bf16_t*)(ws + WS_PO))
#define PM ((float*)(ws + WS_PM))
#define PL ((float*)(ws + WS_PL))
#define Y5 ((bf16_t*)(ws + WS_Y5))
#define HID ((bf16_t*)(ws + WS_HID))
#define XC ((bf16_t*)(ws + WS_XC))
#define BB ((bf16_t*)(ws + WS_BB))
#define Y1 ((bf16_t*)(ws + WS_Y1))
#define LA ((bf16_t*)(ws + WS_LA))
#define ROPE ((float*)(ws + WS_ROPE))
#define S5T (ws + WS_S5TAB)
#define SP ((float*)(ws + WS_S5TAB + S5_SP))
#define X (a.out)
#ifndef PHMASK
#define PHMASK 0xFFFFFFFFu
#endif
#define IN(k) (((PHMASK >> (k)) & 1u) && a.ph_lo <= (k) && (k) < a.ph_hi)
#ifndef REPMASK
#define REPMASK 0x0u
#endif
#define REPS(k) (1 + (int)((REPMASK >> (k)) & 1u))
#define REPSYNC do { if (rep) grid.sync(); } while (0)
#define SEAM(k) do { if (IN(k) && IN((k) + 1)) { xcd_barrier((unsigned*)(ws + WS_CTL), bst); } STAMP((k) + 1); RELOAD(); } while (0)

    constexpr int I_IN = 16 * 64, I_OUT = 16 * 32, I_GLU = 8 * 16, I_GATE = 4 * 64, I_UP = 16 * 176, I_DN = 44 * 32;
#define XPOSE_ITEM(ITEM, scr) do { int r = (ITEM); \
            if (r < I_IN) { const int kb = r / 64, nb = r % 64; transpose_item(a.in[6] + nb * 32, 2048, 1024, (bf16_t*)(ws + WS_W_IN0) + (size_t)nb * 32 * 1024, kb * 64, scr, lane, g_mix_pre); break; } r -= I_IN; \
            if (r < I_IN) { const int kb = r / 64, nb = r % 64; transpose_item(a.in[17] + nb * 32, 2048, 1024, (bf16_t*)(ws + WS_W_IN1) + (size_t)nb * 32 * 1024, kb * 64, scr, lane, g_mix_pre + DM); break; } r -= I_IN; \
            if (r < I_OUT) { const int kb = r / 32, nb = r % 32; transpose_item(a.in[7] + nb * 32, 1024, 1024, (bf16_t*)(ws + WS_W_OUT0) + (size_t)nb * 32 * 1024, kb * 64, scr, lane); break; } r -= I_OUT; \
            if (r < I_OUT) { const int kb = r / 32, nb = r % 32; transpose_item(a.in[18] + nb * 32, 1024, 1024, (bf16_t*)(ws + WS_W_OUT1) + (size_t)nb * 32 * 1024, kb * 64, scr, lane); break; } r -= I_OUT; \
            if (r < I_GLU) { const int kb = r / 16, nb = r % 16; transpose_item(a.in[16] + nb * 32, 512, 512, (bf16_t*)(ws + WS_W_GLU) + (size_t)nb * 32 * 512, kb * 64, scr, lane); break; } r -= I_GLU; \
            if (r < I_GATE) { const int kb = r / 64, nb = r % 64; const int n0 = nb * 32, pn = n0 >> 8, half = (n0 >> 7) & 1, j = n0 & 127, hh = pn >> 1, colg = (pn & 1) * 128 + j; \
                const float* src = (half ? a.in[23] : a.in[21]) + (size_t)hh * 256 * 256 + colg; \
                transpose_item(src, 256, 256, (bf16_t*)(ws + WS_W_GATE) + (size_t)n0 * 256, kb * 64, scr, lane); break; } r -= I_GATE; \
            if (r < 2 * I_UP) { const int layer = r / I_UP; r -= layer * I_UP; const int kb = r / 176, nb = r % 176; const int n0 = nb * 32, t = n0 >> 8, half = (n0 >> 7) & 1, j = n0 & 127; \
                const float* src = (half ? a.in[27] : a.in[26]) + (size_t)layer * 1024 * FFH + t * 128 + j; \
                transpose_item(src, FFH, 1024, (bf16_t*)(ws + (layer ? WS_W_UP1 : WS_W_UP0)) + (size_t)n0 * 1024, kb * 64, scr, lane, g_ffn_pre + layer * DM); break; } r -= 2 * I_UP; \
            { const int layer = r / I_DN; r -= layer * I_DN; const int kb = r / 32, nb = r % 32; \
                transpose_item(a.in[28] + (size_t)layer * FFH * 1024 + nb * 32, 1024, FFH, (bf16_t*)(ws + (layer ? WS_W_DN1 : WS_W_DN0)) + (size_t)nb * 32 * FFH, kb * 64, scr, lane); } \
        } while (0)
    if (IN(0)) _Pragma("unroll") for (int rep = 0; rep < REPS(0); ++rep) {
        LAS float* scr = (LAS float*)(lds + wave * 8448);
        for (int j = gw; j < I_IN; j += NGW) { XPOSE_ITEM(j, scr); }
        for (int idx = gt; idx < MTOK * 8; idx += NGT) { const int tok = idx >> 3, j = idx & 7; const float inv_freq = powf(500000.0f, -(float)j * 0.125f);
            const float ang = (float)positions[tok] * inv_freq; float s, c; sincos_rr(ang, s, c); ROPE[(size_t)tok * 16 + j] = c; ROPE[(size_t)tok * 16 + 8 + j] = s; }
        for (int it = gt; it < 32 * 64 * 16; it += NGT) { const int idx = it >> 4, c = it & 15, g = idx >> 6, p = idx & 63;
            const float are = a.in[8][idx], aim = a.in[9][idx], dt = expf(a.in[10][g]);
            const float xr = are * dt, yi = aim * dt; const float ex = expf(xr); float sn, cs; sincos_rr(yi, sn, cs);
            const float abr = ex * cs, abi = ex * sn;
            float sh, ch; sincos_rr(0.5f * yi, sh, ch); (void)ch;
            const float nre = expm1f(xr) * cs - 2.f * sh * sh, nim = abi;
            const float den = 1.f / (are * are + aim * aim);
            const float cre = (nre * are + nim * aim) * den, cim = (nim * are - nre * aim) * den;
            if (c == 0) { float* AB = (float*)(S5T + S5_ABAR); AB[idx * 2] = abr; AB[idx * 2 + 1] = abi; }
            bf16_t* BMt = (bf16_t*)(S5T + S5_BM); bf16_t* CMt = (bf16_t*)(S5T + S5_CM);
            const float bre = a.in[11][(size_t)idx * 16 + c], bim = a.in[12][(size_t)idx * 16 + c];
            BMt[((size_t)g * 128 + 2 * p) * 32 + c] = (bf16_t)f2bf(cre * bre - cim * bim); BMt[((size_t)g * 128 + 2 * p + 1) * 32 + c] = (bf16_t)f2bf(cre * bim + cim * bre);
            BMt[((size_t)g * 128 + 2 * p) * 32 + 16 + c] = 0; BMt[((size_t)g * 128 + 2 * p + 1) * 32 + 16 + c] = 0;
            CMt[((size_t)g * 16 + c) * 128 + 2 * p] = (bf16_t)f2bf(a.in[13][((size_t)g * 16 + c) * 64 + p]); CMt[((size_t)g * 16 + c) * 128 + 2 * p + 1] = (bf16_t)f2bf(-a.in[14][((size_t)g * 16 + c) * 64 + p]); }
        for (int idx = gt; idx < 1024; idx += NGT) SP[idx] = log1pf(expf(-a.in[25][idx]));
        rows_phase(x_in, HN, RSTD, gw, NGW, lane);
    }
    SEAM(0);
    if (IN(1)) _Pragma("unroll") for (int rep = 0; rep < REPS(1); ++rep) { pg8::Gemm g{HN, (const bf16_t*)(ws + WS_W_IN0), MTOK, 2048, 1024, 1024, 0}; pg8::StaticOrder S; S.init(MTOK, 2048, G, bx);
        pg8::EpiRope E{Z, ROPE, RSTD}; pg8::gemm_phase(lds, g, S, E); }
    SEAM(1);
    if (IN(2)) _Pragma("unroll") for (int rep = 0; rep < REPS(2); ++rep) {
        if (wave < 4) { for (int u = bx; u < 256; u += G) s5_unit(Z, S5T, a.in[15], Y5, lds, u, wave, lane); }
        else {
            LAS float* scr2 = (LAS float*)(lds + 56 * 1024 + (wave - 4) * 8448);
            constexpr int NLATE = I_IN + 2 * I_OUT + I_GLU + I_GATE + 2 * I_UP + 2 * I_DN;
            for (int k = bx * 4 + (wave - 4); k < NLATE; k += G * 4) { XPOSE_ITEM(I_IN + k, scr2); }
        }
        attn_phase(Z, PO, PM, PL, lds, bx, G, tid, wave, lane);
    }
    SEAM(2);
    if (IN(3)) _Pragma("unroll") for (int rep = 0; rep < REPS(3); ++rep) {
        for (int idx0 = gt; idx0 < MTOK * 64; idx0 += 4 * NGT) {
            float mv[4][3], lv[4][3]; u32x4 ow[4][3];
#pragma unroll
            for (int r = 0; r < 4; ++r) { const int idx = idx0 + r * NGT, row = idx >> 6, c8 = idx & 63, h = c8 >> 3;
#pragma unroll
                for (int i = 0; i < 3; ++i) { mv[r][i] = PM[((size_t)i * MTOK + row) * 8 + h]; lv[r][i] = PL[((size_t)i * MTOK + row) * 8 + h]; ow[r][i] = *(const u32x4*)(PO + ((size_t)i * MTOK + row) * 512 + c8 * 8); } }
#pragma unroll
            for (int r = 0; r < 4; ++r) { const int idx = idx0 + r * NGT, row = idx >> 6, c8 = idx & 63;
                const float mx = fmaxf(mv[r][0], fmaxf(mv[r][1], mv[r][2]));
                float w[3]; float den = 0.f;
#pragma unroll
                for (int i = 0; i < 3; ++i) { w[i] = fast_exp2(mv[r][i] - mx) * lv[r][i]; den += w[i]; }
                const float inv = 1.f / den; f32x4 v0 = {0.f, 0.f, 0.f, 0.f}, v1 = v0;
#pragma unroll
                for (int i = 0; i < 3; ++i) { const float ww = w[i] * inv;
                    v0[0] += ww * bflo(ow[r][i].x); v0[1] += ww * bfhi(ow[r][i].x); v0[2] += ww * bflo(ow[r][i].y); v0[3] += ww * bfhi(ow[r][i].y);
                    v1[0] += ww * bflo(ow[r][i].z); v1[1] += ww * bfhi(ow[r][i].z); v1[2] += ww * bflo(ow[r][i].w); v1[3] += ww * bfhi(ow[r][i].w); }
                pg8::st8(YC + (size_t)row * 1024 + c8 * 8, v0, v1); } }
        __syncthreads();
        pg8::Gemm g{Y5, (const bf16_t*)(ws + WS_W_GLU), MTOK, 512, 512, 512, 0}; pg8::StaticOrder S; S.init(MTOK, 512, G, bx);
        pg8::EpiGlu E{Y5, YC}; pg8::gemm_phase(lds, g, S, E);
    }
    SEAM(3);
    if (IN(4)) _Pragma("unroll") for (int rep = 0; rep < REPS(4); ++rep) { pg8::Gemm g{YC, (const bf16_t*)(ws + WS_W_OUT0), MTOK, 1024, 1024, 1024, 0}; pg8::StaticOrder S; S.init(MTOK, 1024, G, bx);
        pg8::EpiPlain E{MIX, 1024}; pg8::gemm_phase(lds, g, S, E); }
    SEAM(4);
    if (IN(5)) _Pragma("unroll") for (int rep = 0; rep < REPS(5); ++rep) resnorm_phase<false, false>(HN, MIX, g_mix_post, HN, RSTD, gw, NGW, lane);
    SEAM(5);
    if (IN(6)) _Pragma("unroll") for (int rep = 0; rep < REPS(6); ++rep) { pg8::Gemm g{HN, (const bf16_t*)(ws + WS_W_UP0), MTOK, 2 * FFH, 1024, 1024, 0}; pg8::StaticOrder S; S.init(MTOK, 2 * FFH, G, bx);
        pg8::EpiSwiGlu E{HID, RSTD}; pg8::gemm_phase(lds, g, S, E); }
    SEAM(6);
    if (IN(7)) _Pragma("unroll") for (int rep = 0; rep < REPS(7); ++rep) { pg8::Gemm g{HID, (const bf16_t*)(ws + WS_W_DN0), MTOK, 1024, FFH, FFH, 0}; pg8::StaticOrder S; S.init(MTOK, 1024, G, bx);
        pg8::EpiPlain E{MIX, 1024}; pg8::gemm_phase(lds, g, S, E); }
    SEAM(7);
    if (IN(8)) _Pragma("unroll") for (int rep = 0; rep < REPS(8); ++rep) resnorm_phase<false, false>(HN, MIX, g_ffn_post, HN, RSTD, gw, NGW, lane);
    SEAM(8);
    if (IN(9)) _Pragma("unroll") for (int rep = 0; rep < REPS(9); ++rep) { pg8::Gemm g{HN, (const bf16_t*)(ws + WS_W_IN1), MTOK, 2048, 1024, 1024, 0}; pg8::StaticOrder S; S.init(MTOK, 2048, G, bx);
        pg8::EpiIn1 E{Z, RSTD}; pg8::gemm_phase(lds, g, S, E); }
    SEAM(9);
    if (IN(10)) _Pragma("unroll") for (int rep = 0; rep < REPS(10); ++rep) {
        const float* cw = a.in[19]; const float* cb = a.in[20];
        constexpr int RB = 16;
        for (int idx = gt; idx < (MTOK / RB) * 128; idx += NGT) { const int c8 = idx & 127, tb = idx >> 7, row0 = tb * RB, c0 = c8 * 8; const int t0 = row0 & (SEQ - 1);
            u32x4 xr[RB + 3];
#pragma unroll
            for (int k = 0; k < RB + 3; ++k) { xr[k] = (u32x4){0u, 0u, 0u, 0u}; if (k >= 3 || t0 > 0) xr[k] = *(const u32x4*)(Z + (size_t)(row0 - 3 + k) * 2048 + c0); }
            float w[4][8], bias[8];
#pragma unroll
            for (int k = 0; k < 4; ++k) { const f32x4 wa = *(const f32x4*)(cw + k * 1024 + c0), wb = *(const f32x4*)(cw + k * 1024 + c0 + 4);
                w[k][0] = wa.x; w[k][1] = wa.y; w[k][2] = wa.z; w[k][3] = wa.w; w[k][4] = wb.x; w[k][5] = wb.y; w[k][6] = wb.z; w[k][7] = wb.w; }
            { const f32x4 ba = *(const f32x4*)(cb + c0), bb = *(const f32x4*)(cb + c0 + 4); bias[0] = ba.x; bias[1] = ba.y; bias[2] = ba.z; bias[3] = ba.w; bias[4] = bb.x; bias[5] = bb.y; bias[6] = bb.z; bias[7] = bb.w; }
            float xm[3][8];
#pragma unroll
            for (int k = 0; k < 3; ++k) { const u32x4 v = xr[k];
                xm[k][0] = bflo(v.x); xm[k][1] = bfhi(v.x); xm[k][2] = bflo(v.y); xm[k][3] = bfhi(v.y); xm[k][4] = bflo(v.z); xm[k][5] = bfhi(v.z); xm[k][6] = bflo(v.w); xm[k][7] = bfhi(v.w); }
#pragma unroll
            for (int r = 0; r < RB; ++r) { const u32x4 v = xr[r + 3];
                const float xc[8] = {bflo(v.x), bfhi(v.x), bflo(v.y), bfhi(v.y), bflo(v.z), bfhi(v.z), bflo(v.w), bfhi(v.w)};
                f32x4 o0, o1;
#pragma unroll
                for (int i = 0; i < 8; ++i) { const float o = bias[i] + w[0][i] * xm[0][i] + w[1][i] * xm[1][i] + w[2][i] * xm[2][i] + w[3][i] * xc[i];
                    if (i < 4) o0[i] = o; else o1[i - 4] = o; xm[0][i] = xm[1][i]; xm[1][i] = xm[2][i]; xm[2][i] = xc[i]; }
                pg8::st8(XC + (size_t)(row0 + r) * 1024 + c0, o0, o1); } }
    }
    SEAM(10);
    if (IN(11)) _Pragma("unroll") for (int rep = 0; rep < REPS(11); ++rep) { pg8::Gemm g{XC, (const bf16_t*)(ws + WS_W_GATE), MTOK, 2048, 256, 1024, 1}; pg8::StaticOrder S; S.init(MTOK, 2048, G, bx);
        pg8::EpiGates E{XC, LA, BB, a.in[22], a.in[24], SP}; pg8::gemm_phase(lds, g, S, E); }
    SEAM(11);
    if (IN(12)) _Pragma("unroll") for (int rep = 0; rep < REPS(12); ++rep) {
        LAS float* car = (LAS float*)lds;
        for (int u = bx; u < 256; u += G) { const int b = u >> 3, c0 = (u & 7) * 128 + 2 * lane;
            float cin0 = 0.f, cin1 = 0.f;
            for (int r = 0; r < 8; ++r) { const size_t rbase = (size_t)b * SEQ + r * 256 + wave * 32;
                const bf16_t* la = LA + rbase * 1024 + c0; const bf16_t* bb = BB + rbase * 1024 + c0; const bf16_t* gb = Z + rbase * 2048 + 1024 + c0; bf16_t* yo = Y1 + rbase * 1024 + c0;
                unsigned lq[32], bq[32], gq[32];
#pragma unroll
                for (int i = 0; i < 32; ++i) { lq[i] = *(const unsigned*)(la + (size_t)i * 1024); bq[i] = *(const unsigned*)(bb + (size_t)i * 1024); }
#pragma unroll
                for (int i = 0; i < 32; ++i) gq[i] = *(const unsigned*)(gb + (size_t)i * 2048);
                float h0 = 0.f, h1 = 0.f, s0 = 0.f, s1 = 0.f;
#pragma unroll
                for (int i = 0; i < 32; ++i) { const float l0 = bflo(lq[i]), l1 = bfhi(lq[i]); s0 += l0; s1 += l1;
                    const float a0 = fast_exp2(l0 * LOG2E), a1 = fast_exp2(l1 * LOG2E);
                    const float b0 = sqrtf(fmaxf(1.f - a0 * a0, 0.f)) * bflo(bq[i]), b1 = sqrtf(fmaxf(1.f - a1 * a1, 0.f)) * bfhi(bq[i]);
                    bq[i] = pk2(b0, b1);
                    h0 = a0 * h0 + bflo(bq[i]); h1 = a1 * h1 + bfhi(bq[i]); }
                __syncthreads();
                *(LAS f32x4*)(car + (wave * 64 + lane) * 4) = (f32x4){fast_exp2(s0 * LOG2E), fast_exp2(s1 * LOG2E), h0, h1};
                __syncthreads();
                h0 = cin0; h1 = cin1; float e0 = cin0, e1 = cin1;
#pragma unroll
                for (int j = 0; j < 8; ++j) { const f32x4 cv = *(const LAS f32x4*)(car + (j * 64 + lane) * 4);
                    if (j < wave) { h0 = cv.x * h0 + cv.z; h1 = cv.y * h1 + cv.w; }
                    e0 = cv.x * e0 + cv.z; e1 = cv.y * e1 + cv.w; }
                cin0 = e0; cin1 = e1;
#pragma unroll
                for (int i = 0; i < 32; ++i) { h0 = fast_exp2(bflo(lq[i]) * LOG2E) * h0 + bflo(bq[i]); h1 = fast_exp2(bfhi(lq[i]) * LOG2E) * h1 + bfhi(bq[i]);
                    *(unsigned*)(yo + (size_t)i * 1024) = pk2(h0 * bflo(gq[i]), h1 * bfhi(gq[i])); }
            }
        }
    }
    SEAM(12);
    if (IN(13)) _Pragma("unroll") for (int rep = 0; rep < REPS(13); ++rep) { pg8::Gemm g{Y1, (const bf16_t*)(ws + WS_W_OUT1), MTOK, 1024, 1024, 1024, 0}; pg8::StaticOrder S; S.init(MTOK, 1024, G, bx);
        pg8::EpiPlain E{MIX, 1024}; pg8::gemm_phase(lds, g, S, E); }
    SEAM(13);
    if (IN(14)) _Pragma("unroll") for (int rep = 0; rep < REPS(14); ++rep) resnorm_phase<false, false>(HN, MIX, g_mix_post + DM, HN, RSTD, gw, NGW, lane);
    SEAM(14);
    if (IN(15)) _Pragma("unroll") for (int rep = 0; rep < REPS(15); ++rep) { pg8::Gemm g{HN, (const bf16_t*)(ws + WS_W_UP1), MTOK, 2 * FFH, 1024, 1024, 0}; pg8::StaticOrder S; S.init(MTOK, 2 * FFH, G, bx);
        pg8::EpiSwiGlu E{HID, RSTD}; pg8::gemm_phase(lds, g, S, E); }
    SEAM(15);
    if (IN(16)) _Pragma("unroll") for (int rep = 0; rep < REPS(16); ++rep) { pg8::Gemm g{HID, (const bf16_t*)(ws + WS_W_DN1), MTOK, 1024, FFH, FFH, 0}; pg8::StaticOrder S; S.init(MTOK, 1024, G, bx);
        pg8::EpiPlain E{MIX, 1024}; pg8::gemm_phase(lds, g, S, E); }
    SEAM(16);
    if (IN(17)) _Pragma("unroll") for (int rep = 0; rep < REPS(17); ++rep) resnorm_phase<false, true>(HN, MIX, g_ffn_post + DM, X, nullptr, gw, NGW, lane);
    if (TSEL_LO >= 0) { xcd_barrier((unsigned*)(ws + WS_CTL), bst); STAMP(18);
        if (blockIdx.x == 0 && threadIdx.x == 0) { volatile LAS unsigned long long* ts = (volatile LAS unsigned long long*)(lds + LDS_MISC + 64);
            float acc_us = 0.f; for (int k = TSEL_LO; k < TSEL_HI; k += TSEL_STEP) acc_us += (float)(ts[k + 1] - ts[k]) * 0.01f;
            a.out[0] = (float)((int)(acc_us * 0.05f + 0.5f)) * 20.f; } }
#undef IN
#undef SEAM
#undef a
#undef ws
}
constexpr int NPHASES = 18;

extern "C" void kernel_launch(void* const* d_in, const int* in_sizes, int n_in, void* d_out, int out_size, void* d_ws, size_t ws_size, hipStream_t stream) {
    static int grid = 0;
    if (grid == 0) {
        if (n_in != 29 || in_sizes[0] != MTOK * DM || out_size != MTOK * DM || ws_size < WS_END) {
            fprintf(stderr, "kernel_launch: unexpected shapes: n_in %d in0 %d out %d ws %zu (need %zu)\n", n_in, n_in > 0 ? in_sizes[0] : -1, out_size, ws_size, (size_t)WS_END); grid = -1; return; }
        int dev = 0, cus = 0, per_cu = 0;
        hipGetDevice(&dev); hipDeviceGetAttribute(&cus, hipDeviceAttributeMultiprocessorCount, dev);
        if (hipFuncSetAttribute((const void*)mega, hipFuncAttributeMaxDynamicSharedMemorySize, LDS_BYTES) != hipSuccess) { fprintf(stderr, "kernel_launch: hipFuncSetAttribute failed\n"); grid = -1; return; }
        if (hipOccupancyMaxActiveBlocksPerMultiprocessor(&per_cu, (const void*)mega, NTHREADS, LDS_BYTES) != hipSuccess || per_cu < 1) { fprintf(stderr, "kernel_launch: occupancy query says %d\n", per_cu); per_cu = 1; }
        (void)hipGetLastError();
        grid = cus;
    }
    if (grid < 0) return;
    if (hipMemsetAsync((char*)d_ws + WS_CTL, 0, CTL_BYTES, stream) != hipSuccess) { fprintf(stderr, "kernel_launch: memset failed\n"); return; }
    Args a{};
    for (int i = 0; i < 29; ++i) a.in[i] = (const float*)d_in[i];
    a.out = (float*)d_out; a.ws = (unsigned char*)d_ws;
#if N_LAUNCH_MODE == 1
    a.ph_lo = 0; a.ph_hi = NPHASES;
    void* args[] = {&a};
    hipError_t e = hipLaunchCooperativeKernel((const void*)mega, dim3(grid), dim3(NTHREADS), args, LDS_BYTES, stream);
    if (e != hipSuccess) fprintf(stderr, "cooperative launch failed: %s (grid %d)\n", hipGetErrorString(e), grid);
#else
    for (int ph = 0; ph < NPHASES; ++ph) { a.ph_lo = ph; a.ph_hi = ph + 1; hipLaunchKernelGGL(mega, dim3(grid), dim3(NTHREADS), LDS_BYTES, stream, a); }
#endif
}
```
